# Optimizing an MI355X kernel written in HIP

```python
import math
import jax
import jax.numpy as jnp
from jax import lax
import numpy as np

D_MODEL = 1024
BATCH = 2
SEQ = 16384
DEPTH = 2

GRID_W = 64
CTX_LEN = 256
A_HEADS = 8
A_DIM = 64
A_WIDTH = A_HEADS * 2 * A_DIM
A_QBLOCK = 128
ROPE_THETA = 10000.0
M_HEADS = 4
M_QK = 128
M_V = 256
M_QKW = M_HEADS * M_QK
M_VW = M_HEADS * M_V
M_CHUNK = 64
CONV_K = 3
F_BIAS_LO = 3.0
F_BIAS_HI = 6.0
N_EXPERTS = 256
TOP_K = 8
E_HIDDEN = 256
S_HIDDEN = 256
ROUTE_SCALE = 2.5
MOE_BLOCK = 128
ALPHA = (2 * DEPTH) ** 0.25
BETA = (8 * DEPTH) ** -0.25
LN_EPS = 1e-5
RMS_EPS = 1e-6
IN_WIDTHS = (A_WIDTH, A_WIDTH, A_WIDTH, 2 * M_QKW, M_VW, M_VW, 4 * M_HEADS, 2 * D_MODEL)
IN_SPLITS = tuple(int(v) for v in np.cumsum(IN_WIDTHS)[:-1])
IN_WIDTH = sum(IN_WIDTHS)

kernel_name = 'hybrid_diffattn_mlstm_moe_dit'


def layer_norm(x, g, b):
    xf = x.astype(jnp.float32)
    mu = jnp.mean(xf, axis=-1, keepdims=True)
    var = jnp.mean(jnp.square(xf - mu), axis=-1, keepdims=True)
    y = (xf - mu) * lax.rsqrt(var + LN_EPS)
    return (y * g.astype(jnp.float32) + b.astype(jnp.float32)).astype(x.dtype)


def rms_norm(x, g):
    xf = x.astype(jnp.float32)
    y = xf * lax.rsqrt(jnp.mean(xf * xf, axis=-1, keepdims=True) + RMS_EPS)
    return (y * g.astype(jnp.float32)).astype(x.dtype)


def modulate(h, shift, scale):
    return h * (1.0 + scale) + shift


def centred_conv(x, w):
    L = x.shape[1]
    pad = CONV_K // 2
    xp = jnp.pad(x, ((0, 0), (pad, pad), (0, 0)))
    y = xp[:, 0:L] * w[0]
    for j in range(1, CONV_K):
        y = y + xp[:, j:j + L] * w[j]
    return y


def axial_rope_tables(rows, dtype):
    n_tok = rows * GRID_W
    row = jnp.repeat(jnp.arange(rows, dtype=jnp.float32), GRID_W)
    col = jnp.tile(jnp.arange(GRID_W, dtype=jnp.float32), rows)
    n_freq = A_DIM // 4
    inv = jnp.power(ROPE_THETA, -jnp.arange(n_freq, dtype=jnp.float32) / n_freq)
    shape = (1, n_tok, 1, 1, n_freq)
    ang_r = (row[:, None] * inv).reshape(shape)
    ang_c = (col[:, None] * inv).reshape(shape)
    return (jnp.cos(ang_r).astype(dtype), jnp.sin(ang_r).astype(dtype),
            jnp.cos(ang_c).astype(dtype), jnp.sin(ang_c).astype(dtype))


def rotate(p, cos, sin):
    p1, p2 = jnp.split(p, 2, axis=-1)
    return jnp.concatenate([p1 * cos - p2 * sin, p2 * cos + p1 * sin], axis=-1)


def apply_axial_rope(x, cos_r, sin_r, cos_c, sin_c):
    half = A_DIM // 2
    return jnp.concatenate([rotate(x[..., :half], cos_r, sin_r),
                            rotate(x[..., half:], cos_c, sin_c)], axis=-1)


def project_heads(h, p):
    B, L, _ = h.shape
    z = h @ p['w_in']
    qa, ka, va, qkm, vm, om, gm, gmerge = jnp.split(z, IN_SPLITS, axis=-1)
    qkm = jax.nn.silu(centred_conv(qkm, p['conv_qk']))
    qm, km = jnp.split(qkm, 2, axis=-1)

    def heads(a, d):
        return a.reshape(B, L, M_HEADS, d).transpose(0, 2, 1, 3).astype(jnp.float32)

    gates = (gm.astype(jnp.float32) + p['b_gates'].astype(jnp.float32)).reshape(B, L, 4, M_HEADS).transpose(2, 0, 3, 1)
    return (qa.reshape(B, L, A_HEADS, 2, A_DIM), ka.reshape(B, L, A_HEADS, 2, A_DIM),
            va.reshape(B, L, A_HEADS, 2 * A_DIM),
            heads(qm, M_QK), heads(km, M_QK) * (M_QK ** -0.5), heads(vm, M_V),
            om, gates, gmerge)


def diff_attend(q, keys, vals, lam_val):
    s = jnp.einsum('bqhjd,bkhjd->bhjqk', q, keys, preferred_element_type=jnp.float32) * (A_DIM ** -0.5)
    prob = jax.nn.softmax(s, axis=-1)
    w = (prob[:, :, 0] - lam_val * prob[:, :, 1]).astype(vals.dtype)
    return jnp.einsum('bhqk,bkhe->bqhe', w, vals)


def diff_attention(q_l, k_l, v_l, q_c, k_c, v_c, lam_val, lam_init, g, with_ctx_out):
    B, S = q_l.shape[:2]
    keys = jnp.concatenate([k_l, k_c], axis=1)
    vals = jnp.concatenate([v_l, v_c], axis=1)
    nb = S // A_QBLOCK
    qb = q_l.reshape(B, nb, A_QBLOCK, A_HEADS, 2, A_DIM).swapaxes(0, 1)
    o_l = lax.map(lambda qq: diff_attend(qq, keys, vals, lam_val), qb)
    o_l = o_l.swapaxes(0, 1).reshape(B, S, A_HEADS, 2 * A_DIM)

    def post(o):
        return (rms_norm(o, g) * (1.0 - lam_init)).reshape(o.shape[0], o.shape[1], A_WIDTH)

    o_c = post(diff_attend(q_c, k_c, v_c, lam_val)) if with_ctx_out else None
    return post(o_l), o_c


def mlstm_scan(q, k, v, ig, fg, state, with_out):
    B, H, L, _ = q.shape
    nc = L // M_CHUNK

    def chunks(a):
        return jnp.moveaxis(a.reshape((B, H, nc, M_CHUNK) + a.shape[3:]), 2, 0)

    tri = jnp.tril(jnp.ones((M_CHUNK, M_CHUNK), dtype=bool))

    def step(carry, inp):
        C, n, m = carry
        qc, kc, vc, ic, fc = inp
        b = jnp.cumsum(jax.nn.log_sigmoid(fc), axis=-1)
        b_end = b[..., -1]
        g = b_end[..., None] - b + ic
        m_new = jnp.maximum(b_end + m, jnp.max(g, axis=-1))
        w = jnp.exp(g - m_new[..., None])
        decay = jnp.exp(b_end + m - m_new)
        C_new = decay[..., None, None] * C + jnp.einsum('bhs,bhsd,bhse->bhde', w, kc, vc)
        n_new = decay[..., None] * n + jnp.einsum('bhs,bhsd->bhd', w, kc)
        if not with_out:
            return (C_new, n_new, m_new), None
        dmat = jnp.where(tri, b[..., :, None] - b[..., None, :] + ic[..., None, :], -jnp.inf)
        inter = b + m[..., None]
        m_t = jnp.maximum(inter, jnp.max(dmat, axis=-1))
        dexp = jnp.exp(dmat - m_t[..., None])
        iscale = jnp.exp(inter - m_t)
        s = jnp.einsum('bhtd,bhsd->bhts', qc, kc) * dexp
        num = iscale[..., None] * jnp.einsum('bhtd,bhde->bhte', qc, C) + jnp.einsum('bhts,bhse->bhte', s, vc)
        den = iscale * jnp.einsum('bhtd,bhd->bht', qc, n) + jnp.sum(s, axis=-1)
        h = num / jnp.maximum(jnp.abs(den), jnp.exp(-m_t))[..., None]
        return (C_new, n_new, m_new), h

    state, hs = lax.scan(step, state, (chunks(q), chunks(k), chunks(v), chunks(ig), chunks(fg)))
    if not with_out:
        return None, state
    return jnp.moveaxis(hs, 0, 2).reshape(B, H, L, M_V), state


def mlstm_bidirectional(q_l, k_l, v_l, g_l, q_c, k_c, v_c, g_c, with_ctx_out):
    B = q_l.shape[0]
    init = (jnp.zeros((B, M_HEADS, M_QK, M_V), jnp.float32),
            jnp.zeros((B, M_HEADS, M_QK), jnp.float32),
            jnp.zeros((B, M_HEADS), jnp.float32))

    def flip(a):
        return jnp.flip(a, axis=2)

    h_cf, st_f = mlstm_scan(q_c, k_c, v_c, g_c[0], g_c[1], init, with_ctx_out)
    h_lf, _ = mlstm_scan(q_l, k_l, v_l, g_l[0], g_l[1], st_f, True)
    h_cb, st_b = mlstm_scan(flip(q_c), flip(k_c), flip(v_c), flip(g_c[2]), flip(g_c[3]), init, with_ctx_out)
    h_lb, _ = mlstm_scan(flip(q_l), flip(k_l), flip(v_l), flip(g_l[2]), flip(g_l[3]), st_b, True)
    h_lat = h_lf + flip(h_lb)
    h_ctx = h_cf + flip(h_cb) if with_ctx_out else None
    return h_lat, h_ctx


def merge_branches(o_a, h_m, o_m, g_merge, p):
    B, L = o_m.shape[:2]
    hm = rms_norm(h_m.transpose(0, 2, 1, 3), p['norm_m'].reshape(M_HEADS, M_V)).reshape(B, L, M_VW)
    hm = hm.astype(o_m.dtype) * jax.nn.sigmoid(o_m)
    ga, gb = jnp.split(jax.nn.sigmoid(g_merge), 2, axis=-1)
    y = ga * (o_a @ p['w_br_a']) + gb * (hm @ p['w_br_m'])
    return y @ p['w_out']


def token_mixer(h_lat, h_ctx, rope, p, lam_init, with_ctx_out):
    qa_l, ka_l, va_l, qm_l, km_l, vm_l, om_l, gm_l, gmg_l = project_heads(h_lat, p)
    qa_c, ka_c, va_c, qm_c, km_c, vm_c, om_c, gm_c, gmg_c = project_heads(h_ctx, p)
    qa_l = apply_axial_rope(qa_l, *rope)
    ka_l = apply_axial_rope(ka_l, *rope)
    lq1, lk1, lq2, lk2 = p['lam'].astype(jnp.float32)
    lam_val = jnp.exp(jnp.sum(lq1 * lk1)) - jnp.exp(jnp.sum(lq2 * lk2)) + lam_init
    oa_l, oa_c = diff_attention(qa_l, ka_l, va_l, qa_c, ka_c, va_c, lam_val, lam_init, p['subln_a'], with_ctx_out)
    hm_l, hm_c = mlstm_bidirectional(qm_l, km_l, vm_l, gm_l, qm_c, km_c, vm_c, gm_c, with_ctx_out)
    y_l = merge_branches(oa_l, hm_l, om_l, gmg_l, p)
    y_c = merge_branches(oa_c, hm_c, om_c, gmg_c, p) if with_ctx_out else None
    return y_l, y_c


def moe_ffn(h, w_router, e_bias, w_e_in, w_e_out, ws_in, ws_out):
    T, D = h.shape
    scores = jax.nn.sigmoid((h @ w_router).astype(jnp.float32))
    _, idx = lax.top_k(scores + e_bias.astype(jnp.float32), TOP_K)
    w = jnp.take_along_axis(scores, idx, axis=-1)
    w = w / jnp.sum(w, axis=-1, keepdims=True) * ROUTE_SCALE
    A = T * TOP_K
    n_blk = -(-A // MOE_BLOCK) + N_EXPERTS
    flat_e = idx.reshape(-1)
    flat_t = jnp.repeat(jnp.arange(T, dtype=jnp.int32), TOP_K)
    order = jnp.argsort(flat_e)
    se = flat_e[order]
    counts = jnp.bincount(flat_e, length=N_EXPERTS)
    padded = (counts + MOE_BLOCK - 1) // MOE_BLOCK * MOE_BLOCK
    start = jnp.cumsum(counts) - counts
    pend = jnp.cumsum(padded)
    pstart = pend - padded
    dest = pstart[se] + (jnp.arange(A) - start[se])
    buf_t = jnp.full((n_blk * MOE_BLOCK,), T, jnp.int32).at[dest].set(flat_t[order])
    buf_w = jnp.zeros((n_blk * MOE_BLOCK,), h.dtype).at[dest].set(w.reshape(-1)[order].astype(h.dtype))
    blk_e = jnp.minimum(jnp.searchsorted(pend, jnp.arange(n_blk) * MOE_BLOCK, side='right'), N_EXPERTS - 1)

    def expert_block(args):
        tb, e = args
        xb = h[jnp.minimum(tb, T - 1)]
        a, g = jnp.split(xb @ w_e_in[e], 2, axis=-1)
        return (jax.nn.silu(a) * g) @ w_e_out[e]

    y_buf = lax.map(expert_block, (buf_t.reshape(n_blk, MOE_BLOCK), blk_e)).reshape(n_blk * MOE_BLOCK, D)
    routed = jnp.zeros((T, D), h.dtype).at[buf_t].add(y_buf * buf_w[:, None], mode='drop')
    a, g = jnp.split(h @ ws_in, 2, axis=-1)
    return routed + (jax.nn.silu(a) * g) @ ws_out


def setup_inputs(seed: int = 0) -> dict:
    key = jax.random.key(seed)
    ks = jax.random.split(key, 26)
    L, D, E = DEPTH, D_MODEL, N_EXPERTS

    def nrm(k, shape, std):
        return jax.random.normal(k, shape, jnp.float32) * std

    f_bias = jnp.linspace(F_BIAS_LO, F_BIAS_HI, M_HEADS, dtype=jnp.float32)
    zero_b = jnp.zeros_like(f_bias)
    b_gates = (nrm(ks[7], (L, 4, M_HEADS), 0.1) + jnp.stack([zero_b, f_bias, zero_b, f_bias])).reshape(L, 4 * M_HEADS)
    return {
        'x': nrm(ks[0], (BATCH, SEQ, D), 1.0),
        'c': nrm(ks[1], (BATCH, D), 1.0),
        'ctx': nrm(ks[2], (BATCH, CTX_LEN, D), 1.0),
        'c_ctx': nrm(ks[3], (D,), 1.0),
        'ada_w': nrm(ks[4], (L, D, 6 * D), 0.5 * D ** -0.5),
        'ada_b': nrm(ks[5], (L, 6 * D), 0.02),
        'w_in': nrm(ks[6], (L, D, IN_WIDTH), D ** -0.5),
        'b_gates': b_gates,
        'conv_qk': nrm(ks[8], (L, CONV_K, 2 * M_QKW), CONV_K ** -0.5),
        'lam': nrm(ks[9], (L, 4, A_DIM), 0.1),
        'subln_a': 1.0 + nrm(ks[10], (L, 2 * A_DIM), 0.02),
        'norm_m': 1.0 + nrm(ks[11], (L, M_VW), 0.02),
        'w_br_a': nrm(ks[12], (L, A_WIDTH, D), A_WIDTH ** -0.5),
        'w_br_m': nrm(ks[13], (L, M_VW, D), M_VW ** -0.5),
        'w_out': nrm(ks[14], (L, D, D), BETA * D ** -0.5),
        'ln1_g': 1.0 + nrm(ks[15], (L, D), 0.02),
        'ln1_b': nrm(ks[16], (L, D), 0.02),
        'ln2_g': 1.0 + nrm(ks[17], (L, D), 0.02),
        'ln2_b': nrm(ks[18], (L, D), 0.02),
        'w_router': nrm(ks[19], (L, D, E), D ** -0.5),
        'e_bias': nrm(ks[20], (L, E), 0.01),
        'w_e_in': nrm(ks[21], (L, E, D, 2 * E_HIDDEN), D ** -0.5),
        'w_e_out': nrm(ks[22], (L, E, E_HIDDEN, D), BETA * E_HIDDEN ** -0.5),
        'ws_in': nrm(ks[23], (L, D, 2 * S_HIDDEN), D ** -0.5),
        'ws_out': nrm(ks[24], (L, S_HIDDEN, D), BETA * S_HIDDEN ** -0.5),
    }


def reference(x, c, ctx, c_ctx, ada_w, ada_b, w_in, b_gates, conv_qk, lam, subln_a, norm_m,
              w_br_a, w_br_m, w_out, ln1_g, ln1_b, ln2_g, ln2_b,
              w_router, e_bias, w_e_in, w_e_out, ws_in, ws_out):
    B, S, D = x.shape
    ROWS = S // GRID_W
    rope = axial_rope_tables(ROWS, x.dtype)
    cond_lat = jax.nn.silu(c)
    cond_ctx = jax.nn.silu(c_ctx)
    s = ctx
    for l in range(DEPTH):
        last = l == DEPTH - 1
        p = {'w_in': w_in[l], 'b_gates': b_gates[l], 'conv_qk': conv_qk[l], 'lam': lam[l],
             'subln_a': subln_a[l], 'norm_m': norm_m[l], 'w_br_a': w_br_a[l], 'w_br_m': w_br_m[l],
             'w_out': w_out[l]}
        lam_init = 0.8 - 0.6 * math.exp(-0.3 * l)
        m_lat = jnp.split((cond_lat @ ada_w[l] + ada_b[l])[:, None, :], 6, axis=-1)
        m_ctx = jnp.split(cond_ctx @ ada_w[l] + ada_b[l], 6, axis=-1)
        y_l, y_c = token_mixer(modulate(x, m_lat[0], m_lat[1]), modulate(s, m_ctx[0], m_ctx[1]),
                               rope, p, lam_init, not last)
        x = layer_norm(ALPHA * x + m_lat[2] * y_l, ln1_g[l], ln1_b[l])
        h_l = modulate(x, m_lat[3], m_lat[4]).reshape(B * S, D)
        if last:
            f_l = moe_ffn(h_l, w_router[l], e_bias[l], w_e_in[l], w_e_out[l], ws_in[l], ws_out[l])
        else:
            s = layer_norm(ALPHA * s + m_ctx[2] * y_c, ln1_g[l], ln1_b[l])
            h_c = modulate(s, m_ctx[3], m_ctx[4]).reshape(-1, D)
            f = moe_ffn(jnp.concatenate([h_l, h_c], axis=0),
                        w_router[l], e_bias[l], w_e_in[l], w_e_out[l], ws_in[l], ws_out[l])
            f_l = f[:B * S]
            s = layer_norm(ALPHA * s + m_ctx[5] * f[B * S:].reshape(s.shape), ln2_g[l], ln2_b[l])
        x = layer_norm(ALPHA * x + m_lat[5] * f_l.reshape(B, S, D), ln2_g[l], ln2_b[l])
    return x
```

```cpp
#include <hip/hip_runtime.h>
#include <cstdio>
#include <cstdint>

#define GAS __attribute__((address_space(1)))
#define LAS __attribute__((address_space(3)))
typedef unsigned short bf16_t;
typedef short bf16x8 __attribute__((ext_vector_type(8)));
typedef short s16x4 __attribute__((ext_vector_type(4)));
typedef float f32x4 __attribute__((ext_vector_type(4)));
typedef float f32x2 __attribute__((ext_vector_type(2)));
typedef float f32x8 __attribute__((ext_vector_type(8)));
typedef float f32x16 __attribute__((ext_vector_type(16)));
typedef unsigned u32x4 __attribute__((ext_vector_type(4)));
typedef unsigned u32x2 __attribute__((ext_vector_type(2)));
typedef GAS unsigned gu32;
#define RLX_AGENT __ATOMIC_RELAXED, __HIP_MEMORY_SCOPE_AGENT
#define LDS_WAIT() asm volatile("s_waitcnt lgkmcnt(0)" ::: "memory")
#define VM_WAIT() asm volatile("s_waitcnt vmcnt(0)" ::: "memory")

constexpr int D = 1024, BATCH = 2, SEQ = 16384, CTX = 256, TPB = SEQ + CTX  , MALL = BATCH * TPB  ;
constexpr int NRT = MALL / 256;
constexpr int NWAVES = 8, NTHR = 512;
constexpr int INW = 8208, INW_PAD = 8448;
constexpr int NEXP = 256, TOPK = 8;
constexpr float ALPHA_RES = 1.4142135623730951f;
constexpr float LN_EPS = 1e-5f, RMS_EPS = 1e-6f;
constexpr int MAXBLK = 1040 + 256 + 130;
constexpr int NCHUNK = TPB / 64;
constexpr int NCHAIN = 16;
#ifndef PHM
#define PHM 0x3ffff
#endif

__device__ __forceinline__ unsigned f2bf(float f) { unsigned u = __builtin_bit_cast(unsigned, f); return (u + 0x7fffu + ((u >> 16) & 1u)) >> 16; }
__device__ __forceinline__ float bf2f(unsigned h) { return __builtin_bit_cast(float, h << 16); }
__device__ __forceinline__ unsigned pk2(float lo, float hi) { return f2bf(lo) | (f2bf(hi) << 16); }
__device__ __forceinline__ u32x2 pk4(f32x4 v) { u32x2 r; r.x = pk2(v.x, v.y); r.y = pk2(v.z, v.w); return r; }
__device__ __forceinline__ f32x4 unpk4(u32x2 w) { f32x4 r; r.x = bf2f(w.x & 0xffffu); r.y = bf2f(w.x >> 16); r.z = bf2f(w.y & 0xffffu); r.w = bf2f(w.y >> 16); return r; }
__device__ __forceinline__ float sigmoidf_(float x) { return 1.f / (1.f + __expf(-x)); }
__device__ __forceinline__ float siluf_(float x) { return x / (1.f + __expf(-x)); }
__device__ __forceinline__ float logsigf_(float x) { return fminf(x, 0.f) - log1pf(__expf(-fabsf(x))); }
__device__ __forceinline__ int opaque_tid() { int t = threadIdx.x; asm volatile("" : "+v"(t)); return t; }
__device__ __forceinline__ float wave_sum(float v) {
#pragma unroll
    for (int o = 1; o < 64; o <<= 1) v += __shfl_xor(v, o);
    return v;
}

constexpr size_t MiB = 1u << 20;
constexpr size_t WS_CTL = 0, CTL_ZERO_BYTES = 1 * MiB;
constexpr size_t WS_MODV = 1 * MiB;
constexpr size_t WS_ROPE = WS_MODV + 256 * 1024;
constexpr size_t WS_W0 = 2 * MiB;
constexpr size_t WL_IN = 0;
constexpr size_t WL_BRA = WL_IN + (size_t)INW_PAD * 1024 * 2;
constexpr size_t WL_BRM = WL_BRA + 2 * MiB;
constexpr size_t WL_OUT = WL_BRM + 2 * MiB;
constexpr size_t WL_R3 = WL_OUT + 2 * MiB;
constexpr size_t WL_E1 = WL_R3 + (size_t)256 * 3072 * 2;
constexpr size_t WL_E2 = WL_E1 + (size_t)257 * 512 * 1024 * 2;
constexpr size_t WL_SIZE = WL_E2 + (size_t)257 * 1024 * 256 * 2;
constexpr size_t ACT0 = WS_W0 + 2 * WL_SIZE;
constexpr size_t SZ_B16 = (size_t)MALL * 1024 * 2;
constexpr size_t WS_HMOD = ACT0;
constexpr size_t WS_Q = WS_HMOD + SZ_B16, WS_K = WS_Q + SZ_B16, WS_V = WS_K + SZ_B16, WS_QKM = WS_V + SZ_B16, WS_VM = WS_QKM + SZ_B16;
constexpr size_t WS_OMS = WS_VM + SZ_B16, WS_GA = WS_OMS + SZ_B16, WS_GB = WS_GA + SZ_B16;
constexpr size_t WS_GATES = WS_GB + SZ_B16;
constexpr size_t WS_OJ = WS_GATES + (size_t)MALL * 16 * 4 + 61440;
constexpr size_t WS_OA = WS_OJ + 2 * SZ_B16;
constexpr size_t WS_ST = WS_OA + SZ_B16;
constexpr size_t WS_NU = WS_ST + (size_t)NCHAIN * NCHUNK * 65536;
constexpr size_t WS_ADEC = WS_NU + (size_t)NCHAIN * NCHUNK * 128 * 4;
constexpr size_t WS_HM = WS_ADEC + 65536;
constexpr size_t WS_T1 = WS_HM + SZ_B16, WS_Y = WS_T1 + SZ_B16;
constexpr size_t WS_R = WS_Y + SZ_B16;
constexpr size_t WS_X1 = WS_R + 2 * SZ_B16, WS_XCUR = WS_X1 + 2 * SZ_B16;
constexpr size_t WS_H2A = WS_XCUR + 2 * SZ_B16;
constexpr size_t WS_LOG = WS_H2A + 3 * SZ_B16;
constexpr size_t WS_TOPI = WS_LOG + (size_t)MALL * 256 * 4;
constexpr size_t WS_TOPW = WS_TOPI + 2 * MiB, WS_POS = WS_TOPW + 2 * MiB, WS_SLOT = WS_POS + 2 * MiB;
constexpr size_t WS_ROWTOK = WS_SLOT + 2 * MiB;
constexpr size_t WS_ROWW = WS_ROWTOK + 2 * MiB;
constexpr size_t WS_BLKEXP = WS_ROWW + 2 * MiB;
constexpr size_t WS_HE = WS_BLKEXP + 1 * MiB;
constexpr size_t WS_YB = WS_HE + (size_t)MAXBLK * 256 * 256 * 2;
constexpr size_t WS_END = WS_YB + (size_t)MAXBLK * 256 * 1024 * 2;
static_assert(WS_END <= (size_t)4096 * MiB, "d_ws map fits 4 GiB");
constexpr int CW_BAR = 4096;
constexpr int CW_CNT = 16384;
constexpr int CW_MSTAB = 17408;

constexpr int RING_BYTES = 131072;
constexpr int TAB_OFF = RING_BYTES;
constexpr int TAB_BYTES = 12 * 1024 + 256;
constexpr int MISC_OFF = TAB_OFF + TAB_BYTES;
constexpr int LDS_BYTES = 147456;
static_assert(MISC_OFF + 128 <= LDS_BYTES, "LDS map");

#define XB_TMO      128
#define XB_XCNT(j)  (256  + 64 * (j))
#define XB_XSUB(j)  (1280 + 64 * (j))
#define XB_XGEN(j)  (2304 + 64 * (j))
#define XB_TOP      3328
#define XB_TOPGEN   3392
#define XCD_BAR_WORDS 3456
#define XB_SPIN_CAP (1u << 22)
__device__ __forceinline__ unsigned xb_ld(unsigned* p)              { return __hip_atomic_load(p, __ATOMIC_RELAXED, __HIP_MEMORY_SCOPE_AGENT); }
__device__ __forceinline__ unsigned xb_add(unsigned* p, unsigned v) { return __hip_atomic_fetch_add(p, v, __ATOMIC_RELAXED, __HIP_MEMORY_SCOPE_AGENT); }
__device__ __forceinline__ unsigned xb_xcc_id() { return (unsigned)__builtin_amdgcn_s_getreg((3 << 11) | 20) & 0xFu; }
#define XB_SPIN(cond, bar) do { unsigned _sp = 0; while (cond) { __builtin_amdgcn_s_sleep(1); \
    if ((++_sp & 255u) == 0u) { if (xb_ld(&(bar)[XB_TMO])) break; if (_sp > XB_SPIN_CAP) { atomicAdd(&(bar)[XB_TMO], 1u); break; } } } } while (0)
struct XcdBarrier { unsigned* bar; unsigned x; volatile LAS unsigned* st; };
__device__ __forceinline__ XcdBarrier xcd_barrier_post(unsigned* bar, volatile LAS unsigned* st) {
    XcdBarrier b; b.bar = bar; b.x = xb_xcc_id(); b.st = st;
    if (threadIdx.x == 0) (void)xb_add(&bar[XB_XCNT(b.x)], 1u);
    return b;
}
__device__ __forceinline__ void xcd_barrier_complete(unsigned* bar, unsigned x, unsigned& nloc, unsigned& nx) {
    const unsigned G = gridDim.x * gridDim.y * gridDim.z;
    unsigned sum, cnt, mine, sp = 0u;
    for (;;) {
        sum = 0u; cnt = 0u; mine = 0u;
#pragma unroll
        for (unsigned j = 0; j < 16; ++j) { const unsigned c = xb_ld(&bar[XB_XCNT(j)]); sum += c; cnt += (c > 0u) ? 1u : 0u; mine = (j == x) ? c : mine; }
        if (sum == G) break;
        __builtin_amdgcn_s_sleep(1);
        if ((++sp & 255u) == 0u) { if (xb_ld(&bar[XB_TMO])) break; if (sp > XB_SPIN_CAP) { atomicAdd(&bar[XB_TMO], 1u); break; } }
    }
    nloc = mine > 0u ? mine : 1u; nx = cnt > 0u ? cnt : 1u;
}
__device__ __forceinline__ void xcd_barrier(const XcdBarrier& b) {
    asm volatile("s_waitcnt vmcnt(0)" ::: "memory");
    __syncthreads();
    if (threadIdx.x == 0) {
        unsigned* bar = b.bar;
        __builtin_amdgcn_s_waitcnt(0);
        unsigned nloc = b.st[0], nx = b.st[1];
        if (nloc == 0u) { xcd_barrier_complete(bar, b.x, nloc, nx); b.st[0] = nloc; b.st[1] = nx; }
        const unsigned old = xb_add(&bar[XB_XSUB(b.x)], 1u);
        const unsigned gen = old / nloc;
        if (old + 1u == (gen + 1u) * nloc) {
            __builtin_amdgcn_fence(__ATOMIC_RELEASE, "agent");
            asm volatile("s_waitcnt vmcnt(0)" ::: "memory");
            const unsigned og = xb_add(&bar[XB_TOP], 1u);
            const unsigned tg = og / nx;
            if (og + 1u == (tg + 1u) * nx) xb_add(&bar[XB_TOPGEN], 1u);
            else XB_SPIN(xb_ld(&bar[XB_TOPGEN]) == tg, bar);
            __builtin_amdgcn_fence(__ATOMIC_ACQUIRE, "agent");
            xb_add(&bar[XB_XGEN(b.x)], 1u);
            asm volatile("s_waitcnt vmcnt(0)" ::: "memory");
        } else {
            XB_SPIN(xb_ld(&bar[XB_XGEN(b.x)]) == gen, bar);
            __builtin_amdgcn_fence(__ATOMIC_ACQUIRE, "agent");
            asm volatile("s_waitcnt vmcnt(0)" ::: "memory");
        }
    }
    __syncthreads();
}

namespace pg8 {
constexpr int BM = 256, BK = 64, HALF = 128, HTB = HALF * BK * 2, STAGE_BYTES = 8 * HTB, NXCD = 8, WGM = 8;
__host__ __device__ __forceinline__ int lds_byte(int r, int c) { const int st = (r >> 4) * 2 + (c >> 5), rr = r & 15, cc = c & 31, ob = rr * 64 + cc * 2; return st * 1024 + (ob ^ (((ob >> 9) & 1) << 5)); }
__host__ __device__ __forceinline__ void stage_rc(int b, int& R, int& C) { const int st = b / 1024, sb = b % 1024, swz = sb ^ (((sb >> 9) & 1) << 5); R = (st >> 1) * 16 + swz / 64; C = (st & 1) * 32 + (swz % 64) / 2; }
struct Unit { int pm, pn, aux; };

struct DenseOrder {
    static constexpr bool GATHER = false;
    int nM, nN, nwg, G, c; const char* Bt; size_t btile;
    __device__ __forceinline__ void init(int nM_, int nN_, int G_, int c_, const void* Bt_, int K) { nM = nM_; nN = nN_; nwg = nM * nN; G = G_; c = c_; Bt = (const char*)Bt_; btile = (size_t)256 * K * 2; }
    __device__ __forceinline__ bool next(int i, Unit& u) const {
        const long L = (long)i * G + c; if (L >= nwg) return false;
        int wgid = (int)L; { const int q = nwg / NXCD, r = nwg % NXCD, xcd = wgid % NXCD, off = wgid / NXCD; wgid = (xcd < r ? xcd * (q + 1) : r * (q + 1) + (xcd - r) * q) + off; }
        const int nig = WGM * nN, gid = wgid / nig, fm = gid * WGM, gsz = (nM - fm) < WGM ? (nM - fm) : WGM;
        u.pm = fm + ((wgid % nig) % gsz); u.pn = (wgid % nig) / gsz; u.aux = 0; return true;
    }
    __device__ __forceinline__ unsigned arow(const Unit& u, int r) const { return 0u; }
    __device__ __forceinline__ const char* bptr(const Unit& u) const { return Bt + (size_t)u.pn * btile; }
};
template <int NPN, bool GATHER_> struct MoeOrder {
    static constexpr bool GATHER = GATHER_;
    int nunits, G, vcu; const char* W; size_t estride, btile; const LAS int* rowtab; const LAS int* etab;
    __device__ __forceinline__ bool next(int i, Unit& u) const {
        const int L = i * G + vcu; if (L >= nunits) return false;
        u.pm = L / NPN; u.pn = L % NPN; u.aux = i; return true;
    }
    __device__ __forceinline__ unsigned arow(const Unit& u, int r) const { return (unsigned)rowtab[u.aux * 256 + r]; }
    __device__ __forceinline__ const char* bptr(const Unit& u) const { return W + (size_t)etab[u.aux] * estride + (size_t)u.pn * btile; }
};

template <class Epi, class Sched>
__device__ __forceinline__ void gemm_phase(LAS unsigned char* lds, const bf16_t* A, int lda, int K, const Sched& S, const Epi& E) {
    constexpr bool GATHER = Sched::GATHER;
    const int tid = opaque_tid(), wid = __builtin_amdgcn_readfirstlane(tid >> 6), lane = tid & 63, wr = wid >> 2, wc = wid & 3, fr = lane & 15, fq = lane >> 4;
    const int nt = K / BK;
    int R0, C0, R1, C1; stage_rc(tid * 16, R0, C0); stage_rc(tid * 16 + 8192, R1, C1);
    const unsigned vb0 = (unsigned)(R0 * K + C0) * 2u, vb1 = (unsigned)(R1 * K + C1) * 2u;
    const unsigned lda2 = (unsigned)lda * 2u;
    const size_t kstep = (size_t)(BK * 2);
    const size_t hstepB = (size_t)HALF * K * 2;
    const size_t hstepA = GATHER ? (size_t)0 : (size_t)HALF * lda2, tstepA = GATHER ? (size_t)0 : (size_t)256 * lda2;
    const unsigned ldsw = (unsigned)wid * 1024u;
    const int aoff = lds_byte(wr * 64 + fr, fq * 8), boff = lds_byte(wc * 32 + fr, fq * 8);
    const char* gA = (const char*)A;
#define PG8_SA(b, h) (((b) * 2 + (h)) * HTB)
#define PG8_SB(b, h) ((4 + (b) * 2 + (h)) * HTB)
#define PG8_STAGE(bufoff, gbase, o0, o1) do { \
        __builtin_amdgcn_global_load_lds((const unsigned*)((const char*)(gbase) + (o0)), (LAS unsigned*)(lds + (bufoff) + ldsw), 16, 0, 0); \
        __builtin_amdgcn_global_load_lds((const unsigned*)((const char*)(gbase) + (o1)), (LAS unsigned*)(lds + (bufoff) + ldsw + 8192), 16, 0, 0); } while (0)
#define PG8_LDA(dst, b, h) do { _Pragma("unroll") for (int m = 0; m < 4; ++m) _Pragma("unroll") for (int k = 0; k < 2; ++k) dst[m][k] = *(const LAS bf16x8*)(lds + PG8_SA(b, h) + aoff + m * 2048 + k * 1024); } while (0)
#define PG8_LDB(dst, b, h) do { _Pragma("unroll") for (int n = 0; n < 2; ++n) _Pragma("unroll") for (int k = 0; k < 2; ++k) dst[n][k] = *(const LAS bf16x8*)(lds + PG8_SB(b, h) + boff + n * 2048 + k * 1024); } while (0)
#define PG8_MMA(ai, bj, At, Bt) do { __builtin_amdgcn_s_setprio(1); _Pragma("unroll") for (int m = 0; m < 4; ++m) _Pragma("unroll") for (int n = 0; n < 2; ++n) _Pragma("unroll") for (int k = 0; k < 2; ++k) \
        acc[ai][bj][m][n] = __builtin_amdgcn_mfma_f32_16x16x32_bf16(Bt[n][k], At[m][k], acc[ai][bj][m][n], 0, 0, 0); __builtin_amdgcn_s_setprio(0); } while (0)
#define PG8_WAIT_V(n) asm volatile("s_waitcnt vmcnt(" #n ")" ::: "memory")
#define PG8_WAIT_L(n) asm volatile("s_waitcnt lgkmcnt(" #n ")" ::: "memory")
#define PG8_BAR __builtin_amdgcn_s_barrier()
#define PG8_SCHED __builtin_amdgcn_sched_barrier(0)
    Unit cur, nxt; int ui = 0;
    if (!S.next(0, cur)) return;
    f32x4 acc[2][2][4][2];
#pragma unroll
    for (int a = 0; a < 2; ++a)
#pragma unroll
        for (int b = 0; b < 2; ++b)
#pragma unroll
            for (int m = 0; m < 4; ++m)
#pragma unroll
                for (int n = 0; n < 2; ++n) acc[a][b][m][n] = (f32x4){0.f, 0.f, 0.f, 0.f};
    bf16x8 At[4][2], B0[2][2], B1[2][2];
    unsigned o00, o01, o10, o11;
    if constexpr (GATHER) { o00 = S.arow(cur, R0) * lda2 + (unsigned)(C0 * 2); o01 = S.arow(cur, R1) * lda2 + (unsigned)(C1 * 2); o10 = S.arow(cur, 128 + R0) * lda2 + (unsigned)(C0 * 2); o11 = S.arow(cur, 128 + R1) * lda2 + (unsigned)(C1 * 2); }
    else { o00 = (unsigned)R0 * lda2 + (unsigned)(C0 * 2); o01 = (unsigned)R1 * lda2 + (unsigned)(C1 * 2); o10 = o00; o11 = o01; }
    const char* cA = gA + (size_t)cur.pm * tstepA;
    const char* cB = S.bptr(cur);
    PG8_STAGE(PG8_SB(0, 0), cB, vb0, vb1); PG8_STAGE(PG8_SB(0, 1), cB + hstepB, vb0, vb1); PG8_STAGE(PG8_SA(0, 0), cA, o00, o01); PG8_STAGE(PG8_SA(0, 1), cA + hstepA, o10, o11);
    if (wr == 1) PG8_BAR;
    PG8_WAIT_V(2); PG8_BAR;
    PG8_STAGE(PG8_SB(1, 0), cB + kstep, vb0, vb1); PG8_STAGE(PG8_SA(1, 0), cA + kstep, o00, o01); PG8_STAGE(PG8_SB(1, 1), cB + hstepB + kstep, vb0, vb1);
    PG8_WAIT_V(6); PG8_BAR;
    for (;;) {
        const bool has_next = S.next(ui + 1, nxt);
        const char* nA = has_next ? gA + (size_t)nxt.pm * tstepA : cA; const char* nB = has_next ? S.bptr(nxt) : cB;
        for (int t = 0; t < nt; t += 2) {
            const bool last = (t == nt - 2);
            const char* a1 = cA + (size_t)(t + 1) * kstep;
            const char* a2 = last ? nA : cA + (size_t)(t + 2) * kstep; const char* b2 = last ? nB : cB + (size_t)(t + 2) * kstep;
            const char* a3 = a2 + kstep; const char* b3 = b2 + kstep;
            unsigned s00 = o00, s01 = o01, s10 = o10, s11 = o11;
            if constexpr (GATHER) { if (last && has_next) { s00 = S.arow(nxt, R0) * lda2 + (unsigned)(C0 * 2); s01 = S.arow(nxt, R1) * lda2 + (unsigned)(C1 * 2); s10 = S.arow(nxt, 128 + R0) * lda2 + (unsigned)(C0 * 2); s11 = S.arow(nxt, 128 + R1) * lda2 + (unsigned)(C1 * 2); } }
            PG8_LDB(B0, 0, 0); PG8_LDB(B1, 0, 1); PG8_SCHED; PG8_LDA(At, 0, 0); PG8_STAGE(PG8_SA(1, 1), a1 + hstepA, o10, o11);
            PG8_WAIT_V(8); PG8_WAIT_L(0); PG8_BAR; PG8_MMA(0, 0, At, B0); PG8_MMA(0, 1, At, B1); PG8_BAR; PG8_SCHED;
            PG8_LDA(At, 0, 1); PG8_STAGE(PG8_SB(0, 0), b2, vb0, vb1); PG8_STAGE(PG8_SB(0, 1), b2 + hstepB, vb0, vb1); PG8_STAGE(PG8_SA(0, 0), a2, s00, s01);
            PG8_WAIT_V(8); PG8_WAIT_L(0); PG8_BAR; PG8_MMA(1, 0, At, B0); PG8_MMA(1, 1, At, B1); PG8_BAR; PG8_SCHED;
            PG8_LDB(B0, 1, 0); PG8_LDB(B1, 1, 1); PG8_SCHED; PG8_LDA(At, 1, 0); PG8_STAGE(PG8_SA(0, 1), a2 + hstepA, s10, s11);
            PG8_WAIT_V(8); PG8_WAIT_L(0); PG8_BAR; PG8_MMA(0, 0, At, B0); PG8_MMA(0, 1, At, B1); PG8_BAR; PG8_SCHED;
            PG8_LDA(At, 1, 1); PG8_STAGE(PG8_SB(1, 0), b3, vb0, vb1); PG8_STAGE(PG8_SB(1, 1), b3 + hstepB, vb0, vb1); PG8_STAGE(PG8_SA(1, 0), a3, s00, s01);
            PG8_WAIT_V(8); PG8_WAIT_L(0); PG8_BAR; PG8_MMA(1, 0, At, B0); PG8_MMA(1, 1, At, B1); PG8_BAR; PG8_SCHED;
        }
        if (wr == 0) PG8_BAR;
        { const int t2 = opaque_tid(), w2 = __builtin_amdgcn_readfirstlane(t2 >> 6); E(acc, cur, w2 >> 2, w2 & 3, t2 & 15, (t2 & 63) >> 4); }
        if (!has_next) break;
#pragma unroll
        for (int a = 0; a < 2; ++a)
#pragma unroll
            for (int b = 0; b < 2; ++b)
#pragma unroll
                for (int m = 0; m < 4; ++m)
#pragma unroll
                    for (int n = 0; n < 2; ++n) acc[a][b][m][n] = (f32x4){0.f, 0.f, 0.f, 0.f};
        cur = nxt; cA = nA; cB = nB; ++ui;
        if constexpr (GATHER) { o00 = S.arow(cur, R0) * lda2 + (unsigned)(C0 * 2); o01 = S.arow(cur, R1) * lda2 + (unsigned)(C1 * 2); o10 = S.arow(cur, 128 + R0) * lda2 + (unsigned)(C0 * 2); o11 = S.arow(cur, 128 + R1) * lda2 + (unsigned)(C1 * 2); }
        if (wr == 1) PG8_BAR;
    }
    PG8_WAIT_V(0);
    PG8_BAR;
#undef PG8_SA
#undef PG8_SB
#undef PG8_STAGE
#undef PG8_LDA
#undef PG8_LDB
#undef PG8_MMA
#undef PG8_WAIT_V
#undef PG8_WAIT_L
#undef PG8_BAR
#undef PG8_SCHED
}
}

typedef const f32x4 (&AccRef)[2][2][4][2];
#define EPI_ROW(u, ai, m) ((u).pm * 256 + (ai) * 128 + wr * 64 + (m) * 16 + fr)
#define EPI_COL(bj, n) ((bj) * 128 + wc * 32 + (n) * 16 + 4 * fq)

struct EpiInProj {
    bf16_t *Q, *K, *V, *QKM, *VM, *OMS, *GA, *GB; float* GATES; const float* b_gates; const f32x2* rope; unsigned* mstab;
    __device__ __forceinline__ void operator()(AccRef acc, const pg8::Unit& u, int wr, int wc, int fr, int fq) const {
        const int b = u.pm / 65, tile = u.pm % 65; const bool is_ctx = (tile == 64);
        if (u.pn == 32) {
            if (wc != 0) return;
            const f32x4 bg = *(const f32x4*)(b_gates + 4 * fq);
            f32x4 mx = (f32x4){0.f, 0.f, 0.f, 0.f};
#pragma unroll
            for (int ai = 0; ai < 2; ++ai)
#pragma unroll
                for (int m = 0; m < 4; ++m) { const f32x4 g = acc[ai][0][m][0] + bg; *(f32x4*)(GATES + (size_t)EPI_ROW(u, ai, m) * 16 + 4 * fq) = g;
                    mx.x = fmaxf(mx.x, g.x); mx.y = fmaxf(mx.y, g.y); mx.z = fmaxf(mx.z, g.z); mx.w = fmaxf(mx.w, g.w); }
#pragma unroll
            for (int o = 1; o < 16; o <<= 1) { mx.x = fmaxf(mx.x, __shfl_xor(mx.x, o)); mx.y = fmaxf(mx.y, __shfl_xor(mx.y, o)); mx.z = fmaxf(mx.z, __shfl_xor(mx.z, o)); mx.w = fmaxf(mx.w, __shfl_xor(mx.w, o)); }
            if (fr == 0 && (fq == 0 || fq == 2)) { const int dir = fq >> 1;
                atomicMax(mstab + (b * 4 + 0) * 2 + dir, __float_as_uint(mx.x)); atomicMax(mstab + (b * 4 + 1) * 2 + dir, __float_as_uint(mx.y));
                atomicMax(mstab + (b * 4 + 2) * 2 + dir, __float_as_uint(mx.z)); atomicMax(mstab + (b * 4 + 3) * 2 + dir, __float_as_uint(mx.w)); }
            return;
        }
        const int grp = u.pn >> 2, cbase = (u.pn & 3) * 256;
        bf16_t* dst = grp == 0 ? Q : grp == 1 ? K : grp == 2 ? V : grp == 3 ? QKM : grp == 4 ? VM : grp == 5 ? OMS : grp == 6 ? GA : GB;
        if (grp <= 1 && !is_ctx) {
            const bool colrot = (wc & 1) != 0;
#pragma unroll
            for (int ai = 0; ai < 2; ++ai)
#pragma unroll
                for (int m = 0; m < 4; ++m) { const int row = EPI_ROW(u, ai, m); const int t = tile * 256 + ai * 128 + wr * 64 + m * 16 + fr;
                    const int pos = colrot ? (t & 63) : (t >> 6);
                    const f32x4 cs0 = *(const f32x4*)(rope + pos * 16 + 4 * fq), cs1 = *(const f32x4*)(rope + pos * 16 + 4 * fq + 2);
                    const f32x4 cv = (f32x4){cs0.x, cs0.z, cs1.x, cs1.z}, sv = (f32x4){cs0.y, cs0.w, cs1.y, cs1.w};
#pragma unroll
                    for (int bj = 0; bj < 2; ++bj) { const f32x4 x0 = acc[ai][bj][m][0], x1 = acc[ai][bj][m][1];
                        const f32x4 o0 = x0 * cv - x1 * sv, o1 = x1 * cv + x0 * sv;
                        bf16_t* p = dst + (size_t)row * 1024 + cbase + EPI_COL(bj, 0);
                        *(u32x2*)p = pk4(o0); *(u32x2*)(p + 16) = pk4(o1); } }
            return;
        }
        const bool sig = grp >= 5;
#pragma unroll
        for (int ai = 0; ai < 2; ++ai)
#pragma unroll
            for (int m = 0; m < 4; ++m) { const int row = EPI_ROW(u, ai, m);
#pragma unroll
                for (int bj = 0; bj < 2; ++bj)
#pragma unroll
                    for (int n = 0; n < 2; ++n) { f32x4 v = acc[ai][bj][m][n];
                        if (sig) { v.x = sigmoidf_(v.x); v.y = sigmoidf_(v.y); v.z = sigmoidf_(v.z); v.w = sigmoidf_(v.w); }
                        *(u32x2*)(dst + (size_t)row * 1024 + cbase + EPI_COL(bj, n)) = pk4(v); } }
    }
};
struct EpiGate1 {
    const bf16_t* G; bf16_t* O;
    __device__ __forceinline__ void operator()(AccRef acc, const pg8::Unit& u, int wr, int wc, int fr, int fq) const {
#pragma unroll
        for (int ai = 0; ai < 2; ++ai)
#pragma unroll
            for (int m = 0; m < 4; ++m) { const size_t ro = (size_t)EPI_ROW(u, ai, m) * 1024 + u.pn * 256;
#pragma unroll
                for (int bj = 0; bj < 2; ++bj)
#pragma unroll
                    for (int n = 0; n < 2; ++n) { const size_t o = ro + EPI_COL(bj, n); const f32x4 g = unpk4(*(const u32x2*)(G + o)); *(u32x2*)(O + o) = pk4(g * acc[ai][bj][m][n]); } }
    }
};
struct EpiGate2 {
    const bf16_t* G; const bf16_t* T1; bf16_t* O;
    __device__ __forceinline__ void operator()(AccRef acc, const pg8::Unit& u, int wr, int wc, int fr, int fq) const {
#pragma unroll
        for (int ai = 0; ai < 2; ++ai)
#pragma unroll
            for (int m = 0; m < 4; ++m) { const size_t ro = (size_t)EPI_ROW(u, ai, m) * 1024 + u.pn * 256;
#pragma unroll
                for (int bj = 0; bj < 2; ++bj)
#pragma unroll
                    for (int n = 0; n < 2; ++n) { const size_t o = ro + EPI_COL(bj, n); const f32x4 g = unpk4(*(const u32x2*)(G + o)), t = unpk4(*(const u32x2*)(T1 + o)); *(u32x2*)(O + o) = pk4(t + g * acc[ai][bj][m][n]); } }
    }
};
struct XSrc {
    const float* x; const float* ctx; const float* xcur; int layer;
    __device__ __forceinline__ const float* row(int r) const {
        if (layer) return xcur + (size_t)r * 1024;
        const int b = r / TPB, t = r % TPB;
        return t < SEQ ? x + ((size_t)b * SEQ + t) * 1024 : ctx + ((size_t)b * CTX + (t - SEQ)) * 1024;
    }
};
struct EpiOut {
    XSrc xs; const float* modv  ; float* R;
    __device__ __forceinline__ void operator()(AccRef acc, const pg8::Unit& u, int wr, int wc, int fr, int fq) const {
        const int b = u.pm / 65, set = (u.pm % 65 == 64) ? 2 : b; const float* gate = modv + set * 6144 + 2 * 1024 + u.pn * 256;
#pragma unroll
        for (int ai = 0; ai < 2; ++ai)
#pragma unroll
            for (int m = 0; m < 4; ++m) { const int row = EPI_ROW(u, ai, m); const float* xr = xs.row(row) + u.pn * 256; float* rr = R + (size_t)row * 1024 + u.pn * 256;
#pragma unroll
                for (int bj = 0; bj < 2; ++bj)
#pragma unroll
                    for (int n = 0; n < 2; ++n) { const int c = EPI_COL(bj, n); const f32x4 xv = *(const f32x4*)(xr + c), g = *(const f32x4*)(gate + c); *(f32x4*)(rr + c) = xv * ALPHA_RES + g * acc[ai][bj][m][n]; } }
    }
};
struct EpiLogits {
    float* O;
    __device__ __forceinline__ void operator()(AccRef acc, const pg8::Unit& u, int wr, int wc, int fr, int fq) const {
#pragma unroll
        for (int ai = 0; ai < 2; ++ai)
#pragma unroll
            for (int m = 0; m < 4; ++m) { float* rr = O + (size_t)EPI_ROW(u, ai, m) * 256;
#pragma unroll
                for (int bj = 0; bj < 2; ++bj)
#pragma unroll
                    for (int n = 0; n < 2; ++n) *(f32x4*)(rr + EPI_COL(bj, n)) = acc[ai][bj][m][n]; }
    }
};
struct EpiSwiglu {
    bf16_t* HE;
    __device__ __forceinline__ void operator()(AccRef acc, const pg8::Unit& u, int wr, int wc, int fr, int fq) const {
#pragma unroll
        for (int ai = 0; ai < 2; ++ai)
#pragma unroll
            for (int m = 0; m < 4; ++m) { bf16_t* rr = HE + (size_t)EPI_ROW(u, ai, m) * 256 + u.pn * 128;
#pragma unroll
                for (int n = 0; n < 2; ++n) { const f32x4 a = acc[ai][0][m][n], g = acc[ai][1][m][n];
                    f32x4 o; o.x = siluf_(a.x) * g.x; o.y = siluf_(a.y) * g.y; o.z = siluf_(a.z) * g.z; o.w = siluf_(a.w) * g.w;
                    *(u32x2*)(rr + EPI_COL(0, n)) = pk4(o); } }
    }
};
struct EpiScaleRow {
    bf16_t* YB; const float* roww;
    __device__ __forceinline__ void operator()(AccRef acc, const pg8::Unit& u, int wr, int wc, int fr, int fq) const {
#pragma unroll
        for (int ai = 0; ai < 2; ++ai)
#pragma unroll
            for (int m = 0; m < 4; ++m) { const int row = EPI_ROW(u, ai, m); const float w = roww[row]; bf16_t* rr = YB + (size_t)row * 1024 + u.pn * 256;
#pragma unroll
                for (int bj = 0; bj < 2; ++bj)
#pragma unroll
                    for (int n = 0; n < 2; ++n) *(u32x2*)(rr + EPI_COL(bj, n)) = pk4(acc[ai][bj][m][n] * w);
                asm volatile("" ::: "memory"); }
    }
};

namespace att {
constexpr int QBLK = 32, KVBLK = 64, LDX = 1024;
constexpr float SCALE = 0.125f, THR = 8.f;
constexpr size_t SHM_V = KVBLK * 128 * 2, SHM_K = KVBLK * 64 * 2, SHM_ATTN = 2 * SHM_V + 2 * SHM_K + NWAVES * 64 * 4;
#define KSWZ64(row, colB) ((row) * 128 + ((colB) ^ ((((row) >> 1) & 7) << 4)))
#define SBAR() __builtin_amdgcn_sched_barrier(0)
__device__ __forceinline__ int crow(int r, int hi) { return (r & 3) + 8 * (r >> 2) + 4 * hi; }
__device__ __forceinline__ unsigned cvtpk(float lo, float hi) { unsigned r; asm volatile("v_cvt_pk_bf16_f32 %0, %1, %2" : "=v"(r) : "v"(lo), "v"(hi)); return r; }
__device__ __forceinline__ void partialSM(f32x16& p0, f32x16& p1, float& m_reg, float& mn, float& alpha) {
  constexpr float C = SCALE * 1.4426950408889634f;
  float pmax = p0[0];
#pragma unroll
  for (int r = 1; r < 16; ++r) pmax = fmaxf(pmax, p0[r]);
#pragma unroll
  for (int r = 0; r < 16; ++r) pmax = fmaxf(pmax, p1[r]);
  { auto rr = __builtin_amdgcn_permlane32_swap(__float_as_uint(pmax), __float_as_uint(pmax), false, false);
    pmax = fmaxf(__uint_as_float(rr[0]), __uint_as_float(rr[1])); }
  if (__builtin_expect(__all(pmax - m_reg <= THR / SCALE), 1)) { mn = m_reg; alpha = 1.f; }
  else { mn = fmaxf(m_reg, pmax); alpha = __builtin_amdgcn_exp2f((m_reg - mn) * C); m_reg = mn; }
  float mnC = -mn * C;
#pragma unroll
  for (int r = 0; r < 16; ++r) p0[r] = fmaf(p0[r], C, mnC);
#pragma unroll
  for (int r = 0; r < 16; ++r) p1[r] = fmaf(p1[r], C, mnC);
#pragma unroll
  for (int r = 0; r < 16; ++r) p0[r] = __builtin_amdgcn_exp2f(p0[r]);
}
__device__ __forceinline__ void finishSM(f32x16& p0, f32x16& p1, float alpha, float& l_reg, bf16x8& pa0, bf16x8& pa1, bf16x8& pa2, bf16x8& pa3) {
#pragma unroll
  for (int r = 0; r < 16; ++r) p1[r] = __builtin_amdgcn_exp2f(p1[r]);
  float ps = 0;
#pragma unroll
  for (int r = 0; r < 16; ++r) ps += p0[r];
#pragma unroll
  for (int r = 0; r < 16; ++r) ps += p1[r];
  { auto rr = __builtin_amdgcn_permlane32_swap(__float_as_uint(ps), __float_as_uint(ps), false, false);
    ps = __uint_as_float(rr[0]) + __uint_as_float(rr[1]); }
  l_reg = l_reg * alpha + ps;
#define PK4(P, BASE, OUT) do { unsigned a0 = cvtpk(P[BASE + 0], P[BASE + 1]), a1 = cvtpk(P[BASE + 2], P[BASE + 3]);   \
    unsigned b0 = cvtpk(P[BASE + 4], P[BASE + 5]), b1 = cvtpk(P[BASE + 6], P[BASE + 7]);                              \
    auto r0 = __builtin_amdgcn_permlane32_swap(a0, b0, false, false); auto r1 = __builtin_amdgcn_permlane32_swap(a1, b1, false, false); \
    u32x4 w = {r0[0], r1[0], r0[1], r1[1]}; OUT = *reinterpret_cast<bf16x8*>(&w); } while (0)
  PK4(p0, 0, pa0); PK4(p0, 8, pa1); PK4(p1, 0, pa2); PK4(p1, 8, pa3);
#undef PK4
}
__device__ __forceinline__ void qkt(f32x16& p0, f32x16& p1, const char* Ks, const bf16x8* qr, int r32, int hi) {
  p0 = f32x16{}; p1 = f32x16{};
#pragma unroll
  for (int d0 = 0; d0 < 4; ++d0) { const int cb = (d0 * 16 + hi * 8) * 2;
    bf16x8 b0 = *reinterpret_cast<const bf16x8*>(Ks + KSWZ64(r32, cb));
    bf16x8 b1 = *reinterpret_cast<const bf16x8*>(Ks + KSWZ64(32 + r32, cb));
    p0 = __builtin_amdgcn_mfma_f32_32x32x16_bf16(b0, qr[d0], p0, 0, 0, 0);
    p1 = __builtin_amdgcn_mfma_f32_32x32x16_bf16(b1, qr[d0], p1, 0, 0, 0); }
}
__device__ __forceinline__ int v_st(int k, int c) { const int kk = (k & ~0xC) | ((k & 4) << 1) | ((k & 8) >> 1); return ((kk >> 3) * 4 + (c >> 5)) * 512 + ((kk & 7) * 32 + (c & 31)) * 2; }
__device__ __forceinline__ int v_rd_base(int lane) { return ((lane & 3) << 3) | (((lane >> 2) & 3) << 6) | (((lane >> 4) & 1) << 5) | (((lane >> 5) & 1) << 8); }
constexpr int v_rd_off(int d0, int ks, int half) { return d0 * 512 + ks * 4096 + half * 2048; }
template <int OFF> __device__ __forceinline__ s16x4 tr_read(int vb) {
  s16x4 r; asm volatile("ds_read_b64_tr_b16 %0, %1 offset:%2" : "=&v"(r) : "v"(vb), "i"(OFF) : "memory"); return r;
}
template <int D0> __device__ __forceinline__ void pv_one(f32x16& od, int vb, bf16x8 pa0, bf16x8 pa1, bf16x8 pa2, bf16x8 pa3) {
  const s16x4 l0 = tr_read<v_rd_off(D0, 0, 0)>(vb), h0 = tr_read<v_rd_off(D0, 0, 1)>(vb), l1 = tr_read<v_rd_off(D0, 1, 0)>(vb), h1 = tr_read<v_rd_off(D0, 1, 1)>(vb);
  const s16x4 l2 = tr_read<v_rd_off(D0, 2, 0)>(vb), h2 = tr_read<v_rd_off(D0, 2, 1)>(vb), l3 = tr_read<v_rd_off(D0, 3, 0)>(vb), h3 = tr_read<v_rd_off(D0, 3, 1)>(vb);
  asm volatile("s_waitcnt lgkmcnt(0)" ::: "memory"); SBAR();
#define PK(L, H) (bf16x8){L[0], L[1], L[2], L[3], H[0], H[1], H[2], H[3]}
  od = __builtin_amdgcn_mfma_f32_32x32x16_bf16(pa0, PK(l0, h0), od, 0, 0, 0);
  od = __builtin_amdgcn_mfma_f32_32x32x16_bf16(pa1, PK(l1, h1), od, 0, 0, 0);
  od = __builtin_amdgcn_mfma_f32_32x32x16_bf16(pa2, PK(l2, h2), od, 0, 0, 0);
  od = __builtin_amdgcn_mfma_f32_32x32x16_bf16(pa3, PK(l3, h3), od, 0, 0, 0);
#undef PK
}
__device__ __forceinline__ void pv_d0(f32x16* o, int vb, bf16x8 pa0, bf16x8 pa1, bf16x8 pa2, bf16x8 pa3) {
  pv_one<0>(o[0], vb, pa0, pa1, pa2, pa3); pv_one<1>(o[1], vb, pa0, pa1, pa2, pa3); pv_one<2>(o[2], vb, pa0, pa1, pa2, pa3); pv_one<3>(o[3], vb, pa0, pa1, pa2, pa3);
}
__device__ __forceinline__ void attn_body(const bf16_t* __restrict__ Qb, const bf16_t* __restrict__ Kh, const bf16_t* __restrict__ Vh, bf16_t* __restrict__ Ob, int seq, char* lds) {
  const int tid = opaque_tid(), wid = tid >> 6, lane = tid & 63, r32 = lane & 31, hi = lane >> 5;
  char* V_lds = lds; char* K_lds = lds + 2 * SHM_V;
  float* ws = (float*)(lds + 2 * SHM_V + 2 * SHM_K) + wid * 64; float* li_l = ws; float* al_l = ws + 32;
  float m_reg = -1e30f, l_reg = 0; f32x16 o[4] = {}; bf16x8 qr[4];
  const bf16_t* Qw = Qb + (long)(wid * QBLK + r32) * LDX + hi * 8;
#pragma unroll
  for (int d0 = 0; d0 < 4; ++d0) qr[d0] = *reinterpret_cast<const bf16x8*>(Qw + d0 * 16);
  const int sr = tid >> 4, sc = (tid & 15) * 8, vst0 = v_st(sr, sc), vst1 = v_st(32 + sr, sc);
  const int kr = tid >> 3, kc = (tid & 7) * 8, kst = KSWZ64(kr, kc * 2);
  const int vb0 = (int)(uintptr_t)V_lds + v_rd_base(lane);
  struct { bf16x8 vs0, vs1, ks0; } sr_[2];
#define SLOAD(i, k0) do { sr_[i].vs0 = *reinterpret_cast<const bf16x8*>(&Vh[(long)((k0) + sr) * LDX + sc]); sr_[i].vs1 = *reinterpret_cast<const bf16x8*>(&Vh[(long)((k0) + 32 + sr) * LDX + sc]); \
    sr_[i].ks0 = *reinterpret_cast<const bf16x8*>(&Kh[(long)((k0) + kr) * LDX + kc]); } while (0)
#define SWRITE(b, i) do { *(bf16x8*)(V_lds + (b) * SHM_V + vst0) = sr_[i].vs0; *(bf16x8*)(V_lds + (b) * SHM_V + vst1) = sr_[i].vs1; \
    *(bf16x8*)(K_lds + (b) * SHM_K + kst) = sr_[i].ks0; } while (0)
#define SWAIT() asm volatile("s_waitcnt vmcnt(3)" ::: "memory")
#define RESC(a) do { if (__any((a) < 1.f)) { if (hi == 0) al_l[r32] = (a); asm volatile("s_waitcnt lgkmcnt(0)" ::: "memory"); \
    _Pragma("unroll") for (int d = 0; d < 4; ++d) _Pragma("unroll") for (int r = 0; r < 16; ++r) o[d][r] *= al_l[crow(r, hi)]; } } while (0)
  f32x16 pA0, pA1, pB0, pB1; float mnA, mnB, alA, alB; bf16x8 pa0, pa1, pa2, pa3; const int NT = seq / KVBLK;
  constexpr int SE = 0, SO = 1;
  SLOAD(SE, 0); asm volatile("s_waitcnt vmcnt(0)" ::: "memory"); SWRITE(0, SE); __syncthreads();
  qkt(pA0, pA1, K_lds, qr, r32, hi); partialSM(pA0, pA1, m_reg, mnA, alA);
  SLOAD(SO, KVBLK); if (2 < NT) SLOAD(SE, 2 * KVBLK);
  SWAIT(); SWRITE(1, SO); __syncthreads();
  for (int j = 1; j + 1 < NT; j += 2) {
    SBAR(); qkt(pB0, pB1, K_lds + SHM_K, qr, r32, hi);
    finishSM(pA0, pA1, alA, l_reg, pa0, pa1, pa2, pa3); SBAR();
    SLOAD(SO, (j + 2) * KVBLK); SBAR();
    pv_d0(o, vb0, pa0, pa1, pa2, pa3); partialSM(pB0, pB1, m_reg, mnB, alB);
    __syncthreads(); SWAIT(); SWRITE(0, SE);
    RESC(alB); __syncthreads();
    SBAR(); qkt(pA0, pA1, K_lds, qr, r32, hi);
    finishSM(pB0, pB1, alB, l_reg, pa0, pa1, pa2, pa3); SBAR();
    if (j + 3 < NT) SLOAD(SE, (j + 3) * KVBLK); SBAR();
    pv_d0(o, vb0 + (int)SHM_V, pa0, pa1, pa2, pa3); partialSM(pA0, pA1, m_reg, mnA, alA);
    __syncthreads(); SWAIT(); SWRITE(1, SO);
    RESC(alA); __syncthreads();
  }
  SBAR(); qkt(pB0, pB1, K_lds + SHM_K, qr, r32, hi);
  finishSM(pA0, pA1, alA, l_reg, pa0, pa1, pa2, pa3); SBAR();
  pv_d0(o, vb0, pa0, pa1, pa2, pa3); partialSM(pB0, pB1, m_reg, mnB, alB);
  __syncthreads(); RESC(alB);
  finishSM(pB0, pB1, alB, l_reg, pa0, pa1, pa2, pa3); SBAR();
  pv_d0(o, vb0 + (int)SHM_V, pa0, pa1, pa2, pa3);
  if (hi == 0) li_l[r32] = l_reg; asm volatile("s_waitcnt lgkmcnt(0)" ::: "memory");
  float rli[16];
#pragma unroll
  for (int r = 0; r < 16; ++r) rli[r] = __builtin_amdgcn_rcpf(li_l[crow(r, hi)]);
  bf16_t* Ow = Ob + (long)(wid * QBLK) * 2048;
#pragma unroll
  for (int r = 0; r < 16; ++r) { const int orow = crow(r, hi);
#pragma unroll
    for (int d0 = 0; d0 < 4; ++d0) Ow[(long)orow * 2048 + d0 * 32 + r32] = (bf16_t)f2bf(o[d0][r] * rli[r]); }
  __syncthreads();
#undef SLOAD
#undef SWRITE
#undef SWAIT
#undef RESC
}
#undef SBAR
}

__device__ __forceinline__ int pos_f(int jb) { return jb < 256 ? 4 + jb : jb - 256; }
__device__ __forceinline__ int pos_b(int jb) { return jb < 256 ? 4 + 255 - jb : 3 - (jb - 256); }
constexpr int KP = 72;
constexpr int QP = 136;
__device__ __forceinline__ bf16x8 lds_frag(const LAS unsigned char* base, int row, int pitch, int col) { return *(const LAS bf16x8*)(base + ((size_t)row * pitch + col) * 2); }

__device__ __forceinline__ void conv_silu8(u32x4 xm, u32x4 x0, u32x4 xp, const float* cw  , float scale, float (&o)[8]) {
    const f32x4 w0a = *(const f32x4*)(cw), w0b = *(const f32x4*)(cw + 4), w1a = *(const f32x4*)(cw + 1024), w1b = *(const f32x4*)(cw + 1028), w2a = *(const f32x4*)(cw + 2048), w2b = *(const f32x4*)(cw + 2052);
    const float w0[8] = {w0a.x, w0a.y, w0a.z, w0a.w, w0b.x, w0b.y, w0b.z, w0b.w}, w1[8] = {w1a.x, w1a.y, w1a.z, w1a.w, w1b.x, w1b.y, w1b.z, w1b.w}, w2[8] = {w2a.x, w2a.y, w2a.z, w2a.w, w2b.x, w2b.y, w2b.z, w2b.w};
    const unsigned am[4] = {xm.x, xm.y, xm.z, xm.w}, a0[4] = {x0.x, x0.y, x0.z, x0.w}, ap[4] = {xp.x, xp.y, xp.z, xp.w};
#pragma unroll
    for (int e = 0; e < 8; ++e) { const unsigned sh = (e & 1) * 16;
        const float vm = bf2f((am[e >> 1] >> sh) & 0xffffu), v0 = bf2f((a0[e >> 1] >> sh) & 0xffffu), vp = bf2f((ap[e >> 1] >> sh) & 0xffffu);
        o[e] = siluf_(vm * w0[e] + v0 * w1[e] + vp * w2[e]) * scale; }
}

struct MlstmArgs { const bf16_t* QKM; const bf16_t* VM; const bf16_t* OMS; const float* GATES; const float* conv; const float* norm_m; const unsigned* mstab;
                   bf16_t* ST; float* NU; float* ADEC; bf16_t* HM; };

__device__ __forceinline__ void mlstm_gates(const MlstmArgs& A, int bh, int row0, int lane, float& bfv, float& bbv, float& ifm, float& ibm, float& bend_f, float& bend_b) {
    const f32x4 g0 = *(const f32x4*)(A.GATES + (size_t)(row0 + lane) * 16), g1 = *(const f32x4*)(A.GATES + (size_t)(row0 + lane) * 16 + 4),
                g2 = *(const f32x4*)(A.GATES + (size_t)(row0 + lane) * 16 + 8), g3 = *(const f32x4*)(A.GATES + (size_t)(row0 + lane) * 16 + 12);
    const int h = bh & 3;
    const float i_f = h == 0 ? g0.x : h == 1 ? g0.y : h == 2 ? g0.z : g0.w, f_f = h == 0 ? g1.x : h == 1 ? g1.y : h == 2 ? g1.z : g1.w;
    const float i_b = h == 0 ? g2.x : h == 1 ? g2.y : h == 2 ? g2.z : g2.w, f_b = h == 0 ? g3.x : h == 1 ? g3.y : h == 2 ? g3.z : g3.w;
    float inc = logsigf_(f_f), suf = logsigf_(f_b);
#pragma unroll
    for (int o = 1; o < 64; o <<= 1) { const float t = __shfl_up(inc, o); if (lane >= o) inc += t; }
#pragma unroll
    for (int o = 1; o < 64; o <<= 1) { const float t = __shfl_down(suf, o); if (lane + o < 64) suf += t; }
    bend_f = __shfl(inc, 63); bend_b = __shfl(suf, 0);
    const float Mf = __uint_as_float(A.mstab[bh * 2 + 0]), Mb = __uint_as_float(A.mstab[bh * 2 + 1]);
    bfv = inc; bbv = suf; ifm = i_f - Mf; ibm = i_b - Mb;
}
__device__ __forceinline__ void mlstm_stage_vt(const MlstmArgs& A, int h, int row0, LAS unsigned char* VT, int tid) {
#pragma unroll
    for (int i = 0; i < 4; ++i) { const int p = tid + 512 * i, s = p & 63, ec = p >> 6;
        const u32x4 v = *(const u32x4*)(A.VM + (size_t)(row0 + s) * 1024 + h * 256 + ec * 8);
        const unsigned a[4] = {v.x, v.y, v.z, v.w};
#pragma unroll
        for (int e = 0; e < 8; ++e) *(LAS bf16_t*)(VT + ((size_t)(ec * 8 + e) * KP + s) * 2) = (bf16_t)((a[e >> 1] >> ((e & 1) * 16)) & 0xffffu); }
}
__device__ __forceinline__ void mlstm_load3(const bf16_t* QKM, int row0, int s, int ch, bool hasL, bool hasR, u32x4& xm, u32x4& x0, u32x4& xp) {
    const bf16_t* p = QKM + (size_t)(row0 + s) * 1024 + ch;
    x0 = *(const u32x4*)p;
    xm = (s > 0 || hasL) ? *(const u32x4*)(p - 1024) : (u32x4){0u, 0u, 0u, 0u};
    xp = (s < 63 || hasR) ? *(const u32x4*)(p + 1024) : (u32x4){0u, 0u, 0u, 0u};
}

__device__ __forceinline__ void mlstm_d1_unit(const MlstmArgs& A, int bh, int jb, LAS unsigned char* lds) {
    const int tid = opaque_tid(), lane = tid & 63, wave = __builtin_amdgcn_readfirstlane(tid >> 6), fr = lane & 15, fq = lane >> 4;
    const int b = bh >> 2, h = bh & 3, row0 = b * TPB + jb * 64;
    const bool hasL = !(jb == 0 || jb == 256), hasR = !(jb == 255 || jb == 259);
    LAS float* WF = (LAS float*)lds; LAS float* WB = WF + 64;
    LAS unsigned char* KF = lds + 512; LAS unsigned char* KB = KF + 128 * KP * 2; LAS unsigned char* VT = KB + 128 * KP * 2;
    const int cf = bh * 2, cb = bh * 2 + 1, pf = pos_f(jb), pb = pos_b(jb);
    if (wave == 0) {
        float bfv, bbv, ifm, ibm, bend_f, bend_b; mlstm_gates(A, bh, row0, lane, bfv, bbv, ifm, ibm, bend_f, bend_b);
        WF[lane] = __expf(bend_f - bfv + ifm); WB[lane] = __expf(bend_b - bbv + ibm);
        if (lane == 0) { A.ADEC[cf * NCHUNK + pf] = __expf(bend_f); A.ADEC[cb * NCHUNK + pb] = __expf(bend_b); }
    }
    __syncthreads();
#pragma unroll
    for (int i = 0; i < 2; ++i) { const int p = tid + 512 * i, s = p & 63, dc = p >> 6; const int ch = 512 + h * 128 + dc * 8;
        u32x4 xm, x0, xp; mlstm_load3(A.QKM, row0, s, ch, hasL, hasR, xm, x0, xp);
        float k[8]; conv_silu8(xm, x0, xp, A.conv + ch, 0.08838834764831845f, k);
        const float wf = WF[s], wb = WB[s];
#pragma unroll
        for (int e = 0; e < 8; ++e) { *(LAS bf16_t*)(KF + ((size_t)(dc * 8 + e) * KP + s) * 2) = (bf16_t)f2bf(k[e] * wf); *(LAS bf16_t*)(KB + ((size_t)(dc * 8 + e) * KP + s) * 2) = (bf16_t)f2bf(k[e] * wb); } }
    mlstm_stage_vt(A, h, row0, VT, tid);
    __syncthreads();
    if (tid < 256) { const int dir = tid >> 7, d = tid & 127; const LAS unsigned char* src = (dir ? KB : KF) + (size_t)d * KP * 2; float s = 0.f;
#pragma unroll 8
        for (int i = 0; i < 64; ++i) s += bf2f(*(const LAS bf16_t*)(src + i * 2));
        A.NU[((size_t)(dir ? cb : cf) * NCHUNK + (dir ? pb : pf)) * 128 + d] = s; }
#pragma unroll
    for (int dir = 0; dir < 2; ++dir) {
        const LAS unsigned char* KW = dir ? KB : KF;
        f32x4 acc[8][2];
#pragma unroll
        for (int m = 0; m < 8; ++m) { acc[m][0] = (f32x4){0.f, 0.f, 0.f, 0.f}; acc[m][1] = (f32x4){0.f, 0.f, 0.f, 0.f}; }
#pragma unroll
        for (int ks = 0; ks < 2; ++ks) {
            const bf16x8 b0 = lds_frag(VT, (2 * wave) * 16 + fr, KP, ks * 32 + fq * 8), b1 = lds_frag(VT, (2 * wave + 1) * 16 + fr, KP, ks * 32 + fq * 8);
#pragma unroll
            for (int m = 0; m < 8; ++m) { const bf16x8 a = lds_frag(KW, m * 16 + fr, KP, ks * 32 + fq * 8);
                acc[m][0] = __builtin_amdgcn_mfma_f32_16x16x32_bf16(a, b0, acc[m][0], 0, 0, 0); acc[m][1] = __builtin_amdgcn_mfma_f32_16x16x32_bf16(a, b1, acc[m][1], 0, 0, 0); } }
        bf16_t* dst = A.ST + ((size_t)(dir ? cb : cf) * NCHUNK + (dir ? pb : pf)) * 32768;
#pragma unroll
        for (int m = 0; m < 8; ++m)
#pragma unroll
            for (int n = 0; n < 2; ++n) { const int e = (2 * wave + n) * 16 + fr, d0 = m * 16 + fq * 4; *(u32x2*)(dst + (size_t)e * 128 + d0) = pk4(acc[m][n]); }
    }
    __syncthreads();
}

__device__ __forceinline__ void mlstm_scan(const MlstmArgs& A, int gtid, int nthreads) {
    for (int it = gtid; it < NCHAIN * 8192; it += nthreads) {
        const int chain = it >> 13, e4 = (it & 8191) * 4; bf16_t* p = A.ST + (size_t)chain * NCHUNK * 32768 + e4; const float* ad = A.ADEC + chain * NCHUNK;
        f32x4 s = (f32x4){0.f, 0.f, 0.f, 0.f};
#pragma unroll 4
        for (int c = 0; c < NCHUNK; ++c) { const f32x4 u = unpk4(*(const u32x2*)(p + (size_t)c * 32768)); *(u32x2*)(p + (size_t)c * 32768) = pk4(s); s = s * ad[c] + u; }
    }
    for (int it = gtid; it < NCHAIN * 128; it += nthreads) {
        const int chain = it >> 7, d = it & 127; float* p = A.NU + (size_t)chain * NCHUNK * 128 + d; const float* ad = A.ADEC + chain * NCHUNK; float s = 0.f;
        for (int c = 0; c < NCHUNK; ++c) { const float u = p[c * 128]; p[c * 128] = s; s = s * ad[c] + u; }
    }
}

constexpr int D3_G = 0, D3_Q = 4096, D3_QF = D3_Q + 64 * QP * 2, D3_QB = D3_QF + 64 * QP * 2, D3_KT = D3_QB + 64 * QP * 2, D3_VT = D3_KT + 64 * QP * 2, D3_PF = D3_VT + 256 * KP * 2, D3_PB = D3_PF + 64 * KP * 2, D3_END = D3_PB + 64 * KP * 2;
static_assert(D3_END <= RING_BYTES, "mLSTM D3 LDS");
__device__ __forceinline__ void mlstm_d3_unit(const MlstmArgs& A, int bh, int jb, LAS unsigned char* lds) {
    const int tid = opaque_tid(), lane = tid & 63, wave = __builtin_amdgcn_readfirstlane(tid >> 6), fr = lane & 15, fq = lane >> 4;
    const int b = bh >> 2, h = bh & 3, row0 = b * TPB + jb * 64;
    const bool hasL = !(jb == 0 || jb == 256), hasR = !(jb == 255 || jb == 259);
    LAS float* GF = (LAS float*)(lds + D3_G);
    LAS float* BF = GF, *BB = GF + 64, *IFM = GF + 128, *IBM = GF + 192, *EBF = GF + 256, *EBB = GF + 320, *DEN = GF + 384, *RS = GF + 512;
    LAS unsigned char* Qs = lds + D3_Q; LAS unsigned char* QF = lds + D3_QF; LAS unsigned char* QB = lds + D3_QB; LAS unsigned char* KT = lds + D3_KT;
    LAS unsigned char* VT = lds + D3_VT; LAS unsigned char* PF = lds + D3_PF; LAS unsigned char* PB = lds + D3_PB;
    const int cf = bh * 2, cb = bh * 2 + 1, pf = pos_f(jb), pb = pos_b(jb);
    const float Mf = __uint_as_float(A.mstab[bh * 2 + 0]), Mb = __uint_as_float(A.mstab[bh * 2 + 1]);
    if (wave == 0) {
        float bfv, bbv, ifm, ibm, bend_f, bend_b; mlstm_gates(A, bh, row0, lane, bfv, bbv, ifm, ibm, bend_f, bend_b);
        BF[lane] = bfv; BB[lane] = bbv; IFM[lane] = ifm; IBM[lane] = ibm; EBF[lane] = __expf(bfv); EBB[lane] = __expf(bbv);
    }
    __syncthreads();
#pragma unroll
    for (int i = 0; i < 4; ++i) { const int p = tid + 512 * i, s = p & 63, dc = (p >> 6) & 15, isk = p >> 10; const int ch = isk * 512 + h * 128 + dc * 8;
        u32x4 xm, x0, xp; mlstm_load3(A.QKM, row0, s, ch, hasL, hasR, xm, x0, xp);
        float v[8]; conv_silu8(xm, x0, xp, A.conv + ch, isk ? 0.08838834764831845f : 1.f, v);
        if (isk) { u32x4 w; w.x = pk2(v[0], v[1]); w.y = pk2(v[2], v[3]); w.z = pk2(v[4], v[5]); w.w = pk2(v[6], v[7]); *(LAS u32x4*)(KT + ((size_t)s * QP + dc * 8) * 2) = w; }
        else { const float ef = EBF[s], eb = EBB[s]; u32x4 w;
            w.x = pk2(v[0], v[1]); w.y = pk2(v[2], v[3]); w.z = pk2(v[4], v[5]); w.w = pk2(v[6], v[7]); *(LAS u32x4*)(Qs + ((size_t)s * QP + dc * 8) * 2) = w;
            w.x = pk2(v[0] * ef, v[1] * ef); w.y = pk2(v[2] * ef, v[3] * ef); w.z = pk2(v[4] * ef, v[5] * ef); w.w = pk2(v[6] * ef, v[7] * ef); *(LAS u32x4*)(QF + ((size_t)s * QP + dc * 8) * 2) = w;
            w.x = pk2(v[0] * eb, v[1] * eb); w.y = pk2(v[2] * eb, v[3] * eb); w.z = pk2(v[4] * eb, v[5] * eb); w.w = pk2(v[6] * eb, v[7] * eb); *(LAS u32x4*)(QB + ((size_t)s * QP + dc * 8) * 2) = w; } }
    mlstm_stage_vt(A, h, row0, VT, tid);
    __syncthreads();
    {
        const int mt = wave >> 1, nt0 = (wave & 1) * 2;
        f32x4 S0 = (f32x4){0.f, 0.f, 0.f, 0.f}, S1 = S0;
#pragma unroll
        for (int ks = 0; ks < 4; ++ks) { const bf16x8 a = lds_frag(Qs, mt * 16 + fr, QP, ks * 32 + fq * 8);
            S0 = __builtin_amdgcn_mfma_f32_16x16x32_bf16(a, lds_frag(KT, nt0 * 16 + fr, QP, ks * 32 + fq * 8), S0, 0, 0, 0);
            S1 = __builtin_amdgcn_mfma_f32_16x16x32_bf16(a, lds_frag(KT, (nt0 + 1) * 16 + fr, QP, ks * 32 + fq * 8), S1, 0, 0, 0); }
#pragma unroll
        for (int n = 0; n < 2; ++n) { const int s = (nt0 + n) * 16 + fr; const float bfs = BF[s], bbs = BB[s], ifs = IFM[s], ibs = IBM[s];
#pragma unroll
            for (int r = 0; r < 4; ++r) { const int t = mt * 16 + fq * 4 + r; const float sv = n ? S1[r] : S0[r];
                const float pf_ = (s <= t) ? sv * __expf(BF[t] - bfs + ifs) : 0.f, pb_ = (s >= t) ? sv * __expf(BB[t] - bbs + ibs) : 0.f;
                *(LAS bf16_t*)(PF + ((size_t)t * KP + s) * 2) = (bf16_t)f2bf(pf_); *(LAS bf16_t*)(PB + ((size_t)t * KP + s) * 2) = (bf16_t)f2bf(pb_); } }
    }
    __syncthreads();
    if (tid < 128) {
        const int dir = tid >> 6, t = tid & 63; const LAS unsigned char* P = (dir ? PB : PF) + (size_t)t * KP * 2; float s = 0.f;
#pragma unroll 8
        for (int i = 0; i < 64; ++i) s += bf2f(*(const LAS bf16_t*)(P + i * 2));
        const float* nprev = A.NU + ((size_t)(dir ? cb : cf) * NCHUNK + (dir ? pb : pf)) * 128; const LAS unsigned char* qrow = Qs + (size_t)t * QP * 2; float dq = 0.f;
#pragma unroll 8
        for (int d = 0; d < 128; ++d) dq += bf2f(*(const LAS bf16_t*)(qrow + d * 2)) * nprev[d];
        const float den = s + (dir ? EBB[t] : EBF[t]) * dq;
        DEN[dir * 64 + t] = fmaxf(fabsf(den), __expf(-(dir ? Mb : Mf)));
    }
    f32x4 acc[2][2][4];
#pragma unroll
    for (int dir = 0; dir < 2; ++dir) {
        const LAS unsigned char* P = dir ? PB : PF; const LAS unsigned char* QD = dir ? QB : QF;
        const bf16_t* CT = A.ST + ((size_t)(dir ? cb : cf) * NCHUNK + (dir ? pb : pf)) * 32768;
#pragma unroll
        for (int m = 0; m < 2; ++m)
#pragma unroll
            for (int n = 0; n < 4; ++n) acc[dir][m][n] = (f32x4){0.f, 0.f, 0.f, 0.f};
#pragma unroll
        for (int ks = 0; ks < 2; ++ks) {
            const bf16x8 a0 = lds_frag(VT, (2 * wave) * 16 + fr, KP, ks * 32 + fq * 8), a1 = lds_frag(VT, (2 * wave + 1) * 16 + fr, KP, ks * 32 + fq * 8);
#pragma unroll
            for (int n = 0; n < 4; ++n) { const bf16x8 bq = lds_frag(P, n * 16 + fr, KP, ks * 32 + fq * 8);
                acc[dir][0][n] = __builtin_amdgcn_mfma_f32_16x16x32_bf16(a0, bq, acc[dir][0][n], 0, 0, 0); acc[dir][1][n] = __builtin_amdgcn_mfma_f32_16x16x32_bf16(a1, bq, acc[dir][1][n], 0, 0, 0); } }
#pragma unroll
        for (int ks = 0; ks < 4; ++ks) {
            const bf16x8 a0 = *(const bf16x8*)(CT + (size_t)((2 * wave) * 16 + fr) * 128 + ks * 32 + fq * 8), a1 = *(const bf16x8*)(CT + (size_t)((2 * wave + 1) * 16 + fr) * 128 + ks * 32 + fq * 8);
#pragma unroll
            for (int n = 0; n < 4; ++n) { const bf16x8 bq = lds_frag(QD, n * 16 + fr, QP, ks * 32 + fq * 8);
                acc[dir][0][n] = __builtin_amdgcn_mfma_f32_16x16x32_bf16(a0, bq, acc[dir][0][n], 0, 0, 0); acc[dir][1][n] = __builtin_amdgcn_mfma_f32_16x16x32_bf16(a1, bq, acc[dir][1][n], 0, 0, 0); } }
    }
    __syncthreads();
    f32x4 hv[2][4];
#pragma unroll
    for (int n = 0; n < 4; ++n) { const int t = n * 16 + fr; const float rf = 1.f / DEN[t], rb = 1.f / DEN[64 + t]; float ss = 0.f;
#pragma unroll
        for (int m = 0; m < 2; ++m) { hv[m][n] = acc[0][m][n] * rf + acc[1][m][n] * rb; ss += hv[m][n].x * hv[m][n].x + hv[m][n].y * hv[m][n].y + hv[m][n].z * hv[m][n].z + hv[m][n].w * hv[m][n].w; }
        ss += __shfl_xor(ss, 16); ss += __shfl_xor(ss, 32);
        if (fq == 0) RS[wave * 64 + t] = ss; }
    __syncthreads();
#pragma unroll
    for (int n = 0; n < 4; ++n) { const int t = n * 16 + fr; float ss = 0.f;
#pragma unroll
        for (int w = 0; w < 8; ++w) ss += RS[w * 64 + t];
        const float rstd = 1.f / sqrtf(ss * (1.f / 256.f) + RMS_EPS);
#pragma unroll
        for (int m = 0; m < 2; ++m) { const int e0 = (2 * wave + m) * 16 + fq * 4; const size_t o = (size_t)(row0 + t) * 1024 + h * 256 + e0;
            const f32x4 g = *(const f32x4*)(A.norm_m + h * 256 + e0), og = unpk4(*(const u32x2*)(A.OMS + o));
            *(u32x2*)(A.HM + o) = pk4(hv[m][n] * rstd * g * og); } }
    __syncthreads();
}

__device__ __forceinline__ void tr_load(const float* W, size_t ldw, int k0, int n0, int nvalid, LAS float* scr, int lane) {
#pragma unroll 8
    for (int i = 0; i < 32; ++i) { const int kk = 2 * i + (lane >> 5), n = lane & 31; scr[kk * 33 + n] = (n < nvalid) ? W[(size_t)(k0 + kk) * ldw + n0 + n] : 0.f; }
    LDS_WAIT(); asm volatile("" ::: "memory");
}
template <int MODE  >
__device__ __forceinline__ void tr_store(bf16_t* WT, size_t ldt, int drow0, int dcol0, int nvalid, const LAS float* scr, int lane) {
    const int c = lane & 7;
#pragma unroll
    for (int j = 0; j < 4; ++j) { const int n = (lane >> 3) + 8 * j; const LAS float* s = scr + (8 * c) * 33 + n; float v[8];
#pragma unroll
        for (int e = 0; e < 8; ++e) { v[e] = s[e * 33]; if (MODE == 1) v[e] = v[e] - bf2f(f2bf(v[e])); }
        u32x4 o; o.x = pk2(v[0], v[1]); o.y = pk2(v[2], v[3]); o.z = pk2(v[4], v[5]); o.w = pk2(v[6], v[7]);
        if (n < nvalid) *(u32x4*)(WT + (size_t)(drow0 + n) * ldt + dcol0 + 8 * c) = o; }
}

struct KArgs { const float* in[25]; float* out; unsigned char* ws; int dbg; int pad; };

__device__ __forceinline__ void ln_row(f32x4 (&v)[4], const float* g, const float* bta, int lane) {
    float s = 0.f;
#pragma unroll
    for (int j = 0; j < 4; ++j) s += (v[j].x + v[j].y) + (v[j].z + v[j].w);
    const float mean = wave_sum(s) * (1.f / 1024.f); float s2 = 0.f;
#pragma unroll
    for (int j = 0; j < 4; ++j) { v[j] = v[j] - mean; s2 += (v[j].x * v[j].x + v[j].y * v[j].y) + (v[j].z * v[j].z + v[j].w * v[j].w); }
    const float rstd = 1.f / sqrtf(wave_sum(s2) * (1.f / 1024.f) + LN_EPS);
#pragma unroll
    for (int j = 0; j < 4; ++j) { const f32x4 gg = *(const f32x4*)(g + 4 * lane + 256 * j), bb = *(const f32x4*)(bta + 4 * lane + 256 * j); v[j] = v[j] * rstd * gg + bb; }
}

#define AS4 __attribute__((address_space(4)))
__device__ __forceinline__ const char AS4* kargp() { const char AS4* p = (const char AS4*)__builtin_amdgcn_kernarg_segment_ptr(); asm volatile("" : "+s"(p)); return p; }
#define INP(k) (*(const float* const AS4*)(kargp() + 8 * (k)))
#define OUTP() (*(float* const AS4*)(kargp() + 200))
#define WSB() (*(unsigned char* const AS4*)(kargp() + 208))
enum { I_X = 0, I_C, I_CTX, I_CCTX, I_ADAW, I_ADAB, I_WIN, I_BG, I_CONV, I_LAM, I_SUBLN, I_NORMM, I_WBRA, I_WBRM, I_WOUT, I_LN1G, I_LN1B, I_LN2G, I_LN2B, I_WR, I_EB, I_WEIN, I_WEOUT, I_WSIN, I_WSOUT };

__global__ void __launch_bounds__(NTHR, 2) mega_fwd(KArgs args) {
    extern __shared__ __attribute__((aligned(16))) unsigned char lds_raw[];
    LAS unsigned char* lds = (LAS unsigned char*)lds_raw;
    for (int u = threadIdx.x; u < (LDS_BYTES - MISC_OFF) / 4; u += NTHR) ((LAS unsigned*)(lds + MISC_OFF))[u] = 0u;
    __syncthreads();
    (void)xcd_barrier_post((unsigned*)(WSB() + WS_CTL) + CW_BAR, (volatile LAS unsigned*)(lds + MISC_OFF) + 8);
#define GRID_BAR() do { XcdBarrier b_; b_.bar = (unsigned*)(WSB() + WS_CTL) + CW_BAR; b_.x = xb_xcc_id(); b_.st = (volatile LAS unsigned*)(lds + MISC_OFF) + 8; xcd_barrier(b_); } while (0)
#define PHASE_LOCALS() const int tid = opaque_tid(), lane = tid & 63, wave = __builtin_amdgcn_readfirstlane(tid >> 6); int G = (int)gridDim.x; asm volatile("" : "+s"(G)); \
    const int bx = (int)blockIdx.x, vcu = (G % 8 == 0) ? (bx % 8) * (G / 8) + bx / 8 : bx, gw = vcu * NWAVES + wave, NGW = G * NWAVES; (void)tid; (void)lane; (void)wave; (void)gw; (void)NGW; (void)vcu

    if (PHM & 1) {
        PHASE_LOCALS(); unsigned char* ws = WSB();
        LAS float* scr = (LAS float*)(lds + wave * 16384);
        constexpr int IT_IN = 257 * 16;
        constexpr int IT_SQ = 32 * 16;
        constexpr int IT_RT = 8 * 16;
        constexpr int IT_E1 = 16 * 16, IT_E2 = 32 * 4;
        constexpr int IT_LAYER = IT_IN + 3 * IT_SQ + IT_RT + 257 * IT_E1 + 257 * IT_E2;
        for (int it = gw; it < 2 * IT_LAYER; it += NGW) {
            const int l = it / IT_LAYER; int r = it % IT_LAYER; unsigned char* WL = ws + WS_W0 + (size_t)l * WL_SIZE;
            if (r < IT_IN) { const int nb = r / 16, kb = r % 16; int n0, drow, nv = 32;
                if (nb < 192) { n0 = nb * 32; drow = n0; } else if (nb == 192) { n0 = 6144; drow = 8192; nv = 16; } else { n0 = 6160 + (nb - 193) * 32; drow = 6144 + (nb - 193) * 32; }
                tr_load(INP(I_WIN) + (size_t)l * 1024 * INW, INW, kb * 64, n0, nv, scr, lane); tr_store<0>((bf16_t*)(WL + WL_IN), 1024, drow, kb * 64, nv, scr, lane); continue; }
            r -= IT_IN;
            if (r < 3 * IT_SQ) { const int w = r / IT_SQ, q = r % IT_SQ, nb = q / 16, kb = q % 16; const float* src = (w == 0 ? INP(I_WBRA) : w == 1 ? INP(I_WBRM) : INP(I_WOUT)) + (size_t)l * 1024 * 1024;
                tr_load(src, 1024, kb * 64, nb * 32, 32, scr, lane); tr_store<0>((bf16_t*)(WL + (w == 0 ? WL_BRA : w == 1 ? WL_BRM : WL_OUT)), 1024, nb * 32, kb * 64, 32, scr, lane); continue; }
            r -= 3 * IT_SQ;
            if (r < IT_RT) { const int nb = r / 16, kb = r % 16; tr_load(INP(I_WR) + (size_t)l * 1024 * 256, 256, kb * 64, nb * 32, 32, scr, lane);
                bf16_t* dst = (bf16_t*)(WL + WL_R3); tr_store<0>(dst, 3072, nb * 32, kb * 64, 32, scr, lane); tr_store<0>(dst, 3072, nb * 32, 1024 + kb * 64, 32, scr, lane); tr_store<1>(dst, 3072, nb * 32, 2048 + kb * 64, 32, scr, lane); continue; }
            r -= IT_RT;
            if (r < 257 * IT_E1) { const int e = r / IT_E1, q = r % IT_E1, nb = q / 16, kb = q % 16, n0 = nb * 32;
                const float* src = e < 256 ? INP(I_WEIN) + ((size_t)l * 256 + e) * 1024 * 512 : INP(I_WSIN) + (size_t)l * 1024 * 512;
                const int isg = n0 >= 256, j0 = n0 & 255, drow = (j0 >> 7) * 256 + isg * 128 + (j0 & 127);
                tr_load(src, 512, kb * 64, n0, 32, scr, lane); tr_store<0>((bf16_t*)(WL + WL_E1) + (size_t)e * 512 * 1024, 1024, drow, kb * 64, 32, scr, lane); continue; }
            r -= 257 * IT_E1;
            { const int e = r / IT_E2, q = r % IT_E2, nb = q / 4, kb = q % 4;
                const float* src = e < 256 ? INP(I_WEOUT) + ((size_t)l * 256 + e) * 256 * 1024 : INP(I_WSOUT) + (size_t)l * 256 * 1024;
                tr_load(src, 1024, kb * 64, nb * 32, 32, scr, lane); tr_store<0>((bf16_t*)(WL + WL_E2) + (size_t)e * 1024 * 256, 256, nb * 32, kb * 64, 32, scr, lane); }
        }
        { const float* in_c = INP(I_C); const float* in_cctx = INP(I_CCTX); const float* ada_w = INP(I_ADAW); const float* ada_b = INP(I_ADAB); float* MODV = (float*)(ws + WS_MODV);
        for (int it = bx * NTHR + tid; it < 2 * 6144; it += G * NTHR) { const int l = it / 6144, j = it % 6144; const float* wcol = ada_w + (size_t)l * 1024 * 6144 + j; float a0 = 0.f, a1 = 0.f, a2 = 0.f;
#pragma unroll 4
            for (int k = 0; k < 1024; ++k) { const float w = wcol[(size_t)k * 6144]; a0 += siluf_(in_c[k]) * w; a1 += siluf_(in_c[1024 + k]) * w; a2 += siluf_(in_cctx[k]) * w; }
            const float bb = ada_b[l * 6144 + j]; MODV[(l * 3 + 0) * 6144 + j] = a0 + bb; MODV[(l * 3 + 1) * 6144 + j] = a1 + bb; MODV[(l * 3 + 2) * 6144 + j] = a2 + bb; } }
        { f32x2* ROPE = (f32x2*)(ws + WS_ROPE);
        for (int it = bx * NTHR + tid; it < 256 * 16; it += G * NTHR) { const int pos = it >> 4, i = it & 15; const float inv = powf(10000.f, -(float)i / 16.f); const float ang = (float)pos * inv; float s, c; sincosf(ang, &s, &c); ROPE[it] = (f32x2){c, s}; } }
    }
    GRID_BAR();

    for (int l = 0; l < 2; ++l) {
        if (l == 0 && (PHM & 2)) {
            PHASE_LOCALS(); unsigned char* ws = WSB(); const float* modv = (const float*)(ws + WS_MODV); bf16_t* HMOD = (bf16_t*)(ws + WS_HMOD);
            XSrc xs{INP(I_X), INP(I_CTX), (const float*)(ws + WS_XCUR), 0};
            for (int r = gw; r < MALL; r += NGW) { const int b = r / TPB, set = (r % TPB) < SEQ ? b : 2; const float* xr = xs.row(r); const float* mv = modv + set * 6144;
#pragma unroll
                for (int j = 0; j < 4; ++j) { const int c = 4 * lane + 256 * j; const f32x4 v = *(const f32x4*)(xr + c), sh = *(const f32x4*)(mv + c), sc = *(const f32x4*)(mv + 1024 + c);
                    *(u32x2*)(HMOD + (size_t)r * 1024 + c) = pk4(v * (sc + 1.f) + sh); } }
            GRID_BAR();
        }
        if (PHM & 4) {
            PHASE_LOCALS(); unsigned char* ws = WSB(); unsigned char* WL = ws + WS_W0 + (size_t)l * WL_SIZE;
            pg8::DenseOrder S; S.init(NRT, INW_PAD / 256, G, bx, WL + WL_IN, 1024);
            EpiInProj E{(bf16_t*)(ws + WS_Q), (bf16_t*)(ws + WS_K), (bf16_t*)(ws + WS_V), (bf16_t*)(ws + WS_QKM), (bf16_t*)(ws + WS_VM), (bf16_t*)(ws + WS_OMS), (bf16_t*)(ws + WS_GA), (bf16_t*)(ws + WS_GB),
                        (float*)(ws + WS_GATES), INP(I_BG) + l * 16, (const f32x2*)(ws + WS_ROPE), (unsigned*)(ws + WS_CTL) + CW_MSTAB + l * 16};
            pg8::gemm_phase(lds, (const bf16_t*)(ws + WS_HMOD), 1024, 1024, S, E);
        }
        GRID_BAR();
        if (PHM & 8) {
            PHASE_LOCALS(); unsigned char* ws = WSB();
            MlstmArgs MA{(const bf16_t*)(ws + WS_QKM), (const bf16_t*)(ws + WS_VM), (const bf16_t*)(ws + WS_OMS), (const float*)(ws + WS_GATES), INP(I_CONV) + (size_t)l * 3 * 1024, INP(I_NORMM) + l * 1024,
                         (const unsigned*)(ws + WS_CTL) + CW_MSTAB + l * 16, (bf16_t*)(ws + WS_ST), (float*)(ws + WS_NU), (float*)(ws + WS_ADEC), (bf16_t*)(ws + WS_HM)};
            for (int u = bx; u < 8 * NCHUNK; u += G) mlstm_d1_unit(MA, u / NCHUNK, u % NCHUNK, lds);
        }
        GRID_BAR();
        if (PHM & 16) {
            PHASE_LOCALS(); unsigned char* ws = WSB();
            MlstmArgs MA{nullptr, nullptr, nullptr, nullptr, nullptr, nullptr, nullptr, (bf16_t*)(ws + WS_ST), (float*)(ws + WS_NU), (float*)(ws + WS_ADEC), nullptr};
            mlstm_scan(MA, bx * NTHR + tid, G * NTHR);
        }
        GRID_BAR();
        if (PHM & 32) {
            PHASE_LOCALS(); unsigned char* ws = WSB(); const bf16_t* Qb_ = (const bf16_t*)(ws + WS_Q); const bf16_t* Kb_ = (const bf16_t*)(ws + WS_K); const bf16_t* Vb_ = (const bf16_t*)(ws + WS_V); bf16_t* OJ = (bf16_t*)(ws + WS_OJ);
            const int nun = (G == 256) ? 8 : (2048 + G - 1) / G;
            for (int r = 0; r < nun; ++r) {
                int grp, qb;
                if (G == 256) { const int xg = vcu >> 5, ii = vcu & 31; grp = xg + 8 * (r >> 1); qb = ii + 32 * (r & 1); }
                else { const int u = bx + r * G; if (u >= 2048) break; grp = u >> 6; qb = u & 63; }
                const int b = grp >> 4, h = (grp >> 1) & 7, j = grp & 1; const size_t q0 = (size_t)b * TPB + qb * 256, k0 = (size_t)b * TPB;
                att::attn_body(Qb_ + q0 * 1024 + h * 128 + j * 64, Kb_ + k0 * 1024 + h * 128 + j * 64, Vb_ + k0 * 1024 + h * 128, OJ + q0 * 2048 + h * 256 + j * 128, TPB, (char*)lds_raw);
            }
            if (l == 0) for (int u = bx; u < 32; u += G) { const int b = u >> 4, h = (u >> 1) & 7, j = u & 1; const size_t q0 = (size_t)b * TPB + SEQ;
                att::attn_body(Qb_ + q0 * 1024 + h * 128 + j * 64, Kb_ + q0 * 1024 + h * 128 + j * 64, Vb_ + q0 * 1024 + h * 128, OJ + q0 * 2048 + h * 256 + j * 128, CTX, (char*)lds_raw); }
        }
        if (PHM & 64) {
            PHASE_LOCALS(); unsigned char* ws = WSB();
            MlstmArgs MA{(const bf16_t*)(ws + WS_QKM), (const bf16_t*)(ws + WS_VM), (const bf16_t*)(ws + WS_OMS), (const float*)(ws + WS_GATES), INP(I_CONV) + (size_t)l * 3 * 1024, INP(I_NORMM) + l * 1024,
                         (const unsigned*)(ws + WS_CTL) + CW_MSTAB + l * 16, (bf16_t*)(ws + WS_ST), (float*)(ws + WS_NU), (float*)(ws + WS_ADEC), (bf16_t*)(ws + WS_HM)};
            for (int u = bx; u < 8 * NCHUNK; u += G) mlstm_d3_unit(MA, u / NCHUNK, u % NCHUNK, lds);
        }
        GRID_BAR();
        if (PHM & 128) {
            PHASE_LOCALS(); unsigned char* ws = WSB(); const bf16_t* OJ = (const bf16_t*)(ws + WS_OJ); bf16_t* OA = (bf16_t*)(ws + WS_OA);
            const float lam_init = l == 0 ? 0.2f : (0.8f - 0.6f * 0.7408182206817179f);
            const float* lm = INP(I_LAM) + l * 256;
            const float lv = __expf(wave_sum(lm[lane] * lm[64 + lane])) - __expf(wave_sum(lm[128 + lane] * lm[192 + lane])) + lam_init;
            const f32x2 sg = *(const f32x2*)(INP(I_SUBLN) + l * 128 + 2 * lane);
            for (int r = gw; r < MALL; r += NGW) {
#pragma unroll
                for (int h = 0; h < 8; ++h) { const unsigned a = *(const unsigned*)(OJ + (size_t)r * 2048 + h * 256 + 2 * lane), bq = *(const unsigned*)(OJ + (size_t)r * 2048 + h * 256 + 128 + 2 * lane);
                    const float d0 = bf2f(a & 0xffffu) - lv * bf2f(bq & 0xffffu), d1 = bf2f(a >> 16) - lv * bf2f(bq >> 16);
                    const float rstd = 1.f / sqrtf(wave_sum(d0 * d0 + d1 * d1) * (1.f / 128.f) + RMS_EPS) * (1.f - lam_init);
                    *(unsigned*)(OA + (size_t)r * 1024 + h * 128 + 2 * lane) = pk2(d0 * rstd * sg.x, d1 * rstd * sg.y); } }
        }
        GRID_BAR();
        if (PHM & 256) { PHASE_LOCALS(); unsigned char* ws = WSB(); unsigned char* WL = ws + WS_W0 + (size_t)l * WL_SIZE;
            pg8::DenseOrder S; S.init(NRT, 4, G, bx, WL + WL_BRA, 1024); EpiGate1 E{(const bf16_t*)(ws + WS_GA), (bf16_t*)(ws + WS_T1)}; pg8::gemm_phase(lds, (const bf16_t*)(ws + WS_OA), 1024, 1024, S, E); }
        GRID_BAR();
        if (PHM & 512) { PHASE_LOCALS(); unsigned char* ws = WSB(); unsigned char* WL = ws + WS_W0 + (size_t)l * WL_SIZE;
            pg8::DenseOrder S; S.init(NRT, 4, G, bx, WL + WL_BRM, 1024); EpiGate2 E{(const bf16_t*)(ws + WS_GB), (const bf16_t*)(ws + WS_T1), (bf16_t*)(ws + WS_Y)}; pg8::gemm_phase(lds, (const bf16_t*)(ws + WS_HM), 1024, 1024, S, E); }
        GRID_BAR();
        if (PHM & 1024) { PHASE_LOCALS(); unsigned char* ws = WSB(); unsigned char* WL = ws + WS_W0 + (size_t)l * WL_SIZE;
            XSrc xs{INP(I_X), INP(I_CTX), (const float*)(ws + WS_XCUR), l};
            pg8::DenseOrder S; S.init(NRT, 4, G, bx, WL + WL_OUT, 1024); EpiOut E{xs, (const float*)(ws + WS_MODV) + l * 3 * 6144, (float*)(ws + WS_R)}; pg8::gemm_phase(lds, (const bf16_t*)(ws + WS_Y), 1024, 1024, S, E); }
        GRID_BAR();
        if (PHM & 2048) {
            PHASE_LOCALS(); unsigned char* ws = WSB(); const float* modv = (const float*)(ws + WS_MODV) + l * 3 * 6144; const float* Rf = (const float*)(ws + WS_R); float* X1 = (float*)(ws + WS_X1); bf16_t* H2A = (bf16_t*)(ws + WS_H2A);
            const float* g1 = INP(I_LN1G) + l * 1024; const float* b1 = INP(I_LN1B) + l * 1024;
            for (int r = gw; r < MALL; r += NGW) { const int b = r / TPB, set = (r % TPB) < SEQ ? b : 2; const float* mv = modv + set * 6144; f32x4 v[4];
#pragma unroll
                for (int j = 0; j < 4; ++j) v[j] = *(const f32x4*)(Rf + (size_t)r * 1024 + 4 * lane + 256 * j);
                ln_row(v, g1, b1, lane);
#pragma unroll
                for (int j = 0; j < 4; ++j) { const int c = 4 * lane + 256 * j; *(f32x4*)(X1 + (size_t)r * 1024 + c) = v[j];
                    const f32x4 sh = *(const f32x4*)(mv + 3 * 1024 + c), sc = *(const f32x4*)(mv + 4 * 1024 + c); const f32x4 hh = v[j] * (sc + 1.f) + sh;
                    const u32x2 hi = pk4(hh); const f32x4 lo = hh - unpk4(hi);
                    bf16_t* o = H2A + (size_t)r * 3072 + c; *(u32x2*)o = hi; *(u32x2*)(o + 1024) = pk4(lo); *(u32x2*)(o + 2048) = hi; } }
        }
        GRID_BAR();
        if (PHM & 4096) { PHASE_LOCALS(); unsigned char* ws = WSB(); unsigned char* WL = ws + WS_W0 + (size_t)l * WL_SIZE;
            pg8::DenseOrder S; S.init(NRT, 1, G, bx, WL + WL_R3, 3072); EpiLogits E{(float*)(ws + WS_LOG)}; pg8::gemm_phase(lds, (const bf16_t*)(ws + WS_H2A), 3072, 3072, S, E); }
        GRID_BAR();
        if (PHM & 8192) {
            PHASE_LOCALS(); unsigned char* ws = WSB(); const float* LOGITS = (const float*)(ws + WS_LOG); const float* e_bias = INP(I_EB) + l * 256; unsigned* ecnt = (unsigned*)(ws + WS_CTL) + CW_CNT + l * 256;
            int* TOPI = (int*)(ws + WS_TOPI); float* TOPW = (float*)(ws + WS_TOPW); int* POS = (int*)(ws + WS_POS);
            for (int r = gw; r < MALL; r += NGW) {
                const f32x4 lg = *(const f32x4*)(LOGITS + (size_t)r * 256 + 4 * lane), eb = *(const f32x4*)(e_bias + 4 * lane);
                float sc[4] = {sigmoidf_(lg.x), sigmoidf_(lg.y), sigmoidf_(lg.z), sigmoidf_(lg.w)}; float bs[4] = {sc[0] + eb.x, sc[1] + eb.y, sc[2] + eb.z, sc[3] + eb.w};
                int myi = 0; float myw = 0.f, wsum = 0.f;
#pragma unroll
                for (int k = 0; k < 8; ++k) {
                    float bv = bs[0]; int bi = 0;
#pragma unroll
                    for (int e = 1; e < 4; ++e) if (bs[e] > bv) { bv = bs[e]; bi = e; }
                    int gi = 4 * lane + bi;
#pragma unroll
                    for (int o = 1; o < 64; o <<= 1) { const float ov = __shfl_xor(bv, o); const int oi = __shfl_xor(gi, o); if (ov > bv || (ov == bv && oi < gi)) { bv = ov; gi = oi; } }
                    const int own = gi >> 2, oe = gi & 3; float sel = 0.f;
                    if (lane == own) {
#pragma unroll
                        for (int e = 0; e < 4; ++e) if (e == oe) { sel = sc[e]; bs[e] = -1e30f; }
                    }
                    sel = __shfl(sel, own); wsum += sel;
                    if (lane == k) { myi = gi; myw = sel; }
                }
                if (lane < 8) { const float w = myw / wsum * 2.5f; const int p = (int)atomicAdd(ecnt + myi, 1u);
                    TOPI[(size_t)r * 8 + lane] = myi; TOPW[(size_t)r * 8 + lane] = w; POS[(size_t)r * 8 + lane] = p; }
            }
        }
        GRID_BAR();
        if (PHM & 16384) {
            PHASE_LOCALS(); unsigned char* ws = WSB(); unsigned* ecnt = (unsigned*)(ws + WS_CTL) + CW_CNT + l * 256;
            const int* TOPI = (const int*)(ws + WS_TOPI); const float* TOPW = (const float*)(ws + WS_TOPW); const int* POS = (const int*)(ws + WS_POS); int* SLOT = (int*)(ws + WS_SLOT);
            int* ROWTOK = (int*)(ws + WS_ROWTOK); float* ROWW = (float*)(ws + WS_ROWW); int* BLKEXP = (int*)(ws + WS_BLKEXP);
            LAS int* cntL = (LAS int*)lds; LAS int* bst = cntL + 256; LAS int* tot = bst + 256;
            if (tid < 256) cntL[tid] = (int)__hip_atomic_load(ecnt + tid, RLX_AGENT);
            __syncthreads();
            if (tid == 0) { int s = 0; for (int e = 0; e < 256; ++e) { bst[e] = s; s += (cntL[e] + 255) >> 8; } tot[0] = s; }
            __syncthreads();
            const int NB = tot[0]; const int gt = bx * NTHR + tid, GT = G * NTHR;
            for (int i = gt; i < MALL * 8; i += GT) { const int e = TOPI[i]; const int slot = bst[e] * 256 + POS[i]; SLOT[i] = slot; ROWTOK[slot] = i >> 3; ROWW[slot] = TOPW[i]; }
            for (int i = gt; i < 256 * 256; i += GT) { const int e = i >> 8, p = i & 255, c = cntL[e]; if ((c & 255) != 0 && p >= (c & 255)) { const int slot = (bst[e] + (c >> 8)) * 256 + p; ROWTOK[slot] = 0; ROWW[slot] = 0.f; } }
            for (int i = gt; i < 256 * 160; i += GT) { const int e = i / 160, j = i % 160; if (j < ((cntL[e] + 255) >> 8)) BLKEXP[bst[e] + j] = e; }
            for (int i = gt; i < NRT * 256; i += GT) { const int slot = NB * 256 + i; ROWTOK[slot] = i; ROWW[slot] = 1.f; if ((i & 255) == 0) BLKEXP[NB + (i >> 8)] = 256; }
            if (gt == 0) BLKEXP[MAXBLK] = NB + NRT;
            __syncthreads();
        }
        GRID_BAR();
        if (PHM & 32768) {
            PHASE_LOCALS(); unsigned char* ws = WSB(); unsigned char* WL = ws + WS_W0 + (size_t)l * WL_SIZE; const int* ROWTOK = (const int*)(ws + WS_ROWTOK); const int* BLKEXP = (const int*)(ws + WS_BLKEXP);
            LAS int* rowtab = (LAS int*)(lds + TAB_OFF); LAS int* etab = rowtab + 12 * 256;
            const int nunits = BLKEXP[MAXBLK] * 2;
            for (int i = 0; i < 12; ++i) { const int L = i * G + vcu; if (L >= nunits) break; const int bi = L >> 1;
                if (tid < 256) rowtab[i * 256 + tid] = ROWTOK[(size_t)bi * 256 + tid]; if (tid == 256) etab[i] = BLKEXP[bi]; }
            __syncthreads();
            pg8::MoeOrder<2, true> S{nunits, G, vcu, (const char*)(WL + WL_E1), (size_t)512 * 1024 * 2, (size_t)256 * 1024 * 2, rowtab, etab};
            EpiSwiglu E{(bf16_t*)(ws + WS_HE)}; pg8::gemm_phase(lds, (const bf16_t*)(ws + WS_H2A), 3072, 1024, S, E);
        }
        GRID_BAR();
        if (PHM & 65536) {
            PHASE_LOCALS(); unsigned char* ws = WSB(); unsigned char* WL = ws + WS_W0 + (size_t)l * WL_SIZE; const int* BLKEXP = (const int*)(ws + WS_BLKEXP);
            LAS int* rowtab = (LAS int*)(lds + TAB_OFF); LAS int* etab = rowtab + 12 * 256;
            const int nunits = BLKEXP[MAXBLK] * 4;
            for (int i = tid; i < 64; i += NTHR) { const int L = i * G + vcu; if (L < nunits) etab[i] = BLKEXP[L >> 2]; }
            __syncthreads();
            pg8::MoeOrder<4, false> S{nunits, G, vcu, (const char*)(WL + WL_E2), (size_t)1024 * 256 * 2, (size_t)256 * 256 * 2, rowtab, etab};
            EpiScaleRow E{(bf16_t*)(ws + WS_YB), (const float*)(ws + WS_ROWW)}; pg8::gemm_phase(lds, (const bf16_t*)(ws + WS_HE), 256, 256, S, E);
        }
        GRID_BAR();
        if (PHM & 131072) {
            PHASE_LOCALS(); unsigned char* ws = WSB(); const float* MODV = (const float*)(ws + WS_MODV); const float* modv = MODV + l * 3 * 6144; const bf16_t* YB = (const bf16_t*)(ws + WS_YB); const int* SLOT = (const int*)(ws + WS_SLOT);
            const float* X1 = (const float*)(ws + WS_X1); float* XCUR = (float*)(ws + WS_XCUR); bf16_t* HMOD = (bf16_t*)(ws + WS_HMOD); float* outp = OUTP();
            const float* g2 = INP(I_LN2G) + l * 1024; const float* b2 = INP(I_LN2B) + l * 1024;
            const int NB = ((const int*)(ws + WS_BLKEXP))[MAXBLK] - NRT;
            for (int r = gw; r < MALL; r += NGW) { const int b = r / TPB, t = r % TPB, set = t < SEQ ? b : 2; const float* mv = modv + set * 6144; f32x4 f[4];
#pragma unroll
                for (int j = 0; j < 4; ++j) f[j] = unpk4(*(const u32x2*)(YB + ((size_t)NB * 256 + r) * 1024 + 4 * lane + 256 * j));
#pragma unroll
                for (int k = 0; k < 8; ++k) { const size_t so = (size_t)SLOT[(size_t)r * 8 + k] * 1024;
#pragma unroll
                    for (int j = 0; j < 4; ++j) f[j] = f[j] + unpk4(*(const u32x2*)(YB + so + 4 * lane + 256 * j)); }
                f32x4 v[4];
#pragma unroll
                for (int j = 0; j < 4; ++j) { const int c = 4 * lane + 256 * j; v[j] = *(const f32x4*)(X1 + (size_t)r * 1024 + c) * ALPHA_RES + *(const f32x4*)(mv + 5 * 1024 + c) * f[j]; }
                ln_row(v, g2, b2, lane);
                if (l == 0) { const float* mn = MODV + 3 * 6144 + set * 6144;
#pragma unroll
                    for (int j = 0; j < 4; ++j) { const int c = 4 * lane + 256 * j; *(f32x4*)(XCUR + (size_t)r * 1024 + c) = v[j];
                        const f32x4 sh = *(const f32x4*)(mn + c), sc = *(const f32x4*)(mn + 1024 + c); *(u32x2*)(HMOD + (size_t)r * 1024 + c) = pk4(v[j] * (sc + 1.f) + sh); } }
                else if (t < SEQ) {
#pragma unroll
                    for (int j = 0; j < 4; ++j) *(f32x4*)(outp + ((size_t)b * SEQ + t) * 1024 + 4 * lane + 256 * j) = v[j]; }
            }
        }
        if (l == 0) GRID_BAR();
    }
}

extern "C" void kernel_launch(void* const* d_in, const int* in_sizes, int n_in, void* d_out, int out_size, void* d_ws, size_t ws_size, hipStream_t stream) {
    static int grid = 0;
    if (grid == 0) {
        if (n_in != 25 || ws_size < WS_END) { fprintf(stderr, "kernel_launch: need 25 inputs and >= %zu bytes of workspace; got %d, %zu\n", (size_t)WS_END, n_in, ws_size); grid = -1; return; }
        int dev = 0, cus = 0, per_cu = 0;
        if (hipGetDevice(&dev) != hipSuccess || hipDeviceGetAttribute(&cus, hipDeviceAttributeMultiprocessorCount, dev) != hipSuccess) { grid = -1; return; }
        if (hipFuncSetAttribute((const void*)mega_fwd, hipFuncAttributeMaxDynamicSharedMemorySize, LDS_BYTES) != hipSuccess) { fprintf(stderr, "kernel_launch: hipFuncSetAttribute failed\n"); grid = -1; return; }
        if (hipOccupancyMaxActiveBlocksPerMultiprocessor(&per_cu, (const void*)mega_fwd, NTHR, LDS_BYTES) != hipSuccess || per_cu < 1) { fprintf(stderr, "kernel_launch: occupancy query says %d\n", per_cu); (void)hipGetLastError(); per_cu = 1; }
        grid = cus;
    }
    if (grid < 0) return;
    if (hipMemsetAsync((char*)d_ws + WS_CTL, 0, CTL_ZERO_BYTES, stream) != hipSuccess) return;
    KArgs a{};
    for (int i = 0; i < 25; ++i) a.in[i] = (const float*)d_in[i];
    a.out = (float*)d_out; a.ws = (unsigned char*)d_ws; a.dbg = 0; a.pad = 0;
    hipLaunchKernelGGL(mega_fwd, dim3(grid), dim3(NTHR), LDS_BYTES, stream, a);
}
```

```cpp
#include <hip/hip_runtime.h>
#include <cstdio>
#include <cstdint>

#define GAS __attribute__((address_space(1)))
#define LAS __attribute__((address_space(3)))
typedef unsigned short bf16_t;
typedef short bf16x8 __attribute__((ext_vector_type(8)));
typedef short s16x4 __attribute__((ext_vector_type(4)));
typedef float f32x4 __attribute__((ext_vector_type(4)));
typedef float f32x2 __attribute__((ext_vector_type(2)));
typedef float f32x8 __attribute__((ext_vector_type(8)));
typedef float f32x16 __attribute__((ext_vector_type(16)));
typedef unsigned u32x4 __attribute__((ext_vector_type(4)));
typedef unsigned u32x2 __attribute__((ext_vector_type(2)));
typedef GAS unsigned gu32;
#define RLX_AGENT __ATOMIC_RELAXED, __HIP_MEMORY_SCOPE_AGENT
#define LDS_WAIT() asm volatile("s_waitcnt lgkmcnt(0)" ::: "memory")
#define VM_WAIT() asm volatile("s_waitcnt vmcnt(0)" ::: "memory")

constexpr int D = 1024, BATCH = 2, SEQ = 16384, CTX = 256, TPB = SEQ + CTX  , MALL = BATCH * TPB  ;
constexpr int NRT = MALL / 256;
constexpr int NWAVES = 8, NTHR = 512;
constexpr int INW = 8208, INW_PAD = 8448;
constexpr int NEXP = 256, TOPK = 8;
constexpr float ALPHA_RES = 1.4142135623730951f;
constexpr float LN_EPS = 1e-5f, RMS_EPS = 1e-6f;
constexpr float QSCALE = 0.125f * 1.4426950408889634f;
constexpr int MAXBLK = 1040 + 256 + 130;
constexpr int NCHUNK = TPB / 64;
constexpr int NCHAIN = 16;
#ifndef PHM
#define PHM 0x3ffff
#endif
#ifndef PROBE
#define PROBE 0
#endif
#ifndef REPM
#define REPM 0
#endif
#ifndef XBAR
#define XBAR 1
#endif
#ifndef ROUTER_K
#define ROUTER_K 1024
#endif
#ifndef XTOPK
#define XTOPK 0
#endif
#ifndef XSCAN
#define XSCAN 0
#endif
#define NREP(bit) (((PHM) & (bit)) ? (((REPM) & (bit)) ? 2 : 1) : 0)
#ifndef PROBE_A
#define PROBE_A 0x10
#endif
#ifndef PROBE_B
#define PROBE_B 0x2c
#endif

__device__ __forceinline__ unsigned pk2(float lo, float hi) { unsigned r; asm("v_cvt_pk_bf16_f32 %0, %1, %2" : "=v"(r) : "v"(lo), "v"(hi)); return r; }
__device__ __forceinline__ unsigned f2bf(float f) { return pk2(f, 0.f) & 0xffffu; }
__device__ __forceinline__ float bf2f(unsigned h) { return __builtin_bit_cast(float, h << 16); }

__device__ __forceinline__ u32x2 pk4(f32x4 v) { u32x2 r; r.x = pk2(v.x, v.y); r.y = pk2(v.z, v.w); return r; }
__device__ __forceinline__ f32x4 unpk4(u32x2 w) { f32x4 r; r.x = bf2f(w.x & 0xffffu); r.y = bf2f(w.x >> 16); r.z = bf2f(w.y & 0xffffu); r.w = bf2f(w.y >> 16); return r; }
__device__ __forceinline__ float sigmoidf_(float x) { return __builtin_amdgcn_rcpf(1.f + __expf(-x)); }
__device__ __forceinline__ float siluf_(float x) { return x * __builtin_amdgcn_rcpf(1.f + __expf(-x)); }
__device__ __forceinline__ float logsigf_(float x) { return fminf(x, 0.f) - log1pf(__expf(-fabsf(x))); }
__device__ __forceinline__ void st_wt(int* p, int v) { __hip_atomic_store(p, v, __ATOMIC_RELAXED, __HIP_MEMORY_SCOPE_AGENT); }
__device__ __forceinline__ void st_wt(float* p, float v) { __hip_atomic_store(p, v, __ATOMIC_RELAXED, __HIP_MEMORY_SCOPE_AGENT); }
__device__ __forceinline__ int opaque_tid() { int t = threadIdx.x; asm volatile("" : "+v"(t)); return t; }
__device__ __forceinline__ float wave_sum(float v) {
    v += __builtin_bit_cast(float, __builtin_amdgcn_mov_dpp(__builtin_bit_cast(int, v), 0xB1, 0xF, 0xF, true));
    v += __builtin_bit_cast(float, __builtin_amdgcn_mov_dpp(__builtin_bit_cast(int, v), 0x4E, 0xF, 0xF, true));
    v += __builtin_bit_cast(float, __builtin_amdgcn_mov_dpp(__builtin_bit_cast(int, v), 0x141, 0xF, 0xF, true));
    v += __builtin_bit_cast(float, __builtin_amdgcn_mov_dpp(__builtin_bit_cast(int, v), 0x140, 0xF, 0xF, true));
    { auto a = __builtin_amdgcn_permlane16_swap(__float_as_uint(v), __float_as_uint(v), false, false); v = __uint_as_float(a[0]) + __uint_as_float(a[1]); }
    { auto b = __builtin_amdgcn_permlane32_swap(__float_as_uint(v), __float_as_uint(v), false, false); v = __uint_as_float(b[0]) + __uint_as_float(b[1]); }
    return v;
}

constexpr size_t MiB = 1u << 20;
constexpr size_t WS_CTL = 0, CTL_ZERO_BYTES = 1 * MiB;
constexpr size_t WS_MODV = 1 * MiB;
constexpr size_t WS_ROPE = WS_MODV + 256 * 1024;
constexpr size_t WS_W0 = 2 * MiB;
constexpr size_t WL_IN = 0;
constexpr size_t WL_BRA = WL_IN + (size_t)INW_PAD * 1024 * 2;
constexpr size_t WL_BRM = WL_BRA + 2 * MiB;
constexpr size_t WL_OUT = WL_BRM + 2 * MiB;
constexpr size_t WL_R3 = WL_OUT + 2 * MiB;
constexpr size_t WL_E1 = WL_R3 + (size_t)256 * 3072 * 2;
constexpr size_t WL_E2 = WL_E1 + (size_t)257 * 512 * 1024 * 2;
constexpr size_t WL_SIZE = WL_E2 + (size_t)257 * 1024 * 256 * 2;
constexpr size_t ACT0 = WS_W0 + 2 * WL_SIZE;
constexpr size_t SZ_B16 = (size_t)MALL * 1024 * 2;
constexpr size_t WS_HMOD = ACT0;
constexpr size_t WS_Q = WS_HMOD + SZ_B16, WS_K = WS_Q + SZ_B16, WS_V = WS_K + SZ_B16, WS_QKM = WS_V + SZ_B16, WS_VM = WS_QKM + SZ_B16;
constexpr size_t WS_OMS = WS_VM + SZ_B16, WS_GA = WS_OMS + SZ_B16, WS_GB = WS_GA + SZ_B16;
constexpr size_t WS_GATES = WS_GB + SZ_B16;
constexpr size_t WS_OJ = WS_GATES + (size_t)MALL * 16 * 4 + 61440;
constexpr size_t WS_OA = WS_OJ + 2 * SZ_B16;
constexpr size_t WS_ST = WS_OA + SZ_B16;
constexpr size_t WS_NU = WS_ST + (size_t)NCHAIN * NCHUNK * 65536;
constexpr size_t WS_ADEC = WS_NU + (size_t)NCHAIN * NCHUNK * 128 * 4;
constexpr size_t WS_HM = WS_ADEC + 65536;
constexpr size_t WS_T1 = WS_HM + SZ_B16, WS_Y = WS_T1 + SZ_B16;
constexpr size_t WS_R = WS_Y + SZ_B16;
constexpr size_t WS_X1 = WS_R + 2 * SZ_B16, WS_XCUR = WS_X1 + 2 * SZ_B16;
constexpr size_t WS_H2A = WS_XCUR + 2 * SZ_B16;
constexpr size_t WS_LOG = WS_H2A + 3 * SZ_B16;
constexpr size_t WS_TOPI = WS_LOG + (size_t)MALL * 256 * 4;
constexpr size_t WS_TOPW = WS_TOPI + 2 * MiB, WS_POS = WS_TOPW + 2 * MiB, WS_SLOT = WS_POS + 2 * MiB;
constexpr size_t WS_ROWTOK = WS_SLOT + 2 * MiB;
constexpr size_t WS_ROWW = WS_ROWTOK + 2 * MiB;
constexpr size_t WS_BLKEXP = WS_ROWW + 2 * MiB;
constexpr size_t WS_HE = WS_BLKEXP + 1 * MiB;
constexpr size_t WS_YB = WS_HE + (size_t)MAXBLK * 256 * 256 * 2;
constexpr size_t WS_END = WS_YB + (size_t)MAXBLK * 256 * 1024 * 2;
static_assert(WS_END <= (size_t)4096 * MiB, "d_ws map fits 4 GiB");
constexpr int CW_BAR = 4096;
constexpr int CW_CNT = 16384;
constexpr int CW_MSTAB = 17408;

constexpr int RING_BYTES = 131072;
constexpr int TAB_OFF = RING_BYTES;
constexpr int TAB_BYTES = 12 * 1024 + 256;
constexpr int MISC_OFF = TAB_OFF + TAB_BYTES;
constexpr int LDS_BYTES = 147456;
static_assert(MISC_OFF + 128 <= LDS_BYTES, "LDS map");

#define XB_TMO      128
#define XB_XCNT(j)  (256  + 64 * (j))
#define XB_XSUB(j)  (1280 + 64 * (j))
#define XB_XGEN(j)  (2304 + 64 * (j))
#define XB_TOP      3328
#define XB_TOPGEN   3392
#define XCD_BAR_WORDS 3456
#define XB_SPIN_CAP (1u << 22)
__device__ __forceinline__ unsigned xb_ld(unsigned* p)              { return __hip_atomic_load(p, __ATOMIC_RELAXED, __HIP_MEMORY_SCOPE_AGENT); }
__device__ __forceinline__ unsigned xb_add(unsigned* p, unsigned v) { return __hip_atomic_fetch_add(p, v, __ATOMIC_RELAXED, __HIP_MEMORY_SCOPE_AGENT); }
__device__ __forceinline__ unsigned xb_xcc_id() { return (unsigned)__builtin_amdgcn_s_getreg((3 << 11) | 20) & 0xFu; }
#define XB_SPIN(cond, bar) do { unsigned _sp = 0; while (cond) { __builtin_amdgcn_s_sleep(1); \
    if ((++_sp & 255u) == 0u) { if (xb_ld(&(bar)[XB_TMO])) break; if (_sp > XB_SPIN_CAP) { atomicAdd(&(bar)[XB_TMO], 1u); break; } } } } while (0)
struct XcdBarrier { unsigned* bar; unsigned x; volatile LAS unsigned* st; };
__device__ __forceinline__ XcdBarrier xcd_barrier_post(unsigned* bar, volatile LAS unsigned* st) {
    XcdBarrier b; b.bar = bar; b.x = xb_xcc_id(); b.st = st;
    if (threadIdx.x == 0) (void)xb_add(&bar[XB_XCNT(b.x)], 1u);
    return b;
}
__device__ __forceinline__ void xcd_barrier_complete(unsigned* bar, unsigned x, unsigned& nloc, unsigned& nx) {
    const unsigned G = gridDim.x * gridDim.y * gridDim.z;
    unsigned sum, cnt, mine, sp = 0u;
    for (;;) {
        sum = 0u; cnt = 0u; mine = 0u;
#pragma unroll
        for (unsigned j = 0; j < 16; ++j) { const unsigned c = xb_ld(&bar[XB_XCNT(j)]); sum += c; cnt += (c > 0u) ? 1u : 0u; mine = (j == x) ? c : mine; }
        if (sum == G) break;
        __builtin_amdgcn_s_sleep(1);
        if ((++sp & 255u) == 0u) { if (xb_ld(&bar[XB_TMO])) break; if (sp > XB_SPIN_CAP) { atomicAdd(&bar[XB_TMO], 1u); break; } }
    }
    nloc = mine > 0u ? mine : 1u; nx = cnt > 0u ? cnt : 1u;
}
template <bool FENCES, bool LOCAL>
__device__ __forceinline__ void xcd_barrier(const XcdBarrier& b) {
    asm volatile("s_waitcnt vmcnt(0)" ::: "memory");
    __syncthreads();
    if (threadIdx.x == 0) {
        unsigned* bar = b.bar;
        __builtin_amdgcn_s_waitcnt(0);
        unsigned nloc = b.st[0], nx = b.st[1];
        if (nloc == 0u) { xcd_barrier_complete(bar, b.x, nloc, nx); b.st[0] = nloc; b.st[1] = nx; }
        const unsigned old = xb_add(&bar[XB_XSUB(b.x)], 1u);
        const unsigned gen = old / nloc;
        if (old + 1u == (gen + 1u) * nloc) {
            if (FENCES) __builtin_amdgcn_fence(__ATOMIC_RELEASE, "agent");
            asm volatile("s_waitcnt vmcnt(0)" ::: "memory");
            if (!LOCAL) { const unsigned og = xb_add(&bar[XB_TOP], 1u);
                const unsigned tg = og / nx;
                if (og + 1u == (tg + 1u) * nx) xb_add(&bar[XB_TOPGEN], 1u);
                else XB_SPIN(xb_ld(&bar[XB_TOPGEN]) == tg, bar); }
            if (FENCES) __builtin_amdgcn_fence(__ATOMIC_ACQUIRE, "agent");
            xb_add(&bar[XB_XGEN(b.x)], 1u);
            asm volatile("s_waitcnt vmcnt(0)" ::: "memory");
        } else {
            XB_SPIN(xb_ld(&bar[XB_XGEN(b.x)]) == gen, bar);
            if (FENCES) __builtin_amdgcn_fence(__ATOMIC_ACQUIRE, "agent");
            asm volatile("s_waitcnt vmcnt(0)" ::: "memory");
        }
    }
    __syncthreads();
}

namespace pg8 {
constexpr int BM = 256, BK = 64, HALF = 128, HTB = HALF * BK * 2, STAGE_BYTES = 8 * HTB, NXCD = 8, WGM = 8;
__host__ __device__ __forceinline__ int lds_byte(int r, int c) { const int st = (r >> 4) * 2 + (c >> 5), rr = r & 15, cc = c & 31, ob = rr * 64 + cc * 2; return st * 1024 + (ob ^ (((ob >> 9) & 1) << 5)); }
__host__ __device__ __forceinline__ void stage_rc(int b, int& R, int& C) { const int st = b / 1024, sb = b % 1024, swz = sb ^ (((sb >> 9) & 1) << 5); R = (st >> 1) * 16 + swz / 64; C = (st & 1) * 32 + (swz % 64) / 2; }
struct Unit { int pm, pn, aux; };

struct DenseOrder {
    static constexpr bool GATHER = false;
    int nM, nN, nwg, G, c, skipctx; const char* Bt; size_t btile;
    __device__ __forceinline__ void init(int nM_, int nN_, int G_, int c_, const void* Bt_, int K, int skipctx_ = 0) { nM = nM_; nN = nN_; nwg = nM * nN; G = G_; c = c_; Bt = (const char*)Bt_; btile = (size_t)256 * K * 2; skipctx = skipctx_; }
    __device__ __forceinline__ bool next(int i, Unit& u) const {
        const long L = (long)i * G + c; if (L >= nwg) return false;
        int wgid = (int)L; { const int q = nwg / NXCD, r = nwg % NXCD, xcd = wgid % NXCD, off = wgid / NXCD; wgid = (xcd < r ? xcd * (q + 1) : r * (q + 1) + (xcd - r) * q) + off; }
        const int nig = WGM * nN, gid = wgid / nig, fm = gid * WGM, gsz = (nM - fm) < WGM ? (nM - fm) : WGM;
        u.pm = fm + ((wgid % nig) % gsz); u.pn = (wgid % nig) / gsz; u.aux = 0; if (skipctx && u.pm >= 64) u.pm += 1; return true;
    }
    __device__ __forceinline__ unsigned arow(const Unit& u, int r) const { return 0u; }
    __device__ __forceinline__ const char* bptr(const Unit& u) const { return Bt + (size_t)u.pn * btile; }
};
template <int NPN, bool GATHER_> struct MoeOrder {
    static constexpr bool GATHER = GATHER_;
    int nunits, G, vcu; const char* W; size_t estride, btile; const LAS int* rowtab; const LAS int* etab;
    __device__ __forceinline__ bool next(int i, Unit& u) const {
        const int L = i * G + vcu; if (L >= nunits) return false;
        u.pm = L / NPN; u.pn = L % NPN; u.aux = i; return true;
    }
    __device__ __forceinline__ unsigned arow(const Unit& u, int r) const { return (unsigned)rowtab[u.aux * 256 + r]; }
    __device__ __forceinline__ const char* bptr(const Unit& u) const { return W + (size_t)etab[u.aux] * estride + (size_t)u.pn * btile; }
};

template <class Epi, class Sched>
__device__ __forceinline__ void gemm_phase(LAS unsigned char* lds, const bf16_t* A, int lda, int K, const Sched& S, const Epi& E, int ldb = 0) {
    if (ldb == 0) ldb = K;
    constexpr bool GATHER = Sched::GATHER;
    const int tid = opaque_tid(), wid = __builtin_amdgcn_readfirstlane(tid >> 6), lane = tid & 63, wr = wid >> 2, wc = wid & 3, fr = lane & 15, fq = lane >> 4;
    const int nt = K / BK;
    int R0, C0, R1, C1; stage_rc(tid * 16, R0, C0); stage_rc(tid * 16 + 8192, R1, C1);
    const unsigned vb0 = (unsigned)(R0 * ldb + C0) * 2u, vb1 = (unsigned)(R1 * ldb + C1) * 2u;
    const unsigned lda2 = (unsigned)lda * 2u;
    const size_t kstep = (size_t)(BK * 2);
    const size_t hstepB = (size_t)HALF * ldb * 2;
    const size_t hstepA = GATHER ? (size_t)0 : (size_t)HALF * lda2, tstepA = GATHER ? (size_t)0 : (size_t)256 * lda2;
    const unsigned ldsw = (unsigned)wid * 1024u;
    const int aoff = lds_byte(wr * 64 + fr, fq * 8), boff = lds_byte(wc * 32 + fr, fq * 8);
    const char* gA = (const char*)A;
#define PG8_SA(b, h) (((b) * 2 + (h)) * HTB)
#define PG8_SB(b, h) ((4 + (b) * 2 + (h)) * HTB)
#define PG8_STAGE(bufoff, gbase, o0, o1) do { \
        __builtin_amdgcn_global_load_lds((const unsigned*)((const char*)(gbase) + (o0)), (LAS unsigned*)(lds + (bufoff) + ldsw), 16, 0, 0); \
        __builtin_amdgcn_global_load_lds((const unsigned*)((const char*)(gbase) + (o1)), (LAS unsigned*)(lds + (bufoff) + ldsw + 8192), 16, 0, 0); } while (0)
#define PG8_LDA(dst, b, h) do { _Pragma("unroll") for (int m = 0; m < 4; ++m) _Pragma("unroll") for (int k = 0; k < 2; ++k) dst[m][k] = *(const LAS bf16x8*)(lds + PG8_SA(b, h) + aoff + m * 2048 + k * 1024); } while (0)
#define PG8_LDB(dst, b, h) do { _Pragma("unroll") for (int n = 0; n < 2; ++n) _Pragma("unroll") for (int k = 0; k < 2; ++k) dst[n][k] = *(const LAS bf16x8*)(lds + PG8_SB(b, h) + boff + n * 2048 + k * 1024); } while (0)
#define PG8_MMA(ai, bj, At, Bt) do { __builtin_amdgcn_s_setprio(1); _Pragma("unroll") for (int m = 0; m < 4; ++m) _Pragma("unroll") for (int n = 0; n < 2; ++n) _Pragma("unroll") for (int k = 0; k < 2; ++k) \
        acc[ai][bj][m][n] = __builtin_amdgcn_mfma_f32_16x16x32_bf16(Bt[n][k], At[m][k], acc[ai][bj][m][n], 0, 0, 0); __builtin_amdgcn_s_setprio(0); } while (0)
#define PG8_WAIT_V(n) asm volatile("s_waitcnt vmcnt(" #n ")" ::: "memory")
#define PG8_WAIT_L(n) asm volatile("s_waitcnt lgkmcnt(" #n ")" ::: "memory")
#define PG8_BAR __builtin_amdgcn_s_barrier()
#define PG8_SCHED __builtin_amdgcn_sched_barrier(0)
    Unit cur, nxt; int ui = 0;
    if (!S.next(0, cur)) return;
    f32x4 acc[2][2][4][2];
#pragma unroll
    for (int a = 0; a < 2; ++a)
#pragma unroll
        for (int b = 0; b < 2; ++b)
#pragma unroll
            for (int m = 0; m < 4; ++m)
#pragma unroll
                for (int n = 0; n < 2; ++n) acc[a][b][m][n] = (f32x4){0.f, 0.f, 0.f, 0.f};
    bf16x8 At[4][2], B0[2][2], B1[2][2];
    unsigned o00, o01, o10, o11;
    if constexpr (GATHER) { o00 = S.arow(cur, R0) * lda2 + (unsigned)(C0 * 2); o01 = S.arow(cur, R1) * lda2 + (unsigned)(C1 * 2); o10 = S.arow(cur, 128 + R0) * lda2 + (unsigned)(C0 * 2); o11 = S.arow(cur, 128 + R1) * lda2 + (unsigned)(C1 * 2); }
    else { o00 = (unsigned)R0 * lda2 + (unsigned)(C0 * 2); o01 = (unsigned)R1 * lda2 + (unsigned)(C1 * 2); o10 = o00; o11 = o01; }
    const char* cA = gA + (size_t)cur.pm * tstepA;
    const char* cB = S.bptr(cur);
    PG8_STAGE(PG8_SB(0, 0), cB, vb0, vb1); PG8_STAGE(PG8_SB(0, 1), cB + hstepB, vb0, vb1); PG8_STAGE(PG8_SA(0, 0), cA, o00, o01); PG8_STAGE(PG8_SA(0, 1), cA + hstepA, o10, o11);
    if (wr == 1) PG8_BAR;
    PG8_WAIT_V(2); PG8_BAR;
    PG8_STAGE(PG8_SB(1, 0), cB + kstep, vb0, vb1); PG8_STAGE(PG8_SA(1, 0), cA + kstep, o00, o01); PG8_STAGE(PG8_SB(1, 1), cB + hstepB + kstep, vb0, vb1);
    PG8_WAIT_V(6); PG8_BAR;
    for (;;) {
        const bool has_next = S.next(ui + 1, nxt);
        const char* nA = has_next ? gA + (size_t)nxt.pm * tstepA : cA; const char* nB = has_next ? S.bptr(nxt) : cB;
        for (int t = 0; t < nt; t += 2) {
            const bool last = (t == nt - 2);
            const char* a1 = cA + (size_t)(t + 1) * kstep;
            const char* a2 = last ? nA : cA + (size_t)(t + 2) * kstep; const char* b2 = last ? nB : cB + (size_t)(t + 2) * kstep;
            const char* a3 = a2 + kstep; const char* b3 = b2 + kstep;
            unsigned s00 = o00, s01 = o01, s10 = o10, s11 = o11;
            if constexpr (GATHER) { if (last && has_next) { s00 = S.arow(nxt, R0) * lda2 + (unsigned)(C0 * 2); s01 = S.arow(nxt, R1) * lda2 + (unsigned)(C1 * 2); s10 = S.arow(nxt, 128 + R0) * lda2 + (unsigned)(C0 * 2); s11 = S.arow(nxt, 128 + R1) * lda2 + (unsigned)(C1 * 2); } }
            PG8_LDB(B0, 0, 0); PG8_LDB(B1, 0, 1); PG8_SCHED; PG8_LDA(At, 0, 0); PG8_STAGE(PG8_SA(1, 1), a1 + hstepA, o10, o11);
            PG8_WAIT_V(8); PG8_WAIT_L(0); PG8_BAR; PG8_MMA(0, 0, At, B0); PG8_MMA(0, 1, At, B1); PG8_BAR; PG8_SCHED;
            PG8_LDA(At, 0, 1); PG8_STAGE(PG8_SB(0, 0), b2, vb0, vb1); PG8_STAGE(PG8_SB(0, 1), b2 + hstepB, vb0, vb1); PG8_STAGE(PG8_SA(0, 0), a2, s00, s01);
            PG8_WAIT_V(8); PG8_WAIT_L(0); PG8_BAR; PG8_MMA(1, 0, At, B0); PG8_MMA(1, 1, At, B1); PG8_BAR; PG8_SCHED;
            PG8_LDB(B0, 1, 0); PG8_LDB(B1, 1, 1); PG8_SCHED; PG8_LDA(At, 1, 0); PG8_STAGE(PG8_SA(0, 1), a2 + hstepA, s10, s11);
            PG8_WAIT_V(8); PG8_WAIT_L(0); PG8_BAR; PG8_MMA(0, 0, At, B0); PG8_MMA(0, 1, At, B1); PG8_BAR; PG8_SCHED;
            PG8_LDA(At, 1, 1); PG8_STAGE(PG8_SB(1, 0), b3, vb0, vb1); PG8_STAGE(PG8_SB(1, 1), b3 + hstepB, vb0, vb1); PG8_STAGE(PG8_SA(1, 0), a3, s00, s01);
            PG8_WAIT_V(8); PG8_WAIT_L(0); PG8_BAR; PG8_MMA(1, 0, At, B0); PG8_MMA(1, 1, At, B1); PG8_BAR; PG8_SCHED;
        }
        if (wr == 0) PG8_BAR;
        { const int t2 = opaque_tid(), w2 = __builtin_amdgcn_readfirstlane(t2 >> 6); E(acc, cur, w2 >> 2, w2 & 3, t2 & 15, (t2 & 63) >> 4); }
        if (!has_next) break;
#pragma unroll
        for (int a = 0; a < 2; ++a)
#pragma unroll
            for (int b = 0; b < 2; ++b)
#pragma unroll
                for (int m = 0; m < 4; ++m)
#pragma unroll
                    for (int n = 0; n < 2; ++n) acc[a][b][m][n] = (f32x4){0.f, 0.f, 0.f, 0.f};
        cur = nxt; cA = nA; cB = nB; ++ui;
        if constexpr (GATHER) { o00 = S.arow(cur, R0) * lda2 + (unsigned)(C0 * 2); o01 = S.arow(cur, R1) * lda2 + (unsigned)(C1 * 2); o10 = S.arow(cur, 128 + R0) * lda2 + (unsigned)(C0 * 2); o11 = S.arow(cur, 128 + R1) * lda2 + (unsigned)(C1 * 2); }
        if (wr == 1) PG8_BAR;
    }
    PG8_WAIT_V(0);
    PG8_BAR;
#undef PG8_SA
#undef PG8_SB
#undef PG8_STAGE
#undef PG8_LDA
#undef PG8_LDB
#undef PG8_MMA
#undef PG8_WAIT_V
#undef PG8_WAIT_L
#undef PG8_BAR
#undef PG8_SCHED
}
}

typedef const f32x4 (&AccRef)[2][2][4][2];
#define EPI_ROW(u, ai, m) ((u).pm * 256 + (ai) * 128 + wr * 64 + (m) * 16 + fr)
#define EPI_COL(bj, n) ((bj) * 128 + wc * 32 + (n) * 16 + 4 * fq)

struct EpiInProj {
    bf16_t *Q, *K, *V, *QKM, *VM, *OMS, *GA, *GB; float* GATES; const float* b_gates; const f32x2* rope; unsigned* mstab;
    __device__ __forceinline__ void operator()(AccRef acc, const pg8::Unit& u, int wr, int wc, int fr, int fq) const {
        const int b = u.pm / 65, tile = u.pm % 65; const bool is_ctx = (tile == 64);
        if (u.pn == 32) {
            if (wc != 0) return;
            const f32x4 bg = *(const f32x4*)(b_gates + 4 * fq);
            f32x4 mx = (f32x4){0.f, 0.f, 0.f, 0.f};
#pragma unroll
            for (int ai = 0; ai < 2; ++ai)
#pragma unroll
                for (int m = 0; m < 4; ++m) { const f32x4 g = acc[ai][0][m][0] + bg; *(f32x4*)(GATES + (size_t)EPI_ROW(u, ai, m) * 16 + 4 * fq) = g;
                    mx.x = fmaxf(mx.x, g.x); mx.y = fmaxf(mx.y, g.y); mx.z = fmaxf(mx.z, g.z); mx.w = fmaxf(mx.w, g.w); }
#pragma unroll
            for (int o = 1; o < 16; o <<= 1) { mx.x = fmaxf(mx.x, __shfl_xor(mx.x, o)); mx.y = fmaxf(mx.y, __shfl_xor(mx.y, o)); mx.z = fmaxf(mx.z, __shfl_xor(mx.z, o)); mx.w = fmaxf(mx.w, __shfl_xor(mx.w, o)); }
            if (fr == 0 && (fq == 0 || fq == 2)) { const int dir = fq >> 1;
                const unsigned r0 = atomicMax(mstab + (b * 4 + 0) * 2 + dir, __float_as_uint(mx.x)), r1 = atomicMax(mstab + (b * 4 + 1) * 2 + dir, __float_as_uint(mx.y));
                const unsigned r2 = atomicMax(mstab + (b * 4 + 2) * 2 + dir, __float_as_uint(mx.z)), r3 = atomicMax(mstab + (b * 4 + 3) * 2 + dir, __float_as_uint(mx.w));
                asm volatile("" :: "v"(r0), "v"(r1), "v"(r2), "v"(r3)); }
            return;
        }
        const int grp = u.pn >> 2, cbase = (u.pn & 3) * 256;
        bf16_t* dst = grp == 0 ? Q : grp == 1 ? K : grp == 2 ? V : grp == 3 ? QKM : grp == 4 ? VM : grp == 5 ? OMS : grp == 6 ? GA : GB;
        if (grp <= 1 && !is_ctx) {
            const bool colrot = (wc & 1) != 0; const float qs = grp == 0 ? QSCALE : 1.f;
#pragma unroll
            for (int ai = 0; ai < 2; ++ai) { f32x4 csa[4], csb[4];
#pragma unroll
                for (int m = 0; m < 4; ++m) { const int t = tile * 256 + ai * 128 + wr * 64 + m * 16 + fr; const int pos = colrot ? (t & 63) : (t >> 6);
                    csa[m] = *(const f32x4*)(rope + pos * 16 + 4 * fq); csb[m] = *(const f32x4*)(rope + pos * 16 + 4 * fq + 2); }
#pragma unroll
                for (int m = 0; m < 4; ++m) { const int row = EPI_ROW(u, ai, m);
                    const f32x4 cs0 = csa[m], cs1 = csb[m];
                    const f32x4 cv = (f32x4){cs0.x, cs0.z, cs1.x, cs1.z}, sv = (f32x4){cs0.y, cs0.w, cs1.y, cs1.w};
#pragma unroll
                    for (int bj = 0; bj < 2; ++bj) { const f32x4 x0 = acc[ai][bj][m][0], x1 = acc[ai][bj][m][1];
                        const f32x4 o0 = (x0 * cv - x1 * sv) * qs, o1 = (x1 * cv + x0 * sv) * qs;
                        bf16_t* p = dst + (size_t)row * 1024 + cbase + EPI_COL(bj, 0);
                        *(u32x2*)p = pk4(o0); *(u32x2*)(p + 16) = pk4(o1); } } }
            return;
        }
        const bool sig = grp >= 5; const float qs2 = grp == 0 ? QSCALE : 1.f;
#pragma unroll
        for (int ai = 0; ai < 2; ++ai)
#pragma unroll
            for (int m = 0; m < 4; ++m) { const int row = EPI_ROW(u, ai, m);
#pragma unroll
                for (int bj = 0; bj < 2; ++bj) { u32x2 pk[2];
#pragma unroll
                    for (int n = 0; n < 2; ++n) { f32x4 v = acc[ai][bj][m][n] * qs2;
                        if (sig) { v.x = sigmoidf_(v.x); v.y = sigmoidf_(v.y); v.z = sigmoidf_(v.z); v.w = sigmoidf_(v.w); }
                        pk[n] = pk4(v); }
                    bf16_t* p = dst + (size_t)row * 1024 + cbase;
                    if (grp >= 2) *(u32x4*)(p + bj * 128 + wc * 32 + 8 * fq) = (u32x4){pk[0].x, pk[0].y, pk[1].x, pk[1].y};
                    else { *(u32x2*)(p + EPI_COL(bj, 0)) = pk[0]; *(u32x2*)(p + EPI_COL(bj, 1)) = pk[1]; } } }
    }
};
struct EpiGate1 {
    const bf16_t* G; bf16_t* O;
    __device__ __forceinline__ void operator()(AccRef acc, const pg8::Unit& u, int wr, int wc, int fr, int fq) const {
#pragma unroll
        for (int ai = 0; ai < 2; ++ai) { u32x4 gw[4][2];
#pragma unroll
            for (int m = 0; m < 4; ++m) { const size_t ro = (size_t)EPI_ROW(u, ai, m) * 1024 + u.pn * 256;
#pragma unroll
                for (int bj = 0; bj < 2; ++bj) gw[m][bj] = *(const u32x4*)(G + ro + bj * 128 + wc * 32 + 8 * fq); }
#pragma unroll
            for (int m = 0; m < 4; ++m) { const size_t ro = (size_t)EPI_ROW(u, ai, m) * 1024 + u.pn * 256;
#pragma unroll
                for (int bj = 0; bj < 2; ++bj) { const u32x4 g = gw[m][bj];
                    const u32x2 lo = pk4(unpk4((u32x2){g.x, g.y}) * acc[ai][bj][m][0]), hi = pk4(unpk4((u32x2){g.z, g.w}) * acc[ai][bj][m][1]);
                    *(u32x4*)(O + ro + bj * 128 + wc * 32 + 8 * fq) = (u32x4){lo.x, lo.y, hi.x, hi.y}; } } }
    }
};
struct EpiGate2 {
    const bf16_t* G; const bf16_t* T1; bf16_t* O;
    __device__ __forceinline__ void operator()(AccRef acc, const pg8::Unit& u, int wr, int wc, int fr, int fq) const {
#pragma unroll
        for (int ai = 0; ai < 2; ++ai) { u32x4 gw[4][2], tw[4][2];
#pragma unroll
            for (int m = 0; m < 4; ++m) { const size_t ro = (size_t)EPI_ROW(u, ai, m) * 1024 + u.pn * 256;
#pragma unroll
                for (int bj = 0; bj < 2; ++bj) { gw[m][bj] = *(const u32x4*)(G + ro + bj * 128 + wc * 32 + 8 * fq); tw[m][bj] = *(const u32x4*)(T1 + ro + bj * 128 + wc * 32 + 8 * fq); } }
#pragma unroll
            for (int m = 0; m < 4; ++m) { const size_t ro = (size_t)EPI_ROW(u, ai, m) * 1024 + u.pn * 256;
#pragma unroll
                for (int bj = 0; bj < 2; ++bj) { const u32x4 g = gw[m][bj], t = tw[m][bj];
                    const u32x2 lo = pk4(unpk4((u32x2){t.x, t.y}) + unpk4((u32x2){g.x, g.y}) * acc[ai][bj][m][0]), hi = pk4(unpk4((u32x2){t.z, t.w}) + unpk4((u32x2){g.z, g.w}) * acc[ai][bj][m][1]);
                    *(u32x4*)(O + ro + bj * 128 + wc * 32 + 8 * fq) = (u32x4){lo.x, lo.y, hi.x, hi.y}; } } }
    }
};
struct XSrc {
    const float* x; const float* ctx; const float* xcur; int layer;
    __device__ __forceinline__ const float* row(int r) const {
        if (layer) return xcur + (size_t)r * 1024;
        const int b = r / TPB, t = r % TPB;
        return t < SEQ ? x + ((size_t)b * SEQ + t) * 1024 : ctx + ((size_t)b * CTX + (t - SEQ)) * 1024;
    }
};
struct EpiOut {
    XSrc xs; const float* modv  ; float* R;
    __device__ __forceinline__ void operator()(AccRef acc, const pg8::Unit& u, int wr, int wc, int fr, int fq) const {
        const int b = u.pm / 65, set = (u.pm % 65 == 64) ? 2 : b; const float* gate = modv + set * 6144 + 2 * 1024 + u.pn * 256;
        f32x4 g[2][2];
#pragma unroll
        for (int bj = 0; bj < 2; ++bj)
#pragma unroll
            for (int n = 0; n < 2; ++n) g[bj][n] = *(const f32x4*)(gate + bj * 128 + wc * 32 + 8 * fq + 4 * n);
#pragma unroll
        for (int ai = 0; ai < 2; ++ai) { f32x4 xv[4][2][2];
#pragma unroll
            for (int m = 0; m < 4; ++m) { const float* xr = xs.row(EPI_ROW(u, ai, m)) + u.pn * 256;
#pragma unroll
                for (int bj = 0; bj < 2; ++bj)
#pragma unroll
                    for (int n = 0; n < 2; ++n) xv[m][bj][n] = *(const f32x4*)(xr + bj * 128 + wc * 32 + 8 * fq + 4 * n); }
#pragma unroll
            for (int m = 0; m < 4; ++m) { bf16_t* rr = (bf16_t*)R + (size_t)EPI_ROW(u, ai, m) * 1024 + u.pn * 256;
#pragma unroll
                for (int bj = 0; bj < 2; ++bj) { const u32x2 lo = pk4(xv[m][bj][0] * ALPHA_RES + g[bj][0] * acc[ai][bj][m][0]), hi = pk4(xv[m][bj][1] * ALPHA_RES + g[bj][1] * acc[ai][bj][m][1]);
                    *(u32x4*)(rr + bj * 128 + wc * 32 + 8 * fq) = (u32x4){lo.x, lo.y, hi.x, hi.y}; } } }
    }
};
struct EpiLogits {
    float* O;
    __device__ __forceinline__ void operator()(AccRef acc, const pg8::Unit& u, int wr, int wc, int fr, int fq) const {
#pragma unroll
        for (int ai = 0; ai < 2; ++ai)
#pragma unroll
            for (int m = 0; m < 4; ++m) { float* rr = O + (size_t)EPI_ROW(u, ai, m) * 256;
#pragma unroll
                for (int bj = 0; bj < 2; ++bj)
#pragma unroll
                    for (int n = 0; n < 2; ++n) *(f32x4*)(rr + EPI_COL(bj, n)) = acc[ai][bj][m][n]; }
    }
};
struct EpiSwiglu {
    bf16_t* HE;
    __device__ __forceinline__ void operator()(AccRef acc, const pg8::Unit& u, int wr, int wc, int fr, int fq) const {
#pragma unroll
        for (int ai = 0; ai < 2; ++ai)
#pragma unroll
            for (int m = 0; m < 4; ++m) { bf16_t* rr = HE + (size_t)EPI_ROW(u, ai, m) * 256 + u.pn * 128;
                u32x2 pk[2];
#pragma unroll
                for (int n = 0; n < 2; ++n) { const f32x4 a = acc[ai][0][m][n], g = acc[ai][1][m][n];
                    f32x4 o; o.x = siluf_(a.x) * g.x; o.y = siluf_(a.y) * g.y; o.z = siluf_(a.z) * g.z; o.w = siluf_(a.w) * g.w; pk[n] = pk4(o); }
                *(u32x4*)(rr + wc * 32 + 8 * fq) = (u32x4){pk[0].x, pk[0].y, pk[1].x, pk[1].y}; }
    }
};
constexpr float YB8_SCALE = 64.f;
__device__ __forceinline__ unsigned pk4_fp8(f32x4 v) { int w = 0; w = __builtin_amdgcn_cvt_pk_fp8_f32(v.x, v.y, w, false); w = __builtin_amdgcn_cvt_pk_fp8_f32(v.z, v.w, w, true); return (unsigned)w; }
__device__ __forceinline__ f32x4 unpk4_fp8(unsigned w) { return (f32x4){__builtin_amdgcn_cvt_f32_fp8((int)w, 0), __builtin_amdgcn_cvt_f32_fp8((int)w, 1), __builtin_amdgcn_cvt_f32_fp8((int)w, 2), __builtin_amdgcn_cvt_f32_fp8((int)w, 3)}; }
struct EpiScaleRow {
    bf16_t* YB; const float* roww;
    __device__ __forceinline__ void operator()(AccRef acc, const pg8::Unit& u, int wr, int wc, int fr, int fq) const {
        float w8[2][4];
#pragma unroll
        for (int ai = 0; ai < 2; ++ai)
#pragma unroll
            for (int m = 0; m < 4; ++m) w8[ai][m] = roww[EPI_ROW(u, ai, m)];
#pragma unroll
        for (int ai = 0; ai < 2; ++ai)
#pragma unroll
            for (int m = 0; m < 4; ++m) { const int row = EPI_ROW(u, ai, m); const float w0 = w8[ai][m], w = w0 * YB8_SCALE;
#pragma unroll
                for (int bj = 0; bj < 2; ++bj)
                    if (w0 >= 0.f) *(u32x2*)((unsigned char*)YB + (size_t)row * 1024 + u.pn * 256 + bj * 128 + wc * 32 + 8 * fq) = (u32x2){pk4_fp8(acc[ai][bj][m][0] * w), pk4_fp8(acc[ai][bj][m][1] * w)};
                asm volatile("" ::: "memory"); }
    }
};

namespace att {
constexpr int QBLK = 32, KVBLK = 64, LDX = 1024;
constexpr float SCALE = 0.125f, THR = 8.f;
constexpr size_t SHM_V = KVBLK * 128 * 2, SHM_K = KVBLK * 64 * 2, SHM_ATTN = 2 * SHM_V + 2 * SHM_K + NWAVES * 64 * 4;
#define KSWZ64(row, colB) ((row) * 128 + ((colB) ^ ((((row) >> 1) & 7) << 4)))
#define SBAR() __builtin_amdgcn_sched_barrier(0)
__device__ __forceinline__ int crow(int r, int hi) { return (r & 3) + 8 * (r >> 2) + 4 * hi; }
__device__ __forceinline__ unsigned cvtpk(float lo, float hi) { unsigned r; asm volatile("v_cvt_pk_bf16_f32 %0, %1, %2" : "=v"(r) : "v"(lo), "v"(hi)); return r; }
__device__ __forceinline__ void partialSM(f32x16& p0, f32x16& p1, float& m_reg, float& mn, float& alpha) {
  constexpr float C = SCALE * 1.4426950408889634f;
  float pmax = p0[0];
#pragma unroll
  for (int r = 1; r < 16; ++r) pmax = fmaxf(pmax, p0[r]);
#pragma unroll
  for (int r = 0; r < 16; ++r) pmax = fmaxf(pmax, p1[r]);
  { auto rr = __builtin_amdgcn_permlane32_swap(__float_as_uint(pmax), __float_as_uint(pmax), false, false);
    pmax = fmaxf(__uint_as_float(rr[0]), __uint_as_float(rr[1])); }
  if (__builtin_expect(__all(pmax - m_reg <= THR / SCALE), 1)) { mn = m_reg; alpha = 1.f; }
  else { mn = fmaxf(m_reg, pmax); alpha = __builtin_amdgcn_exp2f((m_reg - mn) * C); m_reg = mn; }
  float mnC = -mn * C;
#pragma unroll
  for (int r = 0; r < 16; ++r) p0[r] = fmaf(p0[r], C, mnC);
#pragma unroll
  for (int r = 0; r < 16; ++r) p1[r] = fmaf(p1[r], C, mnC);
#pragma unroll
  for (int r = 0; r < 16; ++r) p0[r] = __builtin_amdgcn_exp2f(p0[r]);
}
__device__ __forceinline__ void finishSM(f32x16& p0, f32x16& p1, float alpha, float& l_reg, bf16x8& pa0, bf16x8& pa1, bf16x8& pa2, bf16x8& pa3) {
#pragma unroll
  for (int r = 0; r < 16; ++r) p1[r] = __builtin_amdgcn_exp2f(p1[r]);
  float ps = 0;
#pragma unroll
  for (int r = 0; r < 16; ++r) ps += p0[r];
#pragma unroll
  for (int r = 0; r < 16; ++r) ps += p1[r];
  { auto rr = __builtin_amdgcn_permlane32_swap(__float_as_uint(ps), __float_as_uint(ps), false, false);
    ps = __uint_as_float(rr[0]) + __uint_as_float(rr[1]); }
  l_reg = l_reg * alpha + ps;
#define PK4(P, BASE, OUT) do { u32x4 w = {cvtpk(P[BASE + 0], P[BASE + 1]), cvtpk(P[BASE + 2], P[BASE + 3]), cvtpk(P[BASE + 4], P[BASE + 5]), cvtpk(P[BASE + 6], P[BASE + 7])}; \
    OUT = *reinterpret_cast<bf16x8*>(&w); } while (0)
  PK4(p0, 0, pa0); PK4(p0, 8, pa1); PK4(p1, 0, pa2); PK4(p1, 8, pa3);
#undef PK4
}
__device__ __forceinline__ void qkt(f32x16& p0, f32x16& p1, const char* Ks, const bf16x8* qr, int r32, int hi) {
  p0 = f32x16{}; p1 = f32x16{};
#pragma unroll
  for (int d0 = 0; d0 < 4; ++d0) { const int cb = (d0 * 16 + hi * 8) * 2;
    bf16x8 b0 = *reinterpret_cast<const bf16x8*>(Ks + KSWZ64(r32, cb));
    bf16x8 b1 = *reinterpret_cast<const bf16x8*>(Ks + KSWZ64(32 + r32, cb));
    p0 = __builtin_amdgcn_mfma_f32_32x32x16_bf16(b0, qr[d0], p0, 0, 0, 0);
    p1 = __builtin_amdgcn_mfma_f32_32x32x16_bf16(b1, qr[d0], p1, 0, 0, 0); }
}
__device__ __forceinline__ int v_st(int k, int c) { const int kk = (k & ~0xC) | ((k & 4) << 1) | ((k & 8) >> 1); return ((kk >> 3) * 4 + (c >> 5)) * 512 + ((kk & 7) * 32 + (c & 31)) * 2; }
__device__ __forceinline__ int v_rd_base(int lane) { return ((lane & 3) << 3) | (((lane >> 2) & 3) << 6) | (((lane >> 4) & 1) << 5) | (((lane >> 5) & 1) << 8); }
constexpr int v_rd_off(int d0, int ks, int half) { return d0 * 512 + ks * 4096 + half * 2048; }
template <int OFF> __device__ __forceinline__ s16x4 tr_read(int vb) {
  s16x4 r; asm volatile("ds_read_b64_tr_b16 %0, %1 offset:%2" : "=&v"(r) : "v"(vb), "i"(OFF) : "memory"); return r;
}
template <int I> __device__ __forceinline__ void pv_rd(s16x4& L, s16x4& H, int vb) { L = tr_read<v_rd_off(I >> 2, I & 3, 0)>(vb); H = tr_read<v_rd_off(I >> 2, I & 3, 1)>(vb); }
template <int N> __device__ __forceinline__ void pv_wait(s16x4& L, s16x4& H) { asm volatile("s_waitcnt lgkmcnt(%2)" : "+v"(L), "+v"(H) : "i"(N) : "memory"); }
__device__ __forceinline__ void pv_d0(f32x16* o, int vb, bf16x8 pa0, bf16x8 pa1, bf16x8 pa2, bf16x8 pa3) {
  s16x4 L0, H0, L1, H1, L2, H2, L3, H3;
#define PK(L, H) (bf16x8){L[0], L[1], L[2], L[3], H[0], H[1], H[2], H[3]}
#define PVM(I, PA, L, H, CNT) do { pv_wait<CNT>(L, H); o[(I) >> 2] = __builtin_amdgcn_mfma_f32_32x32x16_bf16(PA, PK(L, H), o[(I) >> 2], 0, 0, 0); } while (0)
  pv_rd<0>(L0, H0, vb); pv_rd<1>(L1, H1, vb); pv_rd<2>(L2, H2, vb);
  PVM(0, pa0, L0, H0, 4);  pv_rd<3>(L3, H3, vb);
  PVM(1, pa1, L1, H1, 4);  pv_rd<4>(L0, H0, vb);
  PVM(2, pa2, L2, H2, 4);  pv_rd<5>(L1, H1, vb);
  PVM(3, pa3, L3, H3, 4);  pv_rd<6>(L2, H2, vb);
  PVM(4, pa0, L0, H0, 4);  pv_rd<7>(L3, H3, vb);
  PVM(5, pa1, L1, H1, 4);  pv_rd<8>(L0, H0, vb);
  PVM(6, pa2, L2, H2, 4);  pv_rd<9>(L1, H1, vb);
  PVM(7, pa3, L3, H3, 4);  pv_rd<10>(L2, H2, vb);
  PVM(8, pa0, L0, H0, 4);  pv_rd<11>(L3, H3, vb);
  PVM(9, pa1, L1, H1, 4);  pv_rd<12>(L0, H0, vb);
  PVM(10, pa2, L2, H2, 4); pv_rd<13>(L1, H1, vb);
  PVM(11, pa3, L3, H3, 4); pv_rd<14>(L2, H2, vb);
  PVM(12, pa0, L0, H0, 4); pv_rd<15>(L3, H3, vb);
  PVM(13, pa1, L1, H1, 4);
  PVM(14, pa2, L2, H2, 2);
  PVM(15, pa3, L3, H3, 0);
#undef PVM
#undef PK
}
constexpr int NSLOT = 4, NVSLOT = 5, KSLOT = 8192, VSLOT = 16384, LDS_K = 0, LDS_V = NSLOT * KSLOT, LDS_WS = LDS_V + NVSLOT * VSLOT, LDS_END = LDS_WS + NWAVES * 64 * 4;
static_assert(LDS_END <= RING_BYTES, "attention LDS");
constexpr float THR2 = 8.f;
__device__ __forceinline__ void glds16(const void* sbase, unsigned voff, unsigned lds_dst) { unsigned keep;
  asm volatile("s_mov_b32 %0, m0\n\ts_mov_b32 m0, %3\n\ts_nop 2\n\tglobal_load_lds_dwordx4 %1, %2\n\ts_mov_b32 m0, %0" : "=&s"(keep) : "v"(voff), "s"(sbase), "s"(lds_dst) : "memory"); }
#define WAIT_BAR(N) asm volatile("s_waitcnt vmcnt(" #N ") lgkmcnt(0)\n\ts_barrier" ::: "memory")
__device__ __forceinline__ float rowmax32(const f32x16& p0, const f32x16& p1) {
  float a = fmaxf(fmaxf(p0[0], p0[1]), p1[0]), b = fmaxf(fmaxf(p0[2], p0[3]), p1[1]); a = fmaxf(fmaxf(a, p1[2]), p1[3]);
#pragma unroll
  for (int r = 4; r < 16; r += 4) { a = fmaxf(fmaxf(a, p0[r]), p0[r + 1]); b = fmaxf(fmaxf(b, p0[r + 2]), p0[r + 3]); a = fmaxf(fmaxf(a, p1[r]), p1[r + 1]); b = fmaxf(fmaxf(b, p1[r + 2]), p1[r + 3]); }
  float m = fmaxf(a, b);
  auto rr = __builtin_amdgcn_permlane32_swap(__float_as_uint(m), __float_as_uint(m), false, false);
  return fmaxf(__uint_as_float(rr[0]), __uint_as_float(rr[1]));
}
template <bool FIRST> __device__ __forceinline__ void partialSM2(f32x16& p0, f32x16& p1, float& m_reg, f32x16& negm, float& alpha) {
  const float pmax = rowmax32(p0, p1);
  if (FIRST || !__builtin_expect(__all(pmax <= THR2), 1)) {
    const float dl = FIRST ? pmax : fmaxf(pmax, 0.f); m_reg += dl;
#pragma unroll
    for (int r = 0; r < 16; ++r) { p0[r] -= dl; p1[r] -= dl; }
#pragma unroll
    for (int r = 0; r < 16; ++r) negm[r] = -m_reg;
    alpha = FIRST ? 1.f : __builtin_amdgcn_exp2f(-dl);
  } else alpha = 1.f;
#pragma unroll
  for (int r = 0; r < 16; ++r) p0[r] = __builtin_amdgcn_exp2f(p0[r]);
}
__device__ __forceinline__ void qkt2(f32x16& p0, f32x16& p1, const char* Ks, const bf16x8* qr, const f32x16& negm, int r32, int hi) {
#pragma unroll
  for (int d0 = 0; d0 < 4; ++d0) { const int cb = (d0 * 16 + hi * 8) * 2;
    bf16x8 b0 = *reinterpret_cast<const bf16x8*>(Ks + KSWZ64(r32, cb));
    bf16x8 b1 = *reinterpret_cast<const bf16x8*>(Ks + KSWZ64(32 + r32, cb));
    if (d0 == 0) { p0 = __builtin_amdgcn_mfma_f32_32x32x16_bf16(b0, qr[0], negm, 0, 0, 0); p1 = __builtin_amdgcn_mfma_f32_32x32x16_bf16(b1, qr[0], negm, 0, 0, 0); }
    else { p0 = __builtin_amdgcn_mfma_f32_32x32x16_bf16(b0, qr[d0], p0, 0, 0, 0); p1 = __builtin_amdgcn_mfma_f32_32x32x16_bf16(b1, qr[d0], p1, 0, 0, 0); } }
}
__device__ __forceinline__ int swap23(int k) { return (k & ~0xC) | ((k & 4) << 1) | ((k & 8) >> 1); }
__device__ __forceinline__ void attn_body(const bf16_t* __restrict__ Qb, const bf16_t* __restrict__ Kh, const bf16_t* __restrict__ Vh, bf16_t* __restrict__ Ob, int seq, char* lds) {
  const int tid = opaque_tid(), wid = __builtin_amdgcn_readfirstlane(tid >> 6), lane = tid & 63, r32 = lane & 31, hi = lane >> 5;
  const unsigned lds0 = (unsigned)(uintptr_t)lds;
  const char* K_lds = lds + LDS_K;
  float* ws = (float*)(lds + LDS_WS) + wid * 64; float* li_l = ws; float* al_l = ws + 32;
  float m_reg = 0.f, l_reg = 0.f; f32x16 o[4] = {}; bf16x8 qr[4]; f32x16 negm = {};
  const bf16_t* Qw = Qb + (long)(wid * QBLK + r32) * LDX + hi * 8;
  asm volatile("global_load_dwordx4 %0, %4, off\n\tglobal_load_dwordx4 %1, %4, off offset:32\n\tglobal_load_dwordx4 %2, %4, off offset:64\n\tglobal_load_dwordx4 %3, %4, off offset:96"
               : "=&v"(qr[0]), "=&v"(qr[1]), "=&v"(qr[2]), "=&v"(qr[3]) : "v"(Qw) : "memory");
  const int rowK = tid >> 3, cK = (tid & 7) ^ ((rowK >> 1) & 7);
  const unsigned ksrc = (unsigned)(rowK * LDX + cK * 8) * 2u;
  const int U0 = tid, U1 = 512 + tid;
  const int sub0 = U0 >> 5, sub1 = U1 >> 5;
  const unsigned vsrc0 = (unsigned)(((sub0 >> 2) * 8 + ((U0 >> 2) & 7)) * LDX + (sub0 & 3) * 32 + (U0 & 3) * 8) * 2u;
  const unsigned vsrc1 = (unsigned)(((sub1 >> 2) * 8 + ((U1 >> 2) & 7)) * LDX + (sub1 & 3) * 32 + (U1 & 3) * 8) * 2u;
  const unsigned kdst = lds0 + LDS_K + wid * 1024, vdst = lds0 + LDS_V + wid * 1024;
#define DMA(t) do { const unsigned sl_ = (unsigned)((t) & 3), sv_ = (unsigned)((t) % NVSLOT); const long go_ = (long)(t) * KVBLK * LDX; \
    glds16(Kh + go_, ksrc, (unsigned)__builtin_amdgcn_readfirstlane(kdst + sl_ * KSLOT)); glds16(Vh + go_, vsrc0, (unsigned)__builtin_amdgcn_readfirstlane(vdst + sv_ * VSLOT)); \
    glds16(Vh + go_, vsrc1, (unsigned)__builtin_amdgcn_readfirstlane(vdst + sv_ * VSLOT + 8192)); } while (0)
#define RESC(a) do { if (__any((a) < 1.f)) { if (hi == 0) al_l[r32] = (a); asm volatile("s_waitcnt lgkmcnt(0)" ::: "memory"); \
    _Pragma("unroll") for (int d = 0; d < 4; ++d) _Pragma("unroll") for (int r = 0; r < 16; ++r) o[d][r] *= al_l[crow(r, hi)]; } } while (0)
  const int vb0 = (int)(lds0 + LDS_V) + v_rd_base(lane);
  f32x16 pA0, pA1, pB0, pB1; float alA, alB; bf16x8 pa0, pa1, pa2, pa3; const int NT = seq / KVBLK;
  if (wid < 4) __builtin_amdgcn_s_setprio(3);
  DMA(0); DMA(1);
  asm volatile("s_waitcnt vmcnt(6)" : "+v"(qr[0]), "+v"(qr[1]), "+v"(qr[2]), "+v"(qr[3]) :: "memory");
  WAIT_BAR(3);
  DMA(2);
#define VSL(t) ((int)((t) % NVSLOT) * VSLOT)
  if (wid < 4) {
    qkt2(pA0, pA1, K_lds, qr, negm, r32, hi); partialSM2<true>(pA0, pA1, m_reg, negm, alA);
#define STEP(C0, C1, alC, P0, P1, alP, jj, WN) do { WAIT_BAR(WN); if ((jj) + 2 < NT) DMA((jj) + 2); \
      SBAR(); qkt2(C0, C1, K_lds + ((jj) & 3) * KSLOT, qr, negm, r32, hi); finishSM(P0, P1, alP, l_reg, pa0, pa1, pa2, pa3); SBAR(); \
      pv_d0(o, vb0 + VSL((jj) - 1), pa0, pa1, pa2, pa3); partialSM2<false>(C0, C1, m_reg, negm, alC); RESC(alC); } while (0)
    int j = 1;
    for (; j + 1 < NT; j += 2) { STEP(pB0, pB1, alB, pA0, pA1, alA, j, 3); STEP(pA0, pA1, alA, pB0, pB1, alB, j + 1, 3); }
    STEP(pB0, pB1, alB, pA0, pA1, alA, NT - 1, 0);
#undef STEP
  } else {
    qkt2(pA0, pA1, K_lds, qr, negm, r32, hi);
    WAIT_BAR(3); if (3 < NT) DMA(3);
    partialSM2<true>(pA0, pA1, m_reg, negm, alA);
    SBAR(); qkt2(pB0, pB1, K_lds + KSLOT, qr, negm, r32, hi); finishSM(pA0, pA1, alA, l_reg, pa0, pa1, pa2, pa3); SBAR();
#define STEPL(C0, C1, P0, P1, alP, jj, WN) do { WAIT_BAR(WN); if ((jj) + 2 < NT) DMA((jj) + 2); \
      pv_d0(o, vb0 + VSL((jj) - 2), pa0, pa1, pa2, pa3); partialSM2<false>(P0, P1, m_reg, negm, alP); RESC(alP); \
      SBAR(); qkt2(C0, C1, K_lds + ((jj) & 3) * KSLOT, qr, negm, r32, hi); finishSM(P0, P1, alP, l_reg, pa0, pa1, pa2, pa3); SBAR(); } while (0)
    int j = 2;
    for (; j + 2 < NT; j += 2) { STEPL(pA0, pA1, pB0, pB1, alB, j, 3); STEPL(pB0, pB1, pA0, pA1, alA, j + 1, 3); }
    STEPL(pA0, pA1, pB0, pB1, alB, NT - 2, 3); STEPL(pB0, pB1, pA0, pA1, alA, NT - 1, 0);
#undef STEPL
    pv_d0(o, vb0 + VSL(NT - 2), pa0, pa1, pa2, pa3); partialSM2<false>(pB0, pB1, m_reg, negm, alB); RESC(alB);
  }
  finishSM(pB0, pB1, alB, l_reg, pa0, pa1, pa2, pa3); SBAR();
  pv_d0(o, vb0 + VSL(NT - 1), pa0, pa1, pa2, pa3);
#undef VSL
  if (hi == 0) li_l[r32] = l_reg; asm volatile("s_waitcnt lgkmcnt(0)" ::: "memory");
  float rli[16];
#pragma unroll
  for (int r = 0; r < 16; ++r) rli[r] = __builtin_amdgcn_rcpf(li_l[crow(r, hi)]);
  bf16_t* Ow = Ob + (long)(wid * QBLK) * 2048;
#pragma unroll
  for (int r = 0; r < 16; ++r) { const int orow = crow(r, hi);
#pragma unroll
    for (int d0 = 0; d0 < 4; ++d0) Ow[(long)orow * 2048 + d0 * 32 + r32] = (bf16_t)f2bf(o[d0][r] * rli[r]); }
  __builtin_amdgcn_s_setprio(0);
  asm volatile("s_waitcnt lgkmcnt(0)\n\ts_barrier" ::: "memory");
#undef DMA
#undef RESC
#undef STEP
}
#undef WAIT_BAR
#undef SBAR
}

__device__ __forceinline__ int pos_f(int jb) { return jb < 256 ? 4 + jb : jb - 256; }
__device__ __forceinline__ int pos_b(int jb) { return jb < 256 ? 4 + 255 - jb : 3 - (jb - 256); }
constexpr int KP = 72;
constexpr int QP = 136;
__device__ __forceinline__ bf16x8 lds_frag(const LAS unsigned char* base, int row, int pitch, int col) { return *(const LAS bf16x8*)(base + ((size_t)row * pitch + col) * 2); }

__device__ __forceinline__ void conv_silu8(u32x4 xm, u32x4 x0, u32x4 xp, const float* cw  , float scale, float (&o)[8]) {
    const f32x4 w0a = *(const f32x4*)(cw), w0b = *(const f32x4*)(cw + 4), w1a = *(const f32x4*)(cw + 1024), w1b = *(const f32x4*)(cw + 1028), w2a = *(const f32x4*)(cw + 2048), w2b = *(const f32x4*)(cw + 2052);
    const float w0[8] = {w0a.x, w0a.y, w0a.z, w0a.w, w0b.x, w0b.y, w0b.z, w0b.w}, w1[8] = {w1a.x, w1a.y, w1a.z, w1a.w, w1b.x, w1b.y, w1b.z, w1b.w}, w2[8] = {w2a.x, w2a.y, w2a.z, w2a.w, w2b.x, w2b.y, w2b.z, w2b.w};
    const unsigned am[4] = {xm.x, xm.y, xm.z, xm.w}, a0[4] = {x0.x, x0.y, x0.z, x0.w}, ap[4] = {xp.x, xp.y, xp.z, xp.w};
#pragma unroll
    for (int e = 0; e < 8; ++e) { const unsigned sh = (e & 1) * 16;
        const float vm = bf2f((am[e >> 1] >> sh) & 0xffffu), v0 = bf2f((a0[e >> 1] >> sh) & 0xffffu), vp = bf2f((ap[e >> 1] >> sh) & 0xffffu);
        o[e] = siluf_(vm * w0[e] + v0 * w1[e] + vp * w2[e]) * scale; }
}

struct MlstmArgs { const bf16_t* QKM; const bf16_t* VM; const bf16_t* OMS; const float* GATES; const float* conv; const float* norm_m; const unsigned* mstab;
                   bf16_t* ST; float* NU; float* ADEC; bf16_t* HM; };

__device__ __forceinline__ void mlstm_gates(const MlstmArgs& A, int bh, int row0, int lane, float& bfv, float& bbv, float& ifm, float& ibm, float& bend_f, float& bend_b) {
    const f32x4 g0 = *(const f32x4*)(A.GATES + (size_t)(row0 + lane) * 16), g1 = *(const f32x4*)(A.GATES + (size_t)(row0 + lane) * 16 + 4),
                g2 = *(const f32x4*)(A.GATES + (size_t)(row0 + lane) * 16 + 8), g3 = *(const f32x4*)(A.GATES + (size_t)(row0 + lane) * 16 + 12);
    const int h = bh & 3;
    const float i_f = h == 0 ? g0.x : h == 1 ? g0.y : h == 2 ? g0.z : g0.w, f_f = h == 0 ? g1.x : h == 1 ? g1.y : h == 2 ? g1.z : g1.w;
    const float i_b = h == 0 ? g2.x : h == 1 ? g2.y : h == 2 ? g2.z : g2.w, f_b = h == 0 ? g3.x : h == 1 ? g3.y : h == 2 ? g3.z : g3.w;
    float inc = logsigf_(f_f), suf = logsigf_(f_b);
#pragma unroll
    for (int o = 1; o < 64; o <<= 1) { const float t = __shfl_up(inc, o); if (lane >= o) inc += t; }
#pragma unroll
    for (int o = 1; o < 64; o <<= 1) { const float t = __shfl_down(suf, o); if (lane + o < 64) suf += t; }
    bend_f = __shfl(inc, 63); bend_b = __shfl(suf, 0);
    const float Mf = __uint_as_float(__hip_atomic_load(A.mstab + bh * 2 + 0, RLX_AGENT)), Mb = __uint_as_float(__hip_atomic_load(A.mstab + bh * 2 + 1, RLX_AGENT));
    bfv = inc; bbv = suf; ifm = i_f - Mf; ibm = i_b - Mb;
}
__device__ __forceinline__ void mlstm_stage_vt(const MlstmArgs& A, int h, int row0, LAS unsigned char* VT, int tid) {
#pragma unroll
    for (int i = 0; i < 4; ++i) { const int p = tid + 512 * i, s = p & 63, ec = p >> 6;
        const u32x4 v = *(const u32x4*)(A.VM + (size_t)(row0 + s) * 1024 + h * 256 + ec * 8);
        const unsigned a[4] = {v.x, v.y, v.z, v.w};
#pragma unroll
        for (int e = 0; e < 8; ++e) *(LAS bf16_t*)(VT + ((size_t)(ec * 8 + e) * KP + s) * 2) = (bf16_t)((a[e >> 1] >> ((e & 1) * 16)) & 0xffffu); }
}
__device__ __forceinline__ void mlstm_load3(const bf16_t* QKM, int row0, int s, int ch, bool hasL, bool hasR, u32x4& xm, u32x4& x0, u32x4& xp) {
    const bf16_t* p = QKM + (size_t)(row0 + s) * 1024 + ch;
    x0 = *(const u32x4*)p;
    xm = (s > 0 || hasL) ? *(const u32x4*)(p - 1024) : (u32x4){0u, 0u, 0u, 0u};
    xp = (s < 63 || hasR) ? *(const u32x4*)(p + 1024) : (u32x4){0u, 0u, 0u, 0u};
}

__device__ __forceinline__ void mlstm_d1_unit(const MlstmArgs& A, int bh, int jb, LAS unsigned char* lds) {
    const int tid = opaque_tid(), lane = tid & 63, wave = __builtin_amdgcn_readfirstlane(tid >> 6), fr = lane & 15, fq = lane >> 4;
    const int b = bh >> 2, h = bh & 3, row0 = b * TPB + jb * 64;
    const bool hasL = !(jb == 0 || jb == 256), hasR = !(jb == 255 || jb == 259);
    LAS float* WF = (LAS float*)lds; LAS float* WB = WF + 64;
    LAS unsigned char* KF = lds + 512; LAS unsigned char* KB = KF + 128 * KP * 2; LAS unsigned char* VT = KB + 128 * KP * 2;
    const int cf = bh * 2, cb = bh * 2 + 1, pf = pos_f(jb), pb = pos_b(jb);
    u32x4 xm_[2], x0_[2], xp_[2];
#pragma unroll
    for (int i = 0; i < 2; ++i) { const int p = tid + 512 * i, s = p & 63, dc = p >> 6; mlstm_load3(A.QKM, row0, s, 512 + h * 128 + dc * 8, hasL, hasR, xm_[i], x0_[i], xp_[i]); }
    mlstm_stage_vt(A, h, row0, VT, tid);
    if (wave == 0) {
        float bfv, bbv, ifm, ibm, bend_f, bend_b; mlstm_gates(A, bh, row0, lane, bfv, bbv, ifm, ibm, bend_f, bend_b);
        WF[lane] = __expf(bend_f - bfv + ifm); WB[lane] = __expf(bend_b - bbv + ibm);
        if (lane == 0) { st_wt(A.ADEC + cf * NCHUNK + pf, __expf(bend_f)); st_wt(A.ADEC + cb * NCHUNK + pb, __expf(bend_b)); }
    }
    __syncthreads();
#pragma unroll
    for (int i = 0; i < 2; ++i) { const int p = tid + 512 * i, s = p & 63, dc = p >> 6; const int ch = 512 + h * 128 + dc * 8;
        const u32x4 xm = xm_[i], x0 = x0_[i], xp = xp_[i];
        float k[8]; conv_silu8(xm, x0, xp, A.conv + ch, 0.08838834764831845f, k);
        const float wf = WF[s], wb = WB[s];
#pragma unroll
        for (int e = 0; e < 8; ++e) { *(LAS bf16_t*)(KF + ((size_t)(dc * 8 + e) * KP + s) * 2) = (bf16_t)f2bf(k[e] * wf); *(LAS bf16_t*)(KB + ((size_t)(dc * 8 + e) * KP + s) * 2) = (bf16_t)f2bf(k[e] * wb); } }
    __syncthreads();
    if (tid < 256) { const int dir = tid >> 7, d = tid & 127; const LAS unsigned char* src = (dir ? KB : KF) + (size_t)d * KP * 2; float s = 0.f;
#pragma unroll 8
        for (int i = 0; i < 64; ++i) s += bf2f(*(const LAS bf16_t*)(src + i * 2));
        A.NU[((size_t)(dir ? cb : cf) * NCHUNK + (dir ? pb : pf)) * 128 + d] = s; }
#pragma unroll
    for (int dir = 0; dir < 2; ++dir) {
        const LAS unsigned char* KW = dir ? KB : KF;
        f32x4 acc[8][2];
#pragma unroll
        for (int m = 0; m < 8; ++m) { acc[m][0] = (f32x4){0.f, 0.f, 0.f, 0.f}; acc[m][1] = (f32x4){0.f, 0.f, 0.f, 0.f}; }
#pragma unroll
        for (int ks = 0; ks < 2; ++ks) {
            const bf16x8 b0 = lds_frag(VT, (2 * wave) * 16 + fr, KP, ks * 32 + fq * 8), b1 = lds_frag(VT, (2 * wave + 1) * 16 + fr, KP, ks * 32 + fq * 8);
#pragma unroll
            for (int m = 0; m < 8; ++m) { const bf16x8 a = lds_frag(KW, m * 16 + fr, KP, ks * 32 + fq * 8);
                acc[m][0] = __builtin_amdgcn_mfma_f32_16x16x32_bf16(a, b0, acc[m][0], 0, 0, 0); acc[m][1] = __builtin_amdgcn_mfma_f32_16x16x32_bf16(a, b1, acc[m][1], 0, 0, 0); } }
        bf16_t* dst = A.ST + ((size_t)(dir ? cb : cf) * NCHUNK + (dir ? pb : pf)) * 32768;
#pragma unroll
        for (int m = 0; m < 8; ++m)
#pragma unroll
            for (int n = 0; n < 2; ++n) { const int e = (2 * wave + n) * 16 + fr, d0 = m * 16 + fq * 4; *(u32x2*)(dst + (size_t)e * 128 + d0) = pk4(acc[m][n]); }
    }
    __syncthreads();
}

__device__ __forceinline__ void mlstm_scan(const MlstmArgs& A, int gtid, int nthreads, bf16_t* dryST = nullptr, float* dryNU = nullptr) {
    constexpr int PF = 20;
    for (int it = gtid; it < NCHAIN * 8192; it += nthreads) {
        const int chain = it >> 13, e4 = (it & 8191) * 4; bf16_t* __restrict__ p = A.ST + (size_t)chain * NCHUNK * 32768 + e4; const float* __restrict__ ad = A.ADEC + chain * NCHUNK;
        f32x4 s = (f32x4){0.f, 0.f, 0.f, 0.f};
        for (int c0 = 0; c0 < NCHUNK; c0 += PF) {
            u32x2 u[PF]; float a[PF];
#pragma unroll
            for (int i = 0; i < PF; ++i) { u[i] = __builtin_nontemporal_load((const u32x2*)(p + (size_t)(c0 + i) * 32768)); a[i] = ad[c0 + i]; }
#pragma unroll
            for (int i = 0; i < PF; ++i) { *(u32x2*)((dryST ? dryST + (p - A.ST) : p) + (size_t)(c0 + i) * 32768) = pk4(s); s = s * a[i] + unpk4(u[i]); }
        }
    }
    for (int it = gtid; it < NCHAIN * 128; it += nthreads) {
        const int chain = it >> 7, d = it & 127; float* __restrict__ p = A.NU + (size_t)chain * NCHUNK * 128 + d; const float* __restrict__ ad = A.ADEC + chain * NCHUNK; float s = 0.f;
        for (int c0 = 0; c0 < NCHUNK; c0 += PF) {
            float u[PF], a[PF];
#pragma unroll
            for (int i = 0; i < PF; ++i) { u[i] = p[(c0 + i) * 128]; a[i] = ad[c0 + i]; }
#pragma unroll
            for (int i = 0; i < PF; ++i) { (dryNU ? dryNU + (p - A.NU) : p)[(c0 + i) * 128] = s; s = s * a[i] + u[i]; }
        }
    }
}

constexpr int D3_G = 0, D3_Q = 4096, D3_QF = D3_Q + 64 * QP * 2, D3_QB = D3_QF + 64 * QP * 2, D3_KT = D3_QB + 64 * QP * 2, D3_VT = D3_KT + 64 * QP * 2, D3_PF = D3_VT + 256 * KP * 2, D3_PB = D3_PF + 64 * KP * 2, D3_END = D3_PB + 64 * KP * 2;
static_assert(D3_END + 1024 <= RING_BYTES, "mLSTM D3 LDS");
__device__ __forceinline__ void mlstm_d3_unit(const MlstmArgs& A, int bh, int jb, LAS unsigned char* lds) {
    const int tid = opaque_tid(), lane = tid & 63, wave = __builtin_amdgcn_readfirstlane(tid >> 6), fr = lane & 15, fq = lane >> 4;
    const int b = bh >> 2, h = bh & 3, row0 = b * TPB + jb * 64;
    const bool hasL = !(jb == 0 || jb == 256), hasR = !(jb == 255 || jb == 259);
    LAS float* GF = (LAS float*)(lds + D3_G);
    LAS float* BF = GF, *BB = GF + 64, *IFM = GF + 128, *IBM = GF + 192, *EBF = GF + 256, *EBB = GF + 320, *DEN = GF + 384, *RS = GF + 512;
    LAS float* NPV = (LAS float*)(lds + D3_END);
    LAS unsigned char* Qs = lds + D3_Q; LAS unsigned char* QF = lds + D3_QF; LAS unsigned char* QB = lds + D3_QB; LAS unsigned char* KT = lds + D3_KT;
    LAS unsigned char* VT = lds + D3_VT; LAS unsigned char* PF = lds + D3_PF; LAS unsigned char* PB = lds + D3_PB;
    const int cf = bh * 2, cb = bh * 2 + 1, pf = pos_f(jb), pb = pos_b(jb);
    const float Mf = __uint_as_float(__hip_atomic_load(A.mstab + bh * 2 + 0, RLX_AGENT)), Mb = __uint_as_float(__hip_atomic_load(A.mstab + bh * 2 + 1, RLX_AGENT));
    u32x4 xm_[4], x0_[4], xp_[4];
#pragma unroll
    for (int i = 0; i < 4; ++i) { const int p = tid + 512 * i, dc = p & 15, s = (p >> 4) & 63, isk = p >> 10; mlstm_load3(A.QKM, row0, s, isk * 512 + h * 128 + dc * 8, hasL, hasR, xm_[i], x0_[i], xp_[i]); }
    mlstm_stage_vt(A, h, row0, VT, tid);
    if (wave == 0) {
        float bfv, bbv, ifm, ibm, bend_f, bend_b; mlstm_gates(A, bh, row0, lane, bfv, bbv, ifm, ibm, bend_f, bend_b);
        BF[lane] = bfv; BB[lane] = bbv; IFM[lane] = ifm; IBM[lane] = ibm; EBF[lane] = __expf(bfv); EBB[lane] = __expf(bbv);
    } else if (tid >= 256) { const int dir = (tid >> 7) & 1, d = tid & 127; NPV[dir * 128 + d] = A.NU[((size_t)(dir ? cb : cf) * NCHUNK + (dir ? pb : pf)) * 128 + d]; }
    __syncthreads();
#pragma unroll
    for (int i = 0; i < 4; ++i) { const int p = tid + 512 * i, dc = p & 15, s = (p >> 4) & 63, isk = p >> 10; const int ch = isk * 512 + h * 128 + dc * 8;
        const u32x4 xm = xm_[i], x0 = x0_[i], xp = xp_[i];
        float v[8]; conv_silu8(xm, x0, xp, A.conv + ch, isk ? 0.08838834764831845f : 1.f, v);
        if (isk) { u32x4 w; w.x = pk2(v[0], v[1]); w.y = pk2(v[2], v[3]); w.z = pk2(v[4], v[5]); w.w = pk2(v[6], v[7]); *(LAS u32x4*)(KT + ((size_t)s * QP + dc * 8) * 2) = w; }
        else { const float ef = EBF[s], eb = EBB[s]; u32x4 w;
            w.x = pk2(v[0], v[1]); w.y = pk2(v[2], v[3]); w.z = pk2(v[4], v[5]); w.w = pk2(v[6], v[7]); *(LAS u32x4*)(Qs + ((size_t)s * QP + dc * 8) * 2) = w;
            w.x = pk2(v[0] * ef, v[1] * ef); w.y = pk2(v[2] * ef, v[3] * ef); w.z = pk2(v[4] * ef, v[5] * ef); w.w = pk2(v[6] * ef, v[7] * ef); *(LAS u32x4*)(QF + ((size_t)s * QP + dc * 8) * 2) = w;
            w.x = pk2(v[0] * eb, v[1] * eb); w.y = pk2(v[2] * eb, v[3] * eb); w.z = pk2(v[4] * eb, v[5] * eb); w.w = pk2(v[6] * eb, v[7] * eb); *(LAS u32x4*)(QB + ((size_t)s * QP + dc * 8) * 2) = w; } }
    __syncthreads();
    {
        const int mt = wave >> 1, nt0 = (wave & 1) * 2;
        f32x4 S0 = (f32x4){0.f, 0.f, 0.f, 0.f}, S1 = S0;
#pragma unroll
        for (int ks = 0; ks < 4; ++ks) { const bf16x8 a = lds_frag(Qs, mt * 16 + fr, QP, ks * 32 + fq * 8);
            S0 = __builtin_amdgcn_mfma_f32_16x16x32_bf16(a, lds_frag(KT, nt0 * 16 + fr, QP, ks * 32 + fq * 8), S0, 0, 0, 0);
            S1 = __builtin_amdgcn_mfma_f32_16x16x32_bf16(a, lds_frag(KT, (nt0 + 1) * 16 + fr, QP, ks * 32 + fq * 8), S1, 0, 0, 0); }
#pragma unroll
        for (int n = 0; n < 2; ++n) { const int s = (nt0 + n) * 16 + fr; const float bfs = BF[s], bbs = BB[s], ifs = IFM[s], ibs = IBM[s];
#pragma unroll
            for (int r = 0; r < 4; ++r) { const int t = mt * 16 + fq * 4 + r; const float sv = n ? S1[r] : S0[r];
                const float pf_ = (s <= t) ? sv * __expf(BF[t] - bfs + ifs) : 0.f, pb_ = (s >= t) ? sv * __expf(BB[t] - bbs + ibs) : 0.f;
                *(LAS bf16_t*)(PF + ((size_t)t * KP + s) * 2) = (bf16_t)f2bf(pf_); *(LAS bf16_t*)(PB + ((size_t)t * KP + s) * 2) = (bf16_t)f2bf(pb_); } }
    }
    __syncthreads();
    {
        const int t = tid >> 3, part = tid & 7;
        const u32x4 pfv = *(const LAS u32x4*)(PF + ((size_t)t * KP + part * 8) * 2), pbv = *(const LAS u32x4*)(PB + ((size_t)t * KP + part * 8) * 2);
        const u32x4 q0v = *(const LAS u32x4*)(Qs + ((size_t)t * QP + part * 16) * 2), q1v = *(const LAS u32x4*)(Qs + ((size_t)t * QP + part * 16 + 8) * 2);
        const unsigned pw[4] = {pfv.x, pfv.y, pfv.z, pfv.w}, pwb[4] = {pbv.x, pbv.y, pbv.z, pbv.w}, qw[8] = {q0v.x, q0v.y, q0v.z, q0v.w, q1v.x, q1v.y, q1v.z, q1v.w};
        float sf = 0.f, sb = 0.f, dqf = 0.f, dqb = 0.f;
#pragma unroll
        for (int i = 0; i < 4; ++i) { sf += bf2f(pw[i] & 0xffffu) + bf2f(pw[i] >> 16); sb += bf2f(pwb[i] & 0xffffu) + bf2f(pwb[i] >> 16); }
#pragma unroll
        for (int i = 0; i < 8; ++i) { const float qa = bf2f(qw[i] & 0xffffu), qb2 = bf2f(qw[i] >> 16); const int d = part * 16 + 2 * i;
            dqf += qa * NPV[d] + qb2 * NPV[d + 1]; dqb += qa * NPV[128 + d] + qb2 * NPV[128 + d + 1]; }
#pragma unroll
        for (int o = 1; o < 8; o <<= 1) { sf += __shfl_xor(sf, o); sb += __shfl_xor(sb, o); dqf += __shfl_xor(dqf, o); dqb += __shfl_xor(dqb, o); }
        if (part == 0) { DEN[t] = fmaxf(fabsf(sf + EBF[t] * dqf), __expf(-Mf)); DEN[64 + t] = fmaxf(fabsf(sb + EBB[t] * dqb), __expf(-Mb)); }
    }
    f32x4 acc[2][2][4];
#pragma unroll
    for (int dir = 0; dir < 2; ++dir) {
        const LAS unsigned char* P = dir ? PB : PF; const LAS unsigned char* QD = dir ? QB : QF;
        const bf16_t* CT = A.ST + ((size_t)(dir ? cb : cf) * NCHUNK + (dir ? pb : pf)) * 32768;
#pragma unroll
        for (int m = 0; m < 2; ++m)
#pragma unroll
            for (int n = 0; n < 4; ++n) acc[dir][m][n] = (f32x4){0.f, 0.f, 0.f, 0.f};
#pragma unroll
        for (int ks = 0; ks < 2; ++ks) {
            const bf16x8 a0 = lds_frag(VT, (2 * wave) * 16 + fr, KP, ks * 32 + fq * 8), a1 = lds_frag(VT, (2 * wave + 1) * 16 + fr, KP, ks * 32 + fq * 8);
#pragma unroll
            for (int n = 0; n < 4; ++n) { const bf16x8 bq = lds_frag(P, n * 16 + fr, KP, ks * 32 + fq * 8);
                acc[dir][0][n] = __builtin_amdgcn_mfma_f32_16x16x32_bf16(a0, bq, acc[dir][0][n], 0, 0, 0); acc[dir][1][n] = __builtin_amdgcn_mfma_f32_16x16x32_bf16(a1, bq, acc[dir][1][n], 0, 0, 0); } }
#pragma unroll
        for (int ks = 0; ks < 4; ++ks) {
            const bf16x8 a0 = *(const bf16x8*)(CT + (size_t)((2 * wave) * 16 + fr) * 128 + ks * 32 + fq * 8), a1 = *(const bf16x8*)(CT + (size_t)((2 * wave + 1) * 16 + fr) * 128 + ks * 32 + fq * 8);
#pragma unroll
            for (int n = 0; n < 4; ++n) { const bf16x8 bq = lds_frag(QD, n * 16 + fr, QP, ks * 32 + fq * 8);
                acc[dir][0][n] = __builtin_amdgcn_mfma_f32_16x16x32_bf16(a0, bq, acc[dir][0][n], 0, 0, 0); acc[dir][1][n] = __builtin_amdgcn_mfma_f32_16x16x32_bf16(a1, bq, acc[dir][1][n], 0, 0, 0); } }
    }
    __syncthreads();
    f32x4 gq[2]; u32x2 ogq[4][2];
#pragma unroll
    for (int m = 0; m < 2; ++m) gq[m] = *(const f32x4*)(A.norm_m + h * 256 + (2 * wave + m) * 16 + fq * 4);
#pragma unroll
    for (int n = 0; n < 4; ++n)
#pragma unroll
        for (int m = 0; m < 2; ++m) ogq[n][m] = *(const u32x2*)(A.OMS + (size_t)(row0 + n * 16 + fr) * 1024 + h * 256 + (2 * wave + m) * 16 + fq * 4);
    f32x4 hv[2][4];
#pragma unroll
    for (int n = 0; n < 4; ++n) { const int t = n * 16 + fr; const float rf = 1.f / DEN[t], rb = 1.f / DEN[64 + t]; float ss = 0.f;
#pragma unroll
        for (int m = 0; m < 2; ++m) { hv[m][n] = acc[0][m][n] * rf + acc[1][m][n] * rb; ss += hv[m][n].x * hv[m][n].x + hv[m][n].y * hv[m][n].y + hv[m][n].z * hv[m][n].z + hv[m][n].w * hv[m][n].w; }
        ss += __shfl_xor(ss, 16); ss += __shfl_xor(ss, 32);
        if (fq == 0) RS[wave * 64 + t] = ss; }
    __syncthreads();
#pragma unroll
    for (int n = 0; n < 4; ++n) { const int t = n * 16 + fr; float ss = 0.f;
#pragma unroll
        for (int w = 0; w < 8; ++w) ss += RS[w * 64 + t];
        const float rstd = 1.f / sqrtf(ss * (1.f / 256.f) + RMS_EPS);
#pragma unroll
        for (int m = 0; m < 2; ++m) { const int e0 = (2 * wave + m) * 16 + fq * 4; const size_t o = (size_t)(row0 + t) * 1024 + h * 256 + e0;
            *(u32x2*)(A.HM + o) = pk4(hv[m][n] * rstd * gq[m] * unpk4(ogq[n][m])); } }
    __syncthreads();
}

__device__ __forceinline__ void tr_load(const float* W, size_t ldw, int k0, int n0, int nvalid, LAS float* scr, int lane) {
#pragma unroll 8
    for (int i = 0; i < 32; ++i) { const int kk = 2 * i + (lane >> 5), n = lane & 31; scr[kk * 33 + n] = (n < nvalid) ? W[(size_t)(k0 + kk) * ldw + n0 + n] : 0.f; }
    LDS_WAIT(); asm volatile("" ::: "memory");
}
__device__ __forceinline__ int perm32(int n) { return (n & ~31) | (((n >> 2) & 1) << 4) | (((n >> 3) & 3) << 2) | (n & 3); }
template <int MODE  >
__device__ __forceinline__ void tr_store(bf16_t* WT, size_t ldt, int drow0, int dcol0, int nvalid, const LAS float* scr, int lane, bool perm = false) {
    const int c = lane & 7;
#pragma unroll
    for (int j = 0; j < 4; ++j) { const int n = (lane >> 3) + 8 * j; const LAS float* s = scr + (8 * c) * 33 + n; float v[8];
#pragma unroll
        for (int e = 0; e < 8; ++e) { v[e] = s[e * 33]; if (MODE == 1) v[e] = v[e] - bf2f(f2bf(v[e])); }
        u32x4 o; o.x = pk2(v[0], v[1]); o.y = pk2(v[2], v[3]); o.z = pk2(v[4], v[5]); o.w = pk2(v[6], v[7]);
        if (n < nvalid) *(u32x4*)(WT + (size_t)(drow0 + (perm ? perm32(n) : n)) * ldt + dcol0 + 8 * c) = o; }
}

__device__ __forceinline__ void tr_load64(const float* W, size_t ldw, int k0, int n0, LAS float* scr, int lane) {
    float v[64];
    const float* p = W + (size_t)k0 * ldw + n0 + lane;
#pragma unroll
    for (int i = 0; i < 64; ++i) v[i] = __builtin_nontemporal_load(p + (size_t)i * ldw);
#pragma unroll
    for (int i = 0; i < 64; ++i) scr[i * 65 + lane] = v[i];
    LDS_WAIT(); asm volatile("" ::: "memory");
}
template <bool PERM = false>
__device__ __forceinline__ void tr_store64(bf16_t* WT, size_t ldt, int drow0, int dcol0, const LAS float* scr, int lane) {
    const int c = lane & 7;
#pragma unroll
    for (int j = 0; j < 8; ++j) { const int nl = (lane >> 3) + 8 * j; const LAS float* s = scr + (8 * c) * 65 + nl; const int n = PERM ? perm32(nl) : nl;
        u32x4 o; o.x = pk2(s[0], s[65]); o.y = pk2(s[2 * 65], s[3 * 65]); o.z = pk2(s[4 * 65], s[5 * 65]); o.w = pk2(s[6 * 65], s[7 * 65]);
        *(u32x4*)(WT + (size_t)(drow0 + n) * ldt + dcol0 + 8 * c) = o; }
    LDS_WAIT(); asm volatile("" ::: "memory");
}
struct KArgs { const float* in[25]; float* out; unsigned char* ws; int dbg; int pad; };

__device__ __forceinline__ void ln_row(f32x4 (&v)[4], const float* g, const float* bta, int lane) {
    float s = 0.f;
#pragma unroll
    for (int j = 0; j < 4; ++j) s += (v[j].x + v[j].y) + (v[j].z + v[j].w);
    const float mean = wave_sum(s) * (1.f / 1024.f); float s2 = 0.f;
#pragma unroll
    for (int j = 0; j < 4; ++j) { v[j] = v[j] - mean; s2 += (v[j].x * v[j].x + v[j].y * v[j].y) + (v[j].z * v[j].z + v[j].w * v[j].w); }
    const float rstd = 1.f / sqrtf(wave_sum(s2) * (1.f / 1024.f) + LN_EPS);
#pragma unroll
    for (int j = 0; j < 4; ++j) { const f32x4 gg = *(const f32x4*)(g + 4 * lane + 256 * j), bb = *(const f32x4*)(bta + 4 * lane + 256 * j); v[j] = v[j] * rstd * gg + bb; }
}

#define C8(j) (8 * lane + 512 * ((j) >> 1) + 4 * ((j) & 1))
__device__ __forceinline__ void ln_row8(f32x4 (&v)[4], const float* g, const float* bta, int lane) {
    float s = 0.f;
#pragma unroll
    for (int j = 0; j < 4; ++j) s += (v[j].x + v[j].y) + (v[j].z + v[j].w);
    const float mean = wave_sum(s) * (1.f / 1024.f); float s2 = 0.f;
#pragma unroll
    for (int j = 0; j < 4; ++j) { v[j] = v[j] - mean; s2 += (v[j].x * v[j].x + v[j].y * v[j].y) + (v[j].z * v[j].z + v[j].w * v[j].w); }
    const float rstd = 1.f / sqrtf(wave_sum(s2) * (1.f / 1024.f) + LN_EPS);
#pragma unroll
    for (int j = 0; j < 4; ++j) { const f32x4 gg = *(const f32x4*)(g + C8(j)), bb = *(const f32x4*)(bta + C8(j)); v[j] = v[j] * rstd * gg + bb; }
}

#define AS4 __attribute__((address_space(4)))
__device__ __forceinline__ const char AS4* kargp() { const char AS4* p = (const char AS4*)__builtin_amdgcn_kernarg_segment_ptr(); asm volatile("" : "+s"(p)); return p; }
#define INP(k) (*(const float* const AS4*)(kargp() + 8 * (k)))
#define OUTP() (*(float* const AS4*)(kargp() + 200))
#define WSB() (*(unsigned char* const AS4*)(kargp() + 208))
enum { I_X = 0, I_C, I_CTX, I_CCTX, I_ADAW, I_ADAB, I_WIN, I_BG, I_CONV, I_LAM, I_SUBLN, I_NORMM, I_WBRA, I_WBRM, I_WOUT, I_LN1G, I_LN1B, I_LN2G, I_LN2B, I_WR, I_EB, I_WEIN, I_WEOUT, I_WSIN, I_WSOUT };

__global__ void __launch_bounds__(NTHR, 2) mega_fwd(KArgs args) {
    extern __shared__ __attribute__((aligned(16))) unsigned char lds_raw[];
    LAS unsigned char* lds = (LAS unsigned char*)lds_raw;
    for (int u = threadIdx.x; u < (LDS_BYTES - MISC_OFF) / 4; u += NTHR) ((LAS unsigned*)(lds + MISC_OFF))[u] = 0u;
    __syncthreads();
    (void)xcd_barrier_post((unsigned*)(WSB() + WS_CTL) + CW_BAR, (volatile LAS unsigned*)(lds + MISC_OFF) + 8);
#define GRID_BAR() do { for (int xb_ = 0; xb_ < 1 + XBAR; ++xb_) { XcdBarrier b_; b_.bar = (unsigned*)(WSB() + WS_CTL) + CW_BAR; b_.x = xb_xcc_id(); b_.st = (volatile LAS unsigned*)(lds + MISC_OFF) + 8; if (xb_ == 0) xcd_barrier<true, false>(b_); else xcd_barrier<false, true>(b_); } } while (0)
#define PHASE_LOCALS() const int tid = opaque_tid(), lane = tid & 63, wave = __builtin_amdgcn_readfirstlane(tid >> 6); int G = (int)gridDim.x; asm volatile("" : "+s"(G)); \
    const int bx = (int)blockIdx.x, vcu = (G % 8 == 0) ? (bx % 8) * (G / 8) + bx / 8 : bx, gw = vcu * NWAVES + wave, NGW = G * NWAVES; (void)tid; (void)lane; (void)wave; (void)gw; (void)NGW; (void)vcu

#if PROBE
#define STAMP(cat) do { if (blockIdx.x == 0 && threadIdx.x == 0) { LAS unsigned long long* ts_ = (LAS unsigned long long*)(lds + MISC_OFF + 64); const unsigned long long t_ = __builtin_amdgcn_s_memrealtime(); ts_[1 + (cat)] += t_ - ts_[0]; ts_[0] = t_; } } while (0)
    if (blockIdx.x == 0 && threadIdx.x == 0) ((LAS unsigned long long*)(lds + MISC_OFF + 64))[0] = __builtin_amdgcn_s_memrealtime();
#else
#define STAMP(cat) do { } while (0)
#endif
    for (int rep_ = 0; rep_ < NREP(1); ++rep_) {
        PHASE_LOCALS(); unsigned char* ws = WSB();
        LAS float* scr = (LAS float*)(lds + wave * 16640);
        constexpr int IT_IN = 257 * 16;
        constexpr int IT_SQ = 32 * 16;
        constexpr int IT_RT = 8 * 16;
        constexpr int IT_E1 = 8 * 16, IT_E2 = 16 * 4;
        constexpr int IT_LAYER = IT_IN + 3 * IT_SQ + IT_RT + 257 * IT_E1 + 257 * IT_E2;
        for (int it = gw; it < 2 * IT_LAYER; it += NGW) {
            const int l = it / IT_LAYER; int r = it % IT_LAYER; unsigned char* WL = ws + WS_W0 + (size_t)l * WL_SIZE;
            if (r < IT_IN) { const int nb = r / 16, kb = r % 16; int n0, drow, nv = 32;
                if (nb < 192) { n0 = nb * 32; drow = n0; } else if (nb == 192) { n0 = 6144; drow = 8192; nv = 16; } else { n0 = 6160 + (nb - 193) * 32; drow = 6144 + (nb - 193) * 32; }
                tr_load(INP(I_WIN) + (size_t)l * 1024 * INW, INW, kb * 64, n0, nv, scr, lane); tr_store<0>((bf16_t*)(WL + WL_IN), 1024, drow, kb * 64, nv, scr, lane, drow >= 2048 && drow < 8192); continue; }
            r -= IT_IN;
            if (r < 3 * IT_SQ) { const int w = r / IT_SQ, q = r % IT_SQ, nb = q / 16, kb = q % 16; const float* src = (w == 0 ? INP(I_WBRA) : w == 1 ? INP(I_WBRM) : INP(I_WOUT)) + (size_t)l * 1024 * 1024;
                tr_load(src, 1024, kb * 64, nb * 32, 32, scr, lane); tr_store<0>((bf16_t*)(WL + (w == 0 ? WL_BRA : w == 1 ? WL_BRM : WL_OUT)), 1024, nb * 32, kb * 64, 32, scr, lane, true); continue; }
            r -= 3 * IT_SQ;
            if (r < IT_RT) { const int nb = r / 16, kb = r % 16; tr_load(INP(I_WR) + (size_t)l * 1024 * 256, 256, kb * 64, nb * 32, 32, scr, lane);
                bf16_t* dst = (bf16_t*)(WL + WL_R3); tr_store<0>(dst, 3072, nb * 32, kb * 64, 32, scr, lane); tr_store<0>(dst, 3072, nb * 32, 1024 + kb * 64, 32, scr, lane); tr_store<1>(dst, 3072, nb * 32, 2048 + kb * 64, 32, scr, lane); continue; }
            r -= IT_RT;
            if (r < 257 * IT_E1) { const int e = r / IT_E1, q = r % IT_E1, kb = q / 8, nb = q % 8, n0 = nb * 64;
                const float* src = e < 256 ? INP(I_WEIN) + ((size_t)l * 256 + e) * 1024 * 512 : INP(I_WSIN) + (size_t)l * 1024 * 512;
                const int isg = n0 >= 256, j0 = n0 & 255, drow = (j0 >> 7) * 256 + isg * 128 + (j0 & 127);
                tr_load64(src, 512, kb * 64, n0, scr, lane); tr_store64<true>((bf16_t*)(WL + WL_E1) + (size_t)e * 512 * 1024, 1024, drow, kb * 64, scr, lane); continue; }
            r -= 257 * IT_E1;
            { const int e = r / IT_E2, q = r % IT_E2, kb = q / 16, nb = q % 16;
                const float* src = e < 256 ? INP(I_WEOUT) + ((size_t)l * 256 + e) * 256 * 1024 : INP(I_WSOUT) + (size_t)l * 256 * 1024;
                tr_load64(src, 1024, kb * 64, nb * 64, scr, lane); tr_store64<true>((bf16_t*)(WL + WL_E2) + (size_t)e * 1024 * 256, 256, nb * 64, kb * 64, scr, lane); }
        }
        { const float* in_c = INP(I_C); const float* in_cctx = INP(I_CCTX); const float* ada_w = INP(I_ADAW); const float* ada_b = INP(I_ADAB); float* MODV = (float*)(ws + WS_MODV);
        for (int it = bx * NTHR + tid; it < 2 * 6144; it += G * NTHR) { const int l = it / 6144, j = it % 6144; const float* wcol = ada_w + (size_t)l * 1024 * 6144 + j; float a0 = 0.f, a1 = 0.f, a2 = 0.f;
#pragma unroll 4
            for (int k = 0; k < 1024; ++k) { const float w = wcol[(size_t)k * 6144]; a0 += siluf_(in_c[k]) * w; a1 += siluf_(in_c[1024 + k]) * w; a2 += siluf_(in_cctx[k]) * w; }
            const float bb = ada_b[l * 6144 + j]; MODV[(l * 3 + 0) * 6144 + j] = a0 + bb; MODV[(l * 3 + 1) * 6144 + j] = a1 + bb; MODV[(l * 3 + 2) * 6144 + j] = a2 + bb; } }
        { f32x2* ROPE = (f32x2*)(ws + WS_ROPE);
        for (int it = bx * NTHR + tid; it < 256 * 16; it += G * NTHR) { const int pos = it >> 4, i = it & 15; const float inv = powf(10000.f, -(float)i / 16.f); const float ang = (float)pos * inv; float s, c; sincosf(ang, &s, &c); ROPE[it] = (f32x2){c, s}; } }
    }
    GRID_BAR(); STAMP(0);

    for (int l = 0; l < 2; ++l) {
        if (l == 0) for (int rep_ = 0; rep_ < NREP(2); ++rep_) {
            PHASE_LOCALS(); unsigned char* ws = WSB(); const float* modv = (const float*)(ws + WS_MODV); bf16_t* HMOD = (bf16_t*)(ws + WS_HMOD);
            XSrc xs{INP(I_X), INP(I_CTX), (const float*)(ws + WS_XCUR), 0};
            for (int r = gw; r < MALL; r += NGW) { const int b = r / TPB, set = (r % TPB) < SEQ ? b : 2; const float* xr = xs.row(r); const float* mv = modv + set * 6144;
#pragma unroll
                for (int j = 0; j < 4; ++j) { const int c = 4 * lane + 256 * j; const f32x4 v = *(const f32x4*)(xr + c), sh = *(const f32x4*)(mv + c), sc = *(const f32x4*)(mv + 1024 + c);
                    *(u32x2*)(HMOD + (size_t)r * 1024 + c) = pk4(v * (sc + 1.f) + sh); } }
            GRID_BAR(); STAMP(0);
        }
        for (int rep_ = 0; rep_ < NREP(4); ++rep_) {
            PHASE_LOCALS(); unsigned char* ws = WSB(); unsigned char* WL = ws + WS_W0 + (size_t)l * WL_SIZE;
            pg8::DenseOrder S; S.init(NRT, INW_PAD / 256, G, bx, WL + WL_IN, 1024);
            EpiInProj E{(bf16_t*)(ws + WS_Q), (bf16_t*)(ws + WS_K), (bf16_t*)(ws + WS_V), (bf16_t*)(ws + WS_QKM), (bf16_t*)(ws + WS_VM), (bf16_t*)(ws + WS_OMS), (bf16_t*)(ws + WS_GA), (bf16_t*)(ws + WS_GB),
                        (float*)(ws + WS_GATES), INP(I_BG) + l * 16, (const f32x2*)(ws + WS_ROPE), (unsigned*)(ws + WS_CTL) + CW_MSTAB + l * 16};
            pg8::gemm_phase(lds, (const bf16_t*)(ws + WS_HMOD), 1024, 1024, S, E);
        }
        GRID_BAR(); STAMP(1);
        for (int rep_ = 0; rep_ < NREP(8); ++rep_) {
            PHASE_LOCALS(); unsigned char* ws = WSB();
            MlstmArgs MA{(const bf16_t*)(ws + WS_QKM), (const bf16_t*)(ws + WS_VM), (const bf16_t*)(ws + WS_OMS), (const float*)(ws + WS_GATES), INP(I_CONV) + (size_t)l * 3 * 1024, INP(I_NORMM) + l * 1024,
                         (const unsigned*)(ws + WS_CTL) + CW_MSTAB + l * 16, (bf16_t*)(ws + WS_ST), (float*)(ws + WS_NU), (float*)(ws + WS_ADEC), (bf16_t*)(ws + WS_HM)};
            for (int u = bx; u < 8 * NCHUNK; u += G) mlstm_d1_unit(MA, u / NCHUNK, u % NCHUNK, lds);
        }
        GRID_BAR(); STAMP(2);
        for (int rep_ = 0; rep_ < NREP(16); ++rep_) {
            PHASE_LOCALS(); unsigned char* ws = WSB();
            MlstmArgs MA{nullptr, nullptr, nullptr, nullptr, nullptr, nullptr, nullptr, (bf16_t*)(ws + WS_ST), (float*)(ws + WS_NU), (float*)(ws + WS_ADEC), nullptr};
            mlstm_scan(MA, bx * NTHR + tid, G * NTHR);
            if (XSCAN) { GRID_BAR(); mlstm_scan(MA, bx * NTHR + tid, G * NTHR, (bf16_t*)(ws + WS_YB), (float*)(ws + WS_HE)); }
        }
        GRID_BAR(); STAMP(3);
        for (int rep_ = 0; rep_ < NREP(32); ++rep_) {
            PHASE_LOCALS(); unsigned char* ws = WSB(); const bf16_t* Qb_ = (const bf16_t*)(ws + WS_Q); const bf16_t* Kb_ = (const bf16_t*)(ws + WS_K); const bf16_t* Vb_ = (const bf16_t*)(ws + WS_V); bf16_t* OJ = (bf16_t*)(ws + WS_OJ);
            const int nun = (G == 256) ? 8 : (2048 + G - 1) / G;
            for (int r = 0; r < nun; ++r) {
                int grp, qb;
                if (G == 256) { const int xg = vcu >> 5, ii = vcu & 31; grp = xg + 8 * (r >> 1); qb = ii + 32 * (r & 1); }
                else { const int u = bx + r * G; if (u >= 2048) break; grp = u >> 6; qb = u & 63; }
                const int b = grp >> 4, h = (grp >> 1) & 7, j = grp & 1; const size_t q0 = (size_t)b * TPB + qb * 256, k0 = (size_t)b * TPB;
                att::attn_body(Qb_ + q0 * 1024 + h * 128 + j * 64, Kb_ + k0 * 1024 + h * 128 + j * 64, Vb_ + k0 * 1024 + h * 128, OJ + q0 * 2048 + h * 256 + j * 128, TPB, (char*)lds_raw);
            }
            if (l == 0) for (int u = bx; u < 32; u += G) { const int b = u >> 4, h = (u >> 1) & 7, j = u & 1; const size_t q0 = (size_t)b * TPB + SEQ;
                att::attn_body(Qb_ + q0 * 1024 + h * 128 + j * 64, Kb_ + q0 * 1024 + h * 128 + j * 64, Vb_ + q0 * 1024 + h * 128, OJ + q0 * 2048 + h * 256 + j * 128, CTX, (char*)lds_raw); }
        }
        STAMP(4);
        for (int rep_ = 0; rep_ < NREP(64); ++rep_) {
            PHASE_LOCALS(); unsigned char* ws = WSB();
            MlstmArgs MA{(const bf16_t*)(ws + WS_QKM), (const bf16_t*)(ws + WS_VM), (const bf16_t*)(ws + WS_OMS), (const float*)(ws + WS_GATES), INP(I_CONV) + (size_t)l * 3 * 1024, INP(I_NORMM) + l * 1024,
                         (const unsigned*)(ws + WS_CTL) + CW_MSTAB + l * 16, (bf16_t*)(ws + WS_ST), (float*)(ws + WS_NU), (float*)(ws + WS_ADEC), (bf16_t*)(ws + WS_HM)};
            for (int u = bx; u < 8 * NCHUNK; u += G) mlstm_d3_unit(MA, u / NCHUNK, u % NCHUNK, lds);
        }
        GRID_BAR(); STAMP(5);
        for (int rep_ = 0; rep_ < NREP(128); ++rep_) {
            PHASE_LOCALS(); unsigned char* ws = WSB(); const bf16_t* OJ = (const bf16_t*)(ws + WS_OJ); bf16_t* OA = (bf16_t*)(ws + WS_OA);
            const float lam_init = l == 0 ? 0.2f : (0.8f - 0.6f * 0.7408182206817179f);
            const float* lm = INP(I_LAM) + l * 256;
            const float lv = __expf(wave_sum(lm[lane] * lm[64 + lane])) - __expf(wave_sum(lm[128 + lane] * lm[192 + lane])) + lam_init;
            const int hh = lane >> 3, e0 = (lane & 7) * 16; f32x4 sgv[4];
#pragma unroll
            for (int q = 0; q < 4; ++q) sgv[q] = *(const f32x4*)(INP(I_SUBLN) + l * 128 + e0 + 4 * q);
            for (int r0 = gw; r0 < MALL; r0 += 2 * NGW) { const int r1 = r0 + NGW; const bool has1 = r1 < MALL; const int rr[2] = {r0, has1 ? r1 : r0};
                u32x4 ra[2][2], rb[2][2];
#pragma unroll
                for (int x = 0; x < 2; ++x) { const bf16_t* p = OJ + (size_t)rr[x] * 2048 + hh * 256 + e0; ra[x][0] = *(const u32x4*)p; ra[x][1] = *(const u32x4*)(p + 8); rb[x][0] = *(const u32x4*)(p + 128); rb[x][1] = *(const u32x4*)(p + 136); }
#pragma unroll
                for (int x = 0; x < 2; ++x) { if (x == 1 && !has1) break;
                    float d[16]; float ss = 0.f;
#pragma unroll
                    for (int q = 0; q < 2; ++q) { const unsigned a4[4] = {ra[x][q].x, ra[x][q].y, ra[x][q].z, ra[x][q].w}, b4[4] = {rb[x][q].x, rb[x][q].y, rb[x][q].z, rb[x][q].w};
#pragma unroll
                        for (int e = 0; e < 4; ++e) { const float lo = bf2f(a4[e] & 0xffffu) - lv * bf2f(b4[e] & 0xffffu), hi_ = bf2f(a4[e] >> 16) - lv * bf2f(b4[e] >> 16); d[q * 8 + 2 * e] = lo; d[q * 8 + 2 * e + 1] = hi_; ss += lo * lo + hi_ * hi_; } }
                    ss += __shfl_xor(ss, 1); ss += __shfl_xor(ss, 2); ss += __shfl_xor(ss, 4);
                    const float rstd = __builtin_amdgcn_rsqf(ss * (1.f / 128.f) + RMS_EPS) * (1.f - lam_init);
                    u32x4 o0, o1;
                    o0.x = pk2(d[0] * rstd * sgv[0].x, d[1] * rstd * sgv[0].y); o0.y = pk2(d[2] * rstd * sgv[0].z, d[3] * rstd * sgv[0].w); o0.z = pk2(d[4] * rstd * sgv[1].x, d[5] * rstd * sgv[1].y); o0.w = pk2(d[6] * rstd * sgv[1].z, d[7] * rstd * sgv[1].w);
                    o1.x = pk2(d[8] * rstd * sgv[2].x, d[9] * rstd * sgv[2].y); o1.y = pk2(d[10] * rstd * sgv[2].z, d[11] * rstd * sgv[2].w); o1.z = pk2(d[12] * rstd * sgv[3].x, d[13] * rstd * sgv[3].y); o1.w = pk2(d[14] * rstd * sgv[3].z, d[15] * rstd * sgv[3].w);
                    bf16_t* po = OA + (size_t)rr[x] * 1024 + hh * 128 + e0; *(u32x4*)po = o0; *(u32x4*)(po + 8) = o1; } }
        }
        GRID_BAR(); STAMP(6);
        for (int rep_ = 0; rep_ < NREP(256); ++rep_) { PHASE_LOCALS(); unsigned char* ws = WSB(); unsigned char* WL = ws + WS_W0 + (size_t)l * WL_SIZE;
            pg8::DenseOrder S; S.init(l ? NRT - 2 : NRT, 4, G, bx, WL + WL_BRA, 1024, l); EpiGate1 E{(const bf16_t*)(ws + WS_GA), (bf16_t*)(ws + WS_T1)}; pg8::gemm_phase(lds, (const bf16_t*)(ws + WS_OA), 1024, 1024, S, E); }
        GRID_BAR(); STAMP(7);
        for (int rep_ = 0; rep_ < NREP(512); ++rep_) { PHASE_LOCALS(); unsigned char* ws = WSB(); unsigned char* WL = ws + WS_W0 + (size_t)l * WL_SIZE;
            pg8::DenseOrder S; S.init(l ? NRT - 2 : NRT, 4, G, bx, WL + WL_BRM, 1024, l); EpiGate2 E{(const bf16_t*)(ws + WS_GB), (const bf16_t*)(ws + WS_T1), (bf16_t*)(ws + WS_Y)}; pg8::gemm_phase(lds, (const bf16_t*)(ws + WS_HM), 1024, 1024, S, E); }
        GRID_BAR(); STAMP(7);
        for (int rep_ = 0; rep_ < NREP(1024); ++rep_) { PHASE_LOCALS(); unsigned char* ws = WSB(); unsigned char* WL = ws + WS_W0 + (size_t)l * WL_SIZE;
            XSrc xs{INP(I_X), INP(I_CTX), (const float*)(ws + WS_XCUR), l};
            pg8::DenseOrder S; S.init(l ? NRT - 2 : NRT, 4, G, bx, WL + WL_OUT, 1024, l); EpiOut E{xs, (const float*)(ws + WS_MODV) + l * 3 * 6144, (float*)(ws + WS_R)}; pg8::gemm_phase(lds, (const bf16_t*)(ws + WS_Y), 1024, 1024, S, E); }
        GRID_BAR(); STAMP(7);
        for (int rep_ = 0; rep_ < NREP(2048); ++rep_) {
            PHASE_LOCALS(); unsigned char* ws = WSB(); const float* modv = (const float*)(ws + WS_MODV) + l * 3 * 6144; const float* Rf = (const float*)(ws + WS_R); float* X1 = (float*)(ws + WS_X1); bf16_t* H2A = (bf16_t*)(ws + WS_H2A);
            const float* g1 = INP(I_LN1G) + l * 1024; const float* b1 = INP(I_LN1B) + l * 1024;
            for (int r0 = gw; r0 < MALL; r0 += 2 * NGW) { const int r1 = r0 + NGW; const bool has1 = r1 < MALL; const int rr[2] = {r0, has1 ? r1 : r0}; f32x4 vv[2][4];
#pragma unroll
                for (int x = 0; x < 2; ++x)
#pragma unroll
                    for (int j = 0; j < 4; ++j) vv[x][j] = unpk4(*(const u32x2*)((const bf16_t*)Rf + (size_t)rr[x] * 1024 + 4 * lane + 256 * j));
#pragma unroll
                for (int x = 0; x < 2; ++x) { if (x == 1 && !has1) break;
                    const int r = rr[x]; const int b = r / TPB, set = (r % TPB) < SEQ ? b : 2; const float* mv = modv + set * 6144;
                    ln_row(vv[x], g1, b1, lane);
#pragma unroll
                    for (int j = 0; j < 4; ++j) { const int c = 4 * lane + 256 * j;
                        const f32x4 sh = *(const f32x4*)(mv + 3 * 1024 + c), sc = *(const f32x4*)(mv + 4 * 1024 + c); const f32x4 hh = vv[x][j] * (sc + 1.f) + sh;
                        *(u32x2*)(H2A + (size_t)r * 1024 + c) = pk4(hh); } } }
        }
        GRID_BAR(); STAMP(8);
        for (int rep_ = 0; rep_ < NREP(4096); ++rep_) { PHASE_LOCALS(); unsigned char* ws = WSB(); unsigned char* WL = ws + WS_W0 + (size_t)l * WL_SIZE;
            pg8::DenseOrder S; S.init(NRT, 1, G, bx, WL + WL_R3, 3072); EpiLogits E{(float*)(ws + WS_LOG)}; pg8::gemm_phase(lds, (const bf16_t*)(ws + WS_H2A), 1024, ROUTER_K, S, E, 3072); }
        GRID_BAR(); STAMP(9);
        for (int rep_ = 0; rep_ < NREP(8192); ++rep_) {
            PHASE_LOCALS(); unsigned char* ws = WSB(); const float* LOGITS = (const float*)(ws + WS_LOG); const float* e_bias = INP(I_EB) + l * 256; unsigned* ecnt = (unsigned*)(ws + WS_CTL) + CW_CNT + l * 256;
            for (int xt_ = 0; xt_ < 1 + XTOPK; ++xt_) {
            if (xt_) ecnt += 2048;
            int* TOPI = (int*)(ws + (xt_ ? WS_YB : WS_TOPI)); float* TOPW = (float*)(ws + (xt_ ? WS_YB + 2 * MiB : WS_TOPW)); int* POS = (int*)(ws + (xt_ ? WS_YB + 4 * MiB : WS_POS));
            for (int r4 = gw * 4; r4 < MALL; r4 += NGW * 4) {
                const int r = r4 + (lane >> 4), sub = lane & 15; float sc[16], bs[16];
#pragma unroll
                for (int q = 0; q < 4; ++q) { const f32x4 lg = *(const f32x4*)(LOGITS + (size_t)r * 256 + sub * 16 + 4 * q), eb = *(const f32x4*)(e_bias + sub * 16 + 4 * q);
                    sc[4 * q] = sigmoidf_(lg.x); sc[4 * q + 1] = sigmoidf_(lg.y); sc[4 * q + 2] = sigmoidf_(lg.z); sc[4 * q + 3] = sigmoidf_(lg.w);
                    bs[4 * q] = sc[4 * q] + eb.x; bs[4 * q + 1] = sc[4 * q + 1] + eb.y; bs[4 * q + 2] = sc[4 * q + 2] + eb.z; bs[4 * q + 3] = sc[4 * q + 3] + eb.w; }
                int myi = 0; float myw = 0.f, wsum = 0.f;
#pragma unroll
                for (int k = 0; k < 8; ++k) {
                    float bv = bs[0], bsc = sc[0]; int bi = 0;
#pragma unroll
                    for (int e = 1; e < 16; ++e) if (bs[e] > bv) { bv = bs[e]; bsc = sc[e]; bi = e; }
                    int gi = sub * 16 + bi;
#pragma unroll
                    for (int o = 1; o < 16; o <<= 1) { const float ov = __shfl_xor(bv, o), os = __shfl_xor(bsc, o); const int oi = __shfl_xor(gi, o); if (ov > bv || (ov == bv && oi < gi)) { bv = ov; gi = oi; bsc = os; } }
                    if ((gi >> 4) == sub) { const int oe = gi & 15;
#pragma unroll
                        for (int e = 0; e < 16; ++e) if (e == oe) bs[e] = -1e30f; }
                    wsum += bsc;
                    if (sub == k) { myi = gi; myw = bsc; }
                }
                if (sub < 8) { const float w = myw / wsum * 2.5f; const int p = (int)atomicAdd(ecnt + myi, 1u);
                    TOPI[(size_t)r * 8 + sub] = myi; TOPW[(size_t)r * 8 + sub] = w; POS[(size_t)r * 8 + sub] = p; }
            }
            }
        }
        GRID_BAR(); STAMP(10);
        for (int rep_ = 0; rep_ < NREP(16384); ++rep_) {
            PHASE_LOCALS(); unsigned char* ws = WSB(); unsigned* ecnt = (unsigned*)(ws + WS_CTL) + CW_CNT + l * 256;
            const int* TOPI = (const int*)(ws + WS_TOPI); const float* TOPW = (const float*)(ws + WS_TOPW); const int* POS = (const int*)(ws + WS_POS); int* SLOT = (int*)(ws + WS_SLOT);
            int* ROWTOK = (int*)(ws + WS_ROWTOK); float* ROWW = (float*)(ws + WS_ROWW); int* BLKEXP = (int*)(ws + WS_BLKEXP);
            LAS int* cntL = (LAS int*)lds; LAS int* bst = cntL + 256; LAS int* tot = bst + 256;
            if (tid < 256) cntL[tid] = (int)__hip_atomic_load(ecnt + tid, RLX_AGENT);
            __syncthreads();
            if (tid == 0) { int s = 0; for (int e = 0; e < 256; ++e) { bst[e] = s; s += (cntL[e] + 255) >> 8; } tot[0] = s; }
            __syncthreads();
            const int NB = tot[0]; const int gt = bx * NTHR + tid, GT = G * NTHR;
            for (int i = gt; i < MALL * 8; i += GT) { const int e = TOPI[i]; const int slot = bst[e] * 256 + POS[i]; SLOT[i] = slot; st_wt(ROWTOK + slot, i >> 3); st_wt(ROWW + slot, TOPW[i]); }
            for (int i = gt; i < 256 * 256; i += GT) { const int e = i >> 8, p = i & 255, c = cntL[e]; if ((c & 255) != 0 && p >= (c & 255)) { const int slot = (bst[e] + (c >> 8)) * 256 + p; st_wt(ROWTOK + slot, 0); st_wt(ROWW + slot, -1.f); } }
            for (int i = gt; i < 256 * 160; i += GT) { const int e = i / 160, j = i % 160; if (j < ((cntL[e] + 255) >> 8)) st_wt(BLKEXP + bst[e] + j, e); }
            for (int i = gt; i < NRT * 256; i += GT) { const int slot = NB * 256 + i; ROWTOK[slot] = i; ROWW[slot] = 1.f; if ((i & 255) == 0) st_wt(BLKEXP + NB + (i >> 8), 256); }
            if (gt == 0) st_wt(BLKEXP + MAXBLK, NB + NRT);
            __syncthreads();
        }
        GRID_BAR(); STAMP(10);
        for (int rep_ = 0; rep_ < NREP(32768); ++rep_) {
            PHASE_LOCALS(); unsigned char* ws = WSB(); unsigned char* WL = ws + WS_W0 + (size_t)l * WL_SIZE; const int* ROWTOK = (const int*)(ws + WS_ROWTOK); const int* BLKEXP = (const int*)(ws + WS_BLKEXP);
            LAS int* rowtab = (LAS int*)(lds + TAB_OFF); LAS int* etab = rowtab + 12 * 256;
            const int nunits = BLKEXP[MAXBLK] * 2;
            for (int i = 0; i < 12; ++i) { const int L = i * G + vcu; if (L >= nunits) break; const int bi = L >> 1;
                if (tid < 256) rowtab[i * 256 + tid] = ROWTOK[(size_t)bi * 256 + tid]; if (tid == 256) etab[i] = BLKEXP[bi]; }
            __syncthreads();
            pg8::MoeOrder<2, true> S{nunits, G, vcu, (const char*)(WL + WL_E1), (size_t)512 * 1024 * 2, (size_t)256 * 1024 * 2, rowtab, etab};
            EpiSwiglu E{(bf16_t*)(ws + WS_HE)}; pg8::gemm_phase(lds, (const bf16_t*)(ws + WS_H2A), 1024, 1024, S, E);
        }
        GRID_BAR(); STAMP(11);
        for (int rep_ = 0; rep_ < NREP(65536); ++rep_) {
            PHASE_LOCALS(); unsigned char* ws = WSB(); unsigned char* WL = ws + WS_W0 + (size_t)l * WL_SIZE; const int* BLKEXP = (const int*)(ws + WS_BLKEXP);
            LAS int* rowtab = (LAS int*)(lds + TAB_OFF); LAS int* etab = rowtab + 12 * 256;
            const int nunits = BLKEXP[MAXBLK] * 4;
            for (int i = tid; i < 64; i += NTHR) { const int L = i * G + vcu; if (L < nunits) etab[i] = BLKEXP[L >> 2]; }
            __syncthreads();
            pg8::MoeOrder<4, false> S{nunits, G, vcu, (const char*)(WL + WL_E2), (size_t)1024 * 256 * 2, (size_t)256 * 256 * 2, rowtab, etab};
            EpiScaleRow E{(bf16_t*)(ws + WS_YB), (const float*)(ws + WS_ROWW)}; pg8::gemm_phase(lds, (const bf16_t*)(ws + WS_HE), 256, 256, S, E);
        }
        GRID_BAR(); STAMP(12);
        for (int rep_ = 0; rep_ < NREP(131072); ++rep_) {
            PHASE_LOCALS(); unsigned char* ws = WSB(); const float* MODV = (const float*)(ws + WS_MODV); const float* modv = MODV + l * 3 * 6144; const bf16_t* YB = (const bf16_t*)(ws + WS_YB); const int* SLOT = (const int*)(ws + WS_SLOT);
            const float* X1 = (const float*)(ws + WS_R); float* XCUR = (float*)(ws + WS_XCUR); bf16_t* HMOD = (bf16_t*)(ws + WS_HMOD); float* outp = OUTP();
            const float* g2 = INP(I_LN2G) + l * 1024; const float* b2 = INP(I_LN2B) + l * 1024; const float* g1 = INP(I_LN1G) + l * 1024; const float* b1 = INP(I_LN1B) + l * 1024;
            const int NB = ((const int*)(ws + WS_BLKEXP))[MAXBLK] - NRT;
            for (int r0 = gw; r0 < MALL; r0 += 2 * NGW) { const int r1 = r0 + NGW; const bool has1 = r1 < MALL; const int rr[2] = {r0, has1 ? r1 : r0};
                int sl[2]; u32x2 yb[2][9][2]; u32x4 rx[2][2];
#pragma unroll
                for (int x = 0; x < 2; ++x) sl[x] = SLOT[(size_t)rr[x] * 8 + (lane & 7)];
#pragma unroll
                for (int x = 0; x < 2; ++x) {
#pragma unroll
                    for (int j2 = 0; j2 < 2; ++j2) { yb[x][8][j2] = *(const u32x2*)((const unsigned char*)YB + ((size_t)NB * 256 + rr[x]) * 1024 + 8 * lane + 512 * j2); rx[x][j2] = *(const u32x4*)((const bf16_t*)X1 + (size_t)rr[x] * 1024 + 8 * lane + 512 * j2); }
#pragma unroll
                    for (int k = 0; k < 8; ++k) { const size_t so = (size_t)__shfl(sl[x], k) * 1024;
#pragma unroll
                        for (int j2 = 0; j2 < 2; ++j2) yb[x][k][j2] = *(const u32x2*)((const unsigned char*)YB + so + 8 * lane + 512 * j2); } }
#pragma unroll
                for (int x = 0; x < 2; ++x) { if (x == 1 && !has1) break;
                    const int r = rr[x]; const int b = r / TPB, t = r % TPB, set = t < SEQ ? b : 2; const float* mv = modv + set * 6144; f32x4 xv[4], v[4];
#pragma unroll
                    for (int j2 = 0; j2 < 2; ++j2) { xv[2 * j2] = unpk4((u32x2){rx[x][j2].x, rx[x][j2].y}); xv[2 * j2 + 1] = unpk4((u32x2){rx[x][j2].z, rx[x][j2].w}); }
                    ln_row8(xv, g1, b1, lane);
#pragma unroll
                    for (int j = 0; j < 4; ++j) { const int j2 = j >> 1, hf = j & 1; f32x4 f = unpk4_fp8(hf ? yb[x][8][j2].y : yb[x][8][j2].x);
#pragma unroll
                        for (int k = 0; k < 8; ++k) f = f + unpk4_fp8(hf ? yb[x][k][j2].y : yb[x][k][j2].x);
                        f = f * (1.f / YB8_SCALE);
                        v[j] = xv[j] * ALPHA_RES + *(const f32x4*)(mv + 5 * 1024 + C8(j)) * f; }
                    ln_row8(v, g2, b2, lane);
                    if (l == 0) { const float* mn = MODV + 3 * 6144 + set * 6144;
#pragma unroll
                        for (int j2 = 0; j2 < 2; ++j2) { u32x2 pk[2];
#pragma unroll
                            for (int hf = 0; hf < 2; ++hf) { const int j = 2 * j2 + hf, c = C8(j); *(f32x4*)(XCUR + (size_t)r * 1024 + c) = v[j];
                                const f32x4 sh = *(const f32x4*)(mn + c), sc = *(const f32x4*)(mn + 1024 + c); pk[hf] = pk4(v[j] * (sc + 1.f) + sh); }
                            *(u32x4*)(HMOD + (size_t)r * 1024 + 8 * lane + 512 * j2) = (u32x4){pk[0].x, pk[0].y, pk[1].x, pk[1].y}; } }
                    else if (t < SEQ) {
#pragma unroll
                        for (int j = 0; j < 4; ++j) *(f32x4*)(outp + ((size_t)b * SEQ + t) * 1024 + C8(j)) = v[j]; } } }
        }
        if (l == 0 || PROBE) { GRID_BAR(); STAMP(13); }
    }
#if PROBE
    {
        unsigned char* ws = WSB(); unsigned* ctl = (unsigned*)(ws + WS_CTL);
        if (blockIdx.x == 0 && threadIdx.x == 0) { LAS unsigned long long* ts_ = (LAS unsigned long long*)(lds + MISC_OFF + 64);
            unsigned long long sa = 0, sb = 0; for (int c = 0; c < 14; ++c) { if ((PROBE_A >> c) & 1) sa += ts_[1 + c]; if ((PROBE_B >> c) & 1) sb += ts_[1 + c]; }
            __hip_atomic_store(ctl + 20000, (unsigned)(sa / 100ull), RLX_AGENT); __hip_atomic_store(ctl + 20001, (unsigned)(sb / 100ull), RLX_AGENT); }
        GRID_BAR();
        const float va = sqrtf((float)__hip_atomic_load(ctl + 20000, RLX_AGENT)), vb = (float)__hip_atomic_load(ctl + 20001, RLX_AGENT);
        float* outp = OUTP();
        for (size_t i = (size_t)blockIdx.x * NTHR + threadIdx.x; i < (size_t)BATCH * SEQ * 1024; i += (size_t)gridDim.x * NTHR) outp[i] = (i == 0) ? vb : va;
    }
#endif
}

extern "C" void kernel_launch(void* const* d_in, const int* in_sizes, int n_in, void* d_out, int out_size, void* d_ws, size_t ws_size, hipStream_t stream) {
    static int grid = 0;
    if (grid == 0) {
        if (n_in != 25 || ws_size < WS_END) { fprintf(stderr, "kernel_launch: need 25 inputs and >= %zu bytes of workspace; got %d, %zu\n", (size_t)WS_END, n_in, ws_size); grid = -1; return; }
        int dev = 0, cus = 0, per_cu = 0;
        if (hipGetDevice(&dev) != hipSuccess || hipDeviceGetAttribute(&cus, hipDeviceAttributeMultiprocessorCount, dev) != hipSuccess) { grid = -1; return; }
        if (hipFuncSetAttribute((const void*)mega_fwd, hipFuncAttributeMaxDynamicSharedMemorySize, LDS_BYTES) != hipSuccess) { fprintf(stderr, "kernel_launch: hipFuncSetAttribute failed\n"); grid = -1; return; }
        if (hipOccupancyMaxActiveBlocksPerMultiprocessor(&per_cu, (const void*)mega_fwd, NTHR, LDS_BYTES) != hipSuccess || per_cu < 1) { fprintf(stderr, "kernel_launch: occupancy query says %d\n", per_cu); (void)hipGetLastError(); per_cu = 1; }
        grid = cus;
    }
    if (grid < 0) return;
    if (hipMemsetAsync((char*)d_ws + WS_CTL, 0, CTL_ZERO_BYTES, stream) != hipSuccess) return;
    KArgs a{};
    for (int i = 0; i < 25; ++i) a.in[i] = (const float*)d_in[i];
    a.out = (float*)d_out; a.ws = (unsigned char*)d_ws; a.dbg = 0; a.pad = 0;
    hipLaunchKernelGGL(mega_fwd, dim3(grid), dim3(NTHR), LDS_BYTES, stream, a);
}
```

```cpp
#include <hip/hip_runtime.h>
#include <cstdio>
#include <cstdint>

#define GAS __attribute__((address_space(1)))
#define LAS __attribute__((address_space(3)))
typedef unsigned short bf16_t;
typedef short bf16x8 __attribute__((ext_vector_type(8)));
typedef short s16x4 __attribute__((ext_vector_type(4)));
typedef float f32x4 __attribute__((ext_vector_type(4)));
typedef float f32x2 __attribute__((ext_vector_type(2)));
typedef float f32x8 __attribute__((ext_vector_type(8)));
typedef float f32x16 __attribute__((ext_vector_type(16)));
typedef unsigned u32x4 __attribute__((ext_vector_type(4)));
typedef unsigned u32x2 __attribute__((ext_vector_type(2)));
typedef GAS unsigned gu32;
#define RLX_AGENT __ATOMIC_RELAXED, __HIP_MEMORY_SCOPE_AGENT
#define LDS_WAIT() asm volatile("s_waitcnt lgkmcnt(0)" ::: "memory")
#define VM_WAIT() asm volatile("s_waitcnt vmcnt(0)" ::: "memory")

constexpr int D = 1024, BATCH = 2, SEQ = 16384, CTX = 256, TPB = SEQ + CTX  , MALL = BATCH * TPB  ;
constexpr int NRT = MALL / 256;
constexpr int NWAVES = 8, NTHR = 512;
constexpr int INW = 8208, INW_PAD = 8448;
constexpr int NEXP = 256, TOPK = 8;
constexpr float ALPHA_RES = 1.4142135623730951f;
constexpr float LN_EPS = 1e-5f, RMS_EPS = 1e-6f;
constexpr float QSCALE = 0.125f * 1.4426950408889634f;
constexpr int MAXBLK = 1040 + 256 + 130;
constexpr int NCHUNK = TPB / 64;
constexpr int NCHAIN = 16;
#ifndef PHM
#define PHM 0x3ffff
#endif
#ifndef PROBE
#define PROBE 0
#endif
#ifndef REPM
#define REPM 0
#endif
#ifndef XBAR
#define XBAR 1
#endif
#ifndef ROUTER_K
#define ROUTER_K 1024
#endif
#ifndef XTOPK
#define XTOPK 0
#endif
#ifndef XSCAN
#define XSCAN 0
#endif
#define NREP(bit) (((PHM) & (bit)) ? (((REPM) & (bit)) ? 2 : 1) : 0)
#ifndef PROBE_A
#define PROBE_A 0x10
#endif
#ifndef PROBE_B
#define PROBE_B 0x2c
#endif

__device__ __forceinline__ unsigned pk2(float lo, float hi) { unsigned r; asm("v_cvt_pk_bf16_f32 %0, %1, %2" : "=v"(r) : "v"(lo), "v"(hi)); return r; }
__device__ __forceinline__ unsigned f2bf(float f) { return pk2(f, 0.f) & 0xffffu; }
__device__ __forceinline__ float bf2f(unsigned h) { return __builtin_bit_cast(float, h << 16); }

__device__ __forceinline__ u32x2 pk4(f32x4 v) { u32x2 r; r.x = pk2(v.x, v.y); r.y = pk2(v.z, v.w); return r; }
__device__ __forceinline__ f32x4 unpk4(u32x2 w) { f32x4 r; r.x = bf2f(w.x & 0xffffu); r.y = bf2f(w.x >> 16); r.z = bf2f(w.y & 0xffffu); r.w = bf2f(w.y >> 16); return r; }
__device__ __forceinline__ float sigmoidf_(float x) { return __builtin_amdgcn_rcpf(1.f + __expf(-x)); }
__device__ __forceinline__ float siluf_(float x) { return x * __builtin_amdgcn_rcpf(1.f + __expf(-x)); }
__device__ __forceinline__ float logsigf_(float x) { return fminf(x, 0.f) - log1pf(__expf(-fabsf(x))); }
__device__ __forceinline__ void st_wt(int* p, int v) { __hip_atomic_store(p, v, __ATOMIC_RELAXED, __HIP_MEMORY_SCOPE_AGENT); }
__device__ __forceinline__ void st_wt(float* p, float v) { __hip_atomic_store(p, v, __ATOMIC_RELAXED, __HIP_MEMORY_SCOPE_AGENT); }
__device__ __forceinline__ int opaque_tid() { int t = threadIdx.x; asm volatile("" : "+v"(t)); return t; }
__device__ __forceinline__ float wave_sum(float v) {
    v += __builtin_bit_cast(float, __builtin_amdgcn_mov_dpp(__builtin_bit_cast(int, v), 0xB1, 0xF, 0xF, true));
    v += __builtin_bit_cast(float, __builtin_amdgcn_mov_dpp(__builtin_bit_cast(int, v), 0x4E, 0xF, 0xF, true));
    v += __builtin_bit_cast(float, __builtin_amdgcn_mov_dpp(__builtin_bit_cast(int, v), 0x141, 0xF, 0xF, true));
    v += __builtin_bit_cast(float, __builtin_amdgcn_mov_dpp(__builtin_bit_cast(int, v), 0x140, 0xF, 0xF, true));
    { auto a = __builtin_amdgcn_permlane16_swap(__float_as_uint(v), __float_as_uint(v), false, false); v = __uint_as_float(a[0]) + __uint_as_float(a[1]); }
    { auto b = __builtin_amdgcn_permlane32_swap(__float_as_uint(v), __float_as_uint(v), false, false); v = __uint_as_float(b[0]) + __uint_as_float(b[1]); }
    return v;
}

constexpr size_t MiB = 1u << 20;
constexpr size_t WS_CTL = 0, CTL_ZERO_BYTES = 1 * MiB;
constexpr size_t WS_MODV = 1 * MiB;
constexpr size_t WS_ROPE = WS_MODV + 256 * 1024;
constexpr size_t WS_W0 = 2 * MiB;
constexpr size_t WL_IN = 0;
constexpr size_t WL_BRA = WL_IN + (size_t)INW_PAD * 1024 * 2;
constexpr size_t WL_BRM = WL_BRA + 2 * MiB;
constexpr size_t WL_OUT = WL_BRM + 2 * MiB;
constexpr size_t WL_R3 = WL_OUT + 2 * MiB;
constexpr size_t WL_E1 = WL_R3 + (size_t)256 * 3072 * 2;
constexpr size_t WL_E2 = WL_E1 + (size_t)257 * 512 * 1024 * 2;
constexpr size_t WL_SIZE = WL_E2 + (size_t)257 * 1024 * 256 * 2;
constexpr size_t ACT0 = WS_W0 + 2 * WL_SIZE;
constexpr size_t SZ_B16 = (size_t)MALL * 1024 * 2;
constexpr size_t WS_HMOD = ACT0;
constexpr size_t WS_Q = WS_HMOD + SZ_B16, WS_K = WS_Q + SZ_B16, WS_V = WS_K + SZ_B16, WS_QKM = WS_V + SZ_B16, WS_VM = WS_QKM + SZ_B16;
constexpr size_t WS_OMS = WS_VM + SZ_B16, WS_GA = WS_OMS + SZ_B16, WS_GB = WS_GA + SZ_B16;
constexpr size_t WS_GATES = WS_GB + SZ_B16;
constexpr size_t WS_OJ = WS_GATES + (size_t)MALL * 16 * 4 + 61440;
constexpr size_t WS_OA = WS_OJ + 2 * SZ_B16;
constexpr size_t WS_ST = WS_OA + SZ_B16;
constexpr size_t WS_NU = WS_ST + (size_t)NCHAIN * NCHUNK * 65536;
constexpr size_t WS_ADEC = WS_NU + (size_t)NCHAIN * NCHUNK * 128 * 4;
constexpr size_t WS_HM = WS_ADEC + 65536;
constexpr size_t WS_T1 = WS_HM + SZ_B16, WS_Y = WS_T1 + SZ_B16;
constexpr size_t WS_R = WS_Y + SZ_B16;
constexpr size_t WS_X1 = WS_R + 2 * SZ_B16, WS_XCUR = WS_X1 + 2 * SZ_B16;
constexpr size_t WS_H2A = WS_XCUR + 2 * SZ_B16;
constexpr size_t WS_LOG = WS_H2A + 3 * SZ_B16;
constexpr size_t WS_TOPI = WS_LOG + (size_t)MALL * 256 * 4;
constexpr size_t WS_TOPW = WS_TOPI + 2 * MiB, WS_POS = WS_TOPW + 2 * MiB, WS_SLOT = WS_POS + 2 * MiB;
constexpr size_t WS_ROWTOK = WS_SLOT + 2 * MiB;
constexpr size_t WS_ROWW = WS_ROWTOK + 2 * MiB;
constexpr size_t WS_BLKEXP = WS_ROWW + 2 * MiB;
constexpr size_t WS_HE = WS_BLKEXP + 1 * MiB;
constexpr size_t WS_YB = WS_HE + (size_t)MAXBLK * 256 * 256 * 2;
constexpr size_t WS_END = WS_YB + (size_t)MAXBLK * 256 * 1024 * 2;
static_assert(WS_END <= (size_t)4096 * MiB, "d_ws map fits 4 GiB");
constexpr int CW_BAR = 4096;
constexpr int CW_CNT = 16384;
constexpr int CW_MSTAB = 17408;

constexpr int RING_BYTES = 131072;
constexpr int TAB_OFF = RING_BYTES;
constexpr int TAB_BYTES = 12 * 1024 + 256;
constexpr int MISC_OFF = TAB_OFF + TAB_BYTES;
constexpr int LDS_BYTES = 147456;
static_assert(MISC_OFF + 128 <= LDS_BYTES, "LDS map");

#define XB_TMO      128
#define XB_XCNT(j)  (256  + 64 * (j))
#define XB_XSUB(j)  (1280 + 64 * (j))
#define XB_XGEN(j)  (2304 + 64 * (j))
#define XB_TOP      3328
#define XB_TOPGEN   3392
#define XCD_BAR_WORDS 3456
#define XB_SPIN_CAP (1u << 22)
__device__ __forceinline__ unsigned xb_ld(unsigned* p)              { return __hip_atomic_load(p, __ATOMIC_RELAXED, __HIP_MEMORY_SCOPE_AGENT); }
__device__ __forceinline__ unsigned xb_add(unsigned* p, unsigned v) { return __hip_atomic_fetch_add(p, v, __ATOMIC_RELAXED, __HIP_MEMORY_SCOPE_AGENT); }
__device__ __forceinline__ unsigned xb_xcc_id() { return (unsigned)__builtin_amdgcn_s_getreg((3 << 11) | 20) & 0xFu; }
#define XB_SPIN(cond, bar) do { unsigned _sp = 0; while (cond) { __builtin_amdgcn_s_sleep(1); \
    if ((++_sp & 255u) == 0u) { if (xb_ld(&(bar)[XB_TMO])) break; if (_sp > XB_SPIN_CAP) { atomicAdd(&(bar)[XB_TMO], 1u); break; } } } } while (0)
struct XcdBarrier { unsigned* bar; unsigned x; volatile LAS unsigned* st; };
__device__ __forceinline__ XcdBarrier xcd_barrier_post(unsigned* bar, volatile LAS unsigned* st) {
    XcdBarrier b; b.bar = bar; b.x = xb_xcc_id(); b.st = st;
    if (threadIdx.x == 0) (void)xb_add(&bar[XB_XCNT(b.x)], 1u);
    return b;
}
__device__ __forceinline__ void xcd_barrier_complete(unsigned* bar, unsigned x, unsigned& nloc, unsigned& nx) {
    const unsigned G = gridDim.x * gridDim.y * gridDim.z;
    unsigned sum, cnt, mine, sp = 0u;
    for (;;) {
        sum = 0u; cnt = 0u; mine = 0u;
#pragma unroll
        for (unsigned j = 0; j < 16; ++j) { const unsigned c = xb_ld(&bar[XB_XCNT(j)]); sum += c; cnt += (c > 0u) ? 1u : 0u; mine = (j == x) ? c : mine; }
        if (sum == G) break;
        __builtin_amdgcn_s_sleep(1);
        if ((++sp & 255u) == 0u) { if (xb_ld(&bar[XB_TMO])) break; if (sp > XB_SPIN_CAP) { atomicAdd(&bar[XB_TMO], 1u); break; } }
    }
    nloc = mine > 0u ? mine : 1u; nx = cnt > 0u ? cnt : 1u;
}
template <bool FENCES, bool LOCAL>
__device__ __forceinline__ void xcd_barrier(const XcdBarrier& b) {
    asm volatile("s_waitcnt vmcnt(0)" ::: "memory");
    __syncthreads();
    if (threadIdx.x == 0) {
        unsigned* bar = b.bar;
        __builtin_amdgcn_s_waitcnt(0);
        unsigned nloc = b.st[0], nx = b.st[1];
        if (nloc == 0u) { xcd_barrier_complete(bar, b.x, nloc, nx); b.st[0] = nloc; b.st[1] = nx; }
        const unsigned old = xb_add(&bar[XB_XSUB(b.x)], 1u);
        const unsigned gen = old / nloc;
        if (old + 1u == (gen + 1u) * nloc) {
            if (FENCES) __builtin_amdgcn_fence(__ATOMIC_RELEASE, "agent");
            asm volatile("s_waitcnt vmcnt(0)" ::: "memory");
            if (!LOCAL) { const unsigned og = xb_add(&bar[XB_TOP], 1u);
                const unsigned tg = og / nx;
                if (og + 1u == (tg + 1u) * nx) xb_add(&bar[XB_TOPGEN], 1u);
                else XB_SPIN(xb_ld(&bar[XB_TOPGEN]) == tg, bar); }
            if (FENCES) __builtin_amdgcn_fence(__ATOMIC_ACQUIRE, "agent");
            xb_add(&bar[XB_XGEN(b.x)], 1u);
            asm volatile("s_waitcnt vmcnt(0)" ::: "memory");
        } else {
            XB_SPIN(xb_ld(&bar[XB_XGEN(b.x)]) == gen, bar);
            if (FENCES) __builtin_amdgcn_fence(__ATOMIC_ACQUIRE, "agent");
            asm volatile("s_waitcnt vmcnt(0)" ::: "memory");
        }
    }
    __syncthreads();
}

namespace pg8 {
constexpr int BM = 256, BK = 64, HALF = 128, HTB = HALF * BK * 2, STAGE_BYTES = 8 * HTB, NXCD = 8, WGM = 8;
__host__ __device__ __forceinline__ int lds_byte(int r, int c) { const int st = (r >> 4) * 2 + (c >> 5), rr = r & 15, cc = c & 31, ob = rr * 64 + cc * 2; return st * 1024 + (ob ^ (((ob >> 9) & 1) << 5)); }
__host__ __device__ __forceinline__ void stage_rc(int b, int& R, int& C) { const int st = b / 1024, sb = b % 1024, swz = sb ^ (((sb >> 9) & 1) << 5); R = (st >> 1) * 16 + swz / 64; C = (st & 1) * 32 + (swz % 64) / 2; }
struct Unit { int pm, pn, aux; };

struct DenseOrder {
    static constexpr bool GATHER = false;
    int nM, nN, nwg, G, c, skipctx; const char* Bt; size_t btile;
    __device__ __forceinline__ void init(int nM_, int nN_, int G_, int c_, const void* Bt_, int K, int skipctx_ = 0) { nM = nM_; nN = nN_; nwg = nM * nN; G = G_; c = c_; Bt = (const char*)Bt_; btile = (size_t)256 * K * 2; skipctx = skipctx_; }
    __device__ __forceinline__ bool next(int i, Unit& u) const {
        const long L = (long)i * G + c; if (L >= nwg) return false;
        int wgid = (int)L; { const int q = nwg / NXCD, r = nwg % NXCD, xcd = wgid % NXCD, off = wgid / NXCD; wgid = (xcd < r ? xcd * (q + 1) : r * (q + 1) + (xcd - r) * q) + off; }
        const int nig = WGM * nN, gid = wgid / nig, fm = gid * WGM, gsz = (nM - fm) < WGM ? (nM - fm) : WGM;
        u.pm = fm + ((wgid % nig) % gsz); u.pn = (wgid % nig) / gsz; u.aux = 0; if (skipctx && u.pm >= 64) u.pm += 1; return true;
    }
    __device__ __forceinline__ unsigned arow(const Unit& u, int r) const { return 0u; }
    __device__ __forceinline__ const char* bptr(const Unit& u) const { return Bt + (size_t)u.pn * btile; }
};
template <int NPN, bool GATHER_> struct MoeOrder {
    static constexpr bool GATHER = GATHER_;
    int nunits, G, vcu; const char* W; size_t estride, btile; const LAS int* rowtab; const LAS int* etab;
    __device__ __forceinline__ bool next(int i, Unit& u) const {
        const int L = i * G + vcu; if (L >= nunits) return false;
        u.pm = L / NPN; u.pn = L % NPN; u.aux = i; return true;
    }
    __device__ __forceinline__ unsigned arow(const Unit& u, int r) const { return (unsigned)rowtab[u.aux * 256 + r]; }
    __device__ __forceinline__ const char* bptr(const Unit& u) const { return W + (size_t)etab[u.aux] * estride + (size_t)u.pn * btile; }
};

template <class Epi, class Sched>
__device__ __forceinline__ void gemm_phase(LAS unsigned char* lds, const bf16_t* A, int lda, int K, const Sched& S, const Epi& E, int ldb = 0) {
    if (ldb == 0) ldb = K;
    constexpr bool GATHER = Sched::GATHER;
    const int tid = opaque_tid(), wid = __builtin_amdgcn_readfirstlane(tid >> 6), lane = tid & 63, wr = wid >> 2, wc = wid & 3, fr = lane & 15, fq = lane >> 4;
    const int nt = K / BK;
    int R0, C0, R1, C1; stage_rc(tid * 16, R0, C0); stage_rc(tid * 16 + 8192, R1, C1);
    const unsigned vb0 = (unsigned)(R0 * ldb + C0) * 2u, vb1 = (unsigned)(R1 * ldb + C1) * 2u;
    const unsigned lda2 = (unsigned)lda * 2u;
    const size_t kstep = (size_t)(BK * 2);
    const size_t hstepB = (size_t)HALF * ldb * 2;
    const size_t hstepA = GATHER ? (size_t)0 : (size_t)HALF * lda2, tstepA = GATHER ? (size_t)0 : (size_t)256 * lda2;
    const unsigned ldsw = (unsigned)wid * 1024u;
    const int aoff = lds_byte(wr * 64 + fr, fq * 8), boff = lds_byte(wc * 32 + fr, fq * 8);
    const char* gA = (const char*)A;
#define PG8_SA(b, h) (((b) * 2 + (h)) * HTB)
#define PG8_SB(b, h) ((4 + (b) * 2 + (h)) * HTB)
#define PG8_STAGE(bufoff, gbase, o0, o1) do { \
        __builtin_amdgcn_global_load_lds((const unsigned*)((const char*)(gbase) + (o0)), (LAS unsigned*)(lds + (bufoff) + ldsw), 16, 0, 0); \
        __builtin_amdgcn_global_load_lds((const unsigned*)((const char*)(gbase) + (o1)), (LAS unsigned*)(lds + (bufoff) + ldsw + 8192), 16, 0, 0); } while (0)
#define PG8_LDA(dst, b, h) do { _Pragma("unroll") for (int m = 0; m < 4; ++m) _Pragma("unroll") for (int k = 0; k < 2; ++k) dst[m][k] = *(const LAS bf16x8*)(lds + PG8_SA(b, h) + aoff + m * 2048 + k * 1024); } while (0)
#define PG8_LDB(dst, b, h) do { _Pragma("unroll") for (int n = 0; n < 2; ++n) _Pragma("unroll") for (int k = 0; k < 2; ++k) dst[n][k] = *(const LAS bf16x8*)(lds + PG8_SB(b, h) + boff + n * 2048 + k * 1024); } while (0)
#define PG8_MMA(ai, bj, At, Bt) do { __builtin_amdgcn_s_setprio(1); _Pragma("unroll") for (int m = 0; m < 4; ++m) _Pragma("unroll") for (int n = 0; n < 2; ++n) _Pragma("unroll") for (int k = 0; k < 2; ++k) \
        acc[ai][bj][m][n] = __builtin_amdgcn_mfma_f32_16x16x32_bf16(Bt[n][k], At[m][k], acc[ai][bj][m][n], 0, 0, 0); __builtin_amdgcn_s_setprio(0); } while (0)
#define PG8_WAIT_V(n) asm volatile("s_waitcnt vmcnt(" #n ")" ::: "memory")
#define PG8_WAIT_L(n) asm volatile("s_waitcnt lgkmcnt(" #n ")" ::: "memory")
#define PG8_BAR __builtin_amdgcn_s_barrier()
#define PG8_SCHED __builtin_amdgcn_sched_barrier(0)
    Unit cur, nxt; int ui = 0;
    if (!S.next(0, cur)) return;
    f32x4 acc[2][2][4][2];
#pragma unroll
    for (int a = 0; a < 2; ++a)
#pragma unroll
        for (int b = 0; b < 2; ++b)
#pragma unroll
            for (int m = 0; m < 4; ++m)
#pragma unroll
                for (int n = 0; n < 2; ++n) acc[a][b][m][n] = (f32x4){0.f, 0.f, 0.f, 0.f};
    bf16x8 At[4][2], B0[2][2], B1[2][2];
    unsigned o00, o01, o10, o11;
    if constexpr (GATHER) { o00 = S.arow(cur, R0) * lda2 + (unsigned)(C0 * 2); o01 = S.arow(cur, R1) * lda2 + (unsigned)(C1 * 2); o10 = S.arow(cur, 128 + R0) * lda2 + (unsigned)(C0 * 2); o11 = S.arow(cur, 128 + R1) * lda2 + (unsigned)(C1 * 2); }
    else { o00 = (unsigned)R0 * lda2 + (unsigned)(C0 * 2); o01 = (unsigned)R1 * lda2 + (unsigned)(C1 * 2); o10 = o00; o11 = o01; }
    const char* cA = gA + (size_t)cur.pm * tstepA;
    const char* cB = S.bptr(cur);
    PG8_STAGE(PG8_SB(0, 0), cB, vb0, vb1); PG8_STAGE(PG8_SB(0, 1), cB + hstepB, vb0, vb1); PG8_STAGE(PG8_SA(0, 0), cA, o00, o01); PG8_STAGE(PG8_SA(0, 1), cA + hstepA, o10, o11);
    if (wr == 1) PG8_BAR;
    PG8_WAIT_V(2); PG8_BAR;
    PG8_STAGE(PG8_SB(1, 0), cB + kstep, vb0, vb1); PG8_STAGE(PG8_SA(1, 0), cA + kstep, o00, o01); PG8_STAGE(PG8_SB(1, 1), cB + hstepB + kstep, vb0, vb1);
    PG8_WAIT_V(6); PG8_BAR;
    for (;;) {
        const bool has_next = S.next(ui + 1, nxt);
        const char* nA = has_next ? gA + (size_t)nxt.pm * tstepA : cA; const char* nB = has_next ? S.bptr(nxt) : cB;
        for (int t = 0; t < nt; t += 2) {
            const bool last = (t == nt - 2);
            const char* a1 = cA + (size_t)(t + 1) * kstep;
            const char* a2 = last ? nA : cA + (size_t)(t + 2) * kstep; const char* b2 = last ? nB : cB + (size_t)(t + 2) * kstep;
            const char* a3 = a2 + kstep; const char* b3 = b2 + kstep;
            unsigned s00 = o00, s01 = o01, s10 = o10, s11 = o11;
            if constexpr (GATHER) { if (last && has_next) { s00 = S.arow(nxt, R0) * lda2 + (unsigned)(C0 * 2); s01 = S.arow(nxt, R1) * lda2 + (unsigned)(C1 * 2); s10 = S.arow(nxt, 128 + R0) * lda2 + (unsigned)(C0 * 2); s11 = S.arow(nxt, 128 + R1) * lda2 + (unsigned)(C1 * 2); } }
            PG8_LDB(B0, 0, 0); PG8_LDB(B1, 0, 1); PG8_SCHED; PG8_LDA(At, 0, 0); PG8_STAGE(PG8_SA(1, 1), a1 + hstepA, o10, o11);
            PG8_WAIT_V(8); PG8_WAIT_L(0); PG8_BAR; PG8_MMA(0, 0, At, B0); PG8_MMA(0, 1, At, B1); PG8_BAR; PG8_SCHED;
            PG8_LDA(At, 0, 1); PG8_STAGE(PG8_SB(0, 0), b2, vb0, vb1); PG8_STAGE(PG8_SB(0, 1), b2 + hstepB, vb0, vb1); PG8_STAGE(PG8_SA(0, 0), a2, s00, s01);
            PG8_WAIT_V(8); PG8_WAIT_L(0); PG8_BAR; PG8_MMA(1, 0, At, B0); PG8_MMA(1, 1, At, B1); PG8_BAR; PG8_SCHED;
            PG8_LDB(B0, 1, 0); PG8_LDB(B1, 1, 1); PG8_SCHED; PG8_LDA(At, 1, 0); PG8_STAGE(PG8_SA(0, 1), a2 + hstepA, s10, s11);
            PG8_WAIT_V(8); PG8_WAIT_L(0); PG8_BAR; PG8_MMA(0, 0, At, B0); PG8_MMA(0, 1, At, B1); PG8_BAR; PG8_SCHED;
            PG8_LDA(At, 1, 1); PG8_STAGE(PG8_SB(1, 0), b3, vb0, vb1); PG8_STAGE(PG8_SB(1, 1), b3 + hstepB, vb0, vb1); PG8_STAGE(PG8_SA(1, 0), a3, s00, s01);
            PG8_WAIT_V(8); PG8_WAIT_L(0); PG8_BAR; PG8_MMA(1, 0, At, B0); PG8_MMA(1, 1, At, B1); PG8_BAR; PG8_SCHED;
        }
        if (wr == 0) PG8_BAR;
        { const int t2 = opaque_tid(), w2 = __builtin_amdgcn_readfirstlane(t2 >> 6); E(acc, cur, w2 >> 2, w2 & 3, t2 & 15, (t2 & 63) >> 4); }
        if (!has_next) break;
#pragma unroll
        for (int a = 0; a < 2; ++a)
#pragma unroll
            for (int b = 0; b < 2; ++b)
#pragma unroll
                for (int m = 0; m < 4; ++m)
#pragma unroll
                    for (int n = 0; n < 2; ++n) acc[a][b][m][n] = (f32x4){0.f, 0.f, 0.f, 0.f};
        cur = nxt; cA = nA; cB = nB; ++ui;
        if constexpr (GATHER) { o00 = S.arow(cur, R0) * lda2 + (unsigned)(C0 * 2); o01 = S.arow(cur, R1) * lda2 + (unsigned)(C1 * 2); o10 = S.arow(cur, 128 + R0) * lda2 + (unsigned)(C0 * 2); o11 = S.arow(cur, 128 + R1) * lda2 + (unsigned)(C1 * 2); }
        if (wr == 1) PG8_BAR;
    }
    PG8_WAIT_V(0);
    PG8_BAR;
#undef PG8_SA
#undef PG8_SB
#undef PG8_STAGE
#undef PG8_LDA
#undef PG8_LDB
#undef PG8_MMA
#undef PG8_WAIT_V
#undef PG8_WAIT_L
#undef PG8_BAR
#undef PG8_SCHED
}
}

typedef const f32x4 (&AccRef)[2][2][4][2];
#define EPI_ROW(u, ai, m) ((u).pm * 256 + (ai) * 128 + wr * 64 + (m) * 16 + fr)
#define EPI_COL(bj, n) ((bj) * 128 + wc * 32 + (n) * 16 + 4 * fq)

struct EpiInProj {
    bf16_t *Q, *K, *V, *QKM, *VM, *OMS, *GA, *GB; float* GATES; const float* b_gates; const f32x2* rope; unsigned* mstab;
    __device__ __forceinline__ void operator()(AccRef acc, const pg8::Unit& u, int wr, int wc, int fr, int fq) const {
        const int b = u.pm / 65, tile = u.pm % 65; const bool is_ctx = (tile == 64);
        if (u.pn == 32) {
            if (wc != 0) return;
            const f32x4 bg = *(const f32x4*)(b_gates + 4 * fq);
            f32x4 mx = (f32x4){0.f, 0.f, 0.f, 0.f};
#pragma unroll
            for (int ai = 0; ai < 2; ++ai)
#pragma unroll
                for (int m = 0; m < 4; ++m) { const f32x4 g = acc[ai][0][m][0] + bg; *(f32x4*)(GATES + (size_t)EPI_ROW(u, ai, m) * 16 + 4 * fq) = g;
                    mx.x = fmaxf(mx.x, g.x); mx.y = fmaxf(mx.y, g.y); mx.z = fmaxf(mx.z, g.z); mx.w = fmaxf(mx.w, g.w); }
#pragma unroll
            for (int o = 1; o < 16; o <<= 1) { mx.x = fmaxf(mx.x, __shfl_xor(mx.x, o)); mx.y = fmaxf(mx.y, __shfl_xor(mx.y, o)); mx.z = fmaxf(mx.z, __shfl_xor(mx.z, o)); mx.w = fmaxf(mx.w, __shfl_xor(mx.w, o)); }
            if (fr == 0 && (fq == 0 || fq == 2)) { const int dir = fq >> 1;
                const unsigned r0 = atomicMax(mstab + (b * 4 + 0) * 2 + dir, __float_as_uint(mx.x)), r1 = atomicMax(mstab + (b * 4 + 1) * 2 + dir, __float_as_uint(mx.y));
                const unsigned r2 = atomicMax(mstab + (b * 4 + 2) * 2 + dir, __float_as_uint(mx.z)), r3 = atomicMax(mstab + (b * 4 + 3) * 2 + dir, __float_as_uint(mx.w));
                asm volatile("" :: "v"(r0), "v"(r1), "v"(r2), "v"(r3)); }
            return;
        }
        const int grp = u.pn >> 2, cbase = (u.pn & 3) * 256;
        bf16_t* dst = grp == 0 ? Q : grp == 1 ? K : grp == 2 ? V : grp == 3 ? QKM : grp == 4 ? VM : grp == 5 ? OMS : grp == 6 ? GA : GB;
        if (grp <= 1 && !is_ctx) {
            const bool colrot = (wc & 1) != 0; const float qs = grp == 0 ? QSCALE : 1.f;
#pragma unroll
            for (int ai = 0; ai < 2; ++ai) { f32x4 csa[4], csb[4];
#pragma unroll
                for (int m = 0; m < 4; ++m) { const int t = tile * 256 + ai * 128 + wr * 64 + m * 16 + fr; const int pos = colrot ? (t & 63) : (t >> 6);
                    csa[m] = *(const f32x4*)(rope + pos * 16 + 4 * fq); csb[m] = *(const f32x4*)(rope + pos * 16 + 4 * fq + 2); }
#pragma unroll
                for (int m = 0; m < 4; ++m) { const int row = EPI_ROW(u, ai, m);
                    const f32x4 cs0 = csa[m], cs1 = csb[m];
                    const f32x4 cv = (f32x4){cs0.x, cs0.z, cs1.x, cs1.z}, sv = (f32x4){cs0.y, cs0.w, cs1.y, cs1.w};
#pragma unroll
                    for (int bj = 0; bj < 2; ++bj) { const f32x4 x0 = acc[ai][bj][m][0], x1 = acc[ai][bj][m][1];
                        const f32x4 o0 = (x0 * cv - x1 * sv) * qs, o1 = (x1 * cv + x0 * sv) * qs;
                        bf16_t* p = dst + (size_t)row * 1024 + cbase + EPI_COL(bj, 0);
                        *(u32x2*)p = pk4(o0); *(u32x2*)(p + 16) = pk4(o1); } } }
            return;
        }
        const bool sig = grp >= 5; const float qs2 = grp == 0 ? QSCALE : 1.f;
#pragma unroll
        for (int ai = 0; ai < 2; ++ai)
#pragma unroll
            for (int m = 0; m < 4; ++m) { const int row = EPI_ROW(u, ai, m);
#pragma unroll
                for (int bj = 0; bj < 2; ++bj) { u32x2 pk[2];
#pragma unroll
                    for (int n = 0; n < 2; ++n) { f32x4 v = acc[ai][bj][m][n] * qs2;
                        if (sig) { v.x = sigmoidf_(v.x); v.y = sigmoidf_(v.y); v.z = sigmoidf_(v.z); v.w = sigmoidf_(v.w); }
                        pk[n] = pk4(v); }
                    bf16_t* p = dst + (size_t)row * 1024 + cbase;
                    if (grp >= 2) *(u32x4*)(p + bj * 128 + wc * 32 + 8 * fq) = (u32x4){pk[0].x, pk[0].y, pk[1].x, pk[1].y};
                    else { *(u32x2*)(p + EPI_COL(bj, 0)) = pk[0]; *(u32x2*)(p + EPI_COL(bj, 1)) = pk[1]; } } }
    }
};
struct EpiGate1 {
    const bf16_t* G; bf16_t* O;
    __device__ __forceinline__ void operator()(AccRef acc, const pg8::Unit& u, int wr, int wc, int fr, int fq) const {
#pragma unroll
        for (int ai = 0; ai < 2; ++ai) { u32x4 gw[4][2];
#pragma unroll
            for (int m = 0; m < 4; ++m) { const size_t ro = (size_t)EPI_ROW(u, ai, m) * 1024 + u.pn * 256;
#pragma unroll
                for (int bj = 0; bj < 2; ++bj) gw[m][bj] = *(const u32x4*)(G + ro + bj * 128 + wc * 32 + 8 * fq); }
#pragma unroll
            for (int m = 0; m < 4; ++m) { const size_t ro = (size_t)EPI_ROW(u, ai, m) * 1024 + u.pn * 256;
#pragma unroll
                for (int bj = 0; bj < 2; ++bj) { const u32x4 g = gw[m][bj];
                    const u32x2 lo = pk4(unpk4((u32x2){g.x, g.y}) * acc[ai][bj][m][0]), hi = pk4(unpk4((u32x2){g.z, g.w}) * acc[ai][bj][m][1]);
                    *(u32x4*)(O + ro + bj * 128 + wc * 32 + 8 * fq) = (u32x4){lo.x, lo.y, hi.x, hi.y}; } } }
    }
};
struct EpiGate2 {
    const bf16_t* G; const bf16_t* T1; bf16_t* O;
    __device__ __forceinline__ void operator()(AccRef acc, const pg8::Unit& u, int wr, int wc, int fr, int fq) const {
#pragma unroll
        for (int ai = 0; ai < 2; ++ai) { u32x4 gw[4][2], tw[4][2];
#pragma unroll
            for (int m = 0; m < 4; ++m) { const size_t ro = (size_t)EPI_ROW(u, ai, m) * 1024 + u.pn * 256;
#pragma unroll
                for (int bj = 0; bj < 2; ++bj) { gw[m][bj] = *(const u32x4*)(G + ro + bj * 128 + wc * 32 + 8 * fq); tw[m][bj] = *(const u32x4*)(T1 + ro + bj * 128 + wc * 32 + 8 * fq); } }
#pragma unroll
            for (int m = 0; m < 4; ++m) { const size_t ro = (size_t)EPI_ROW(u, ai, m) * 1024 + u.pn * 256;
#pragma unroll
                for (int bj = 0; bj < 2; ++bj) { const u32x4 g = gw[m][bj], t = tw[m][bj];
                    const u32x2 lo = pk4(unpk4((u32x2){t.x, t.y}) + unpk4((u32x2){g.x, g.y}) * acc[ai][bj][m][0]), hi = pk4(unpk4((u32x2){t.z, t.w}) + unpk4((u32x2){g.z, g.w}) * acc[ai][bj][m][1]);
                    *(u32x4*)(O + ro + bj * 128 + wc * 32 + 8 * fq) = (u32x4){lo.x, lo.y, hi.x, hi.y}; } } }
    }
};
struct XSrc {
    const float* x; const float* ctx; const float* xcur; int layer;
    __device__ __forceinline__ const float* row(int r) const {
        if (layer) return xcur + (size_t)r * 1024;
        const int b = r / TPB, t = r % TPB;
        return t < SEQ ? x + ((size_t)b * SEQ + t) * 1024 : ctx + ((size_t)b * CTX + (t - SEQ)) * 1024;
    }
};
struct EpiOut {
    XSrc xs; const float* modv  ; float* R;
    __device__ __forceinline__ void operator()(AccRef acc, const pg8::Unit& u, int wr, int wc, int fr, int fq) const {
        const int b = u.pm / 65, set = (u.pm % 65 == 64) ? 2 : b; const float* gate = modv + set * 6144 + 2 * 1024 + u.pn * 256;
        f32x4 g[2][2];
#pragma unroll
        for (int bj = 0; bj < 2; ++bj)
#pragma unroll
            for (int n = 0; n < 2; ++n) g[bj][n] = *(const f32x4*)(gate + bj * 128 + wc * 32 + 8 * fq + 4 * n);
#pragma unroll
        for (int ai = 0; ai < 2; ++ai) { f32x4 xv[4][2][2];
#pragma unroll
            for (int m = 0; m < 4; ++m) { const float* xr = xs.row(EPI_ROW(u, ai, m)) + u.pn * 256;
#pragma unroll
                for (int bj = 0; bj < 2; ++bj)
#pragma unroll
                    for (int n = 0; n < 2; ++n) xv[m][bj][n] = *(const f32x4*)(xr + bj * 128 + wc * 32 + 8 * fq + 4 * n); }
#pragma unroll
            for (int m = 0; m < 4; ++m) { bf16_t* rr = (bf16_t*)R + (size_t)EPI_ROW(u, ai, m) * 1024 + u.pn * 256;
#pragma unroll
                for (int bj = 0; bj < 2; ++bj) { const u32x2 lo = pk4(xv[m][bj][0] * ALPHA_RES + g[bj][0] * acc[ai][bj][m][0]), hi = pk4(xv[m][bj][1] * ALPHA_RES + g[bj][1] * acc[ai][bj][m][1]);
                    *(u32x4*)(rr + bj * 128 + wc * 32 + 8 * fq) = (u32x4){lo.x, lo.y, hi.x, hi.y}; } } }
    }
};
struct EpiLogits {
    float* O;
    __device__ __forceinline__ void operator()(AccRef acc, const pg8::Unit& u, int wr, int wc, int fr, int fq) const {
#pragma unroll
        for (int ai = 0; ai < 2; ++ai)
#pragma unroll
            for (int m = 0; m < 4; ++m) { float* rr = O + (size_t)EPI_ROW(u, ai, m) * 256;
#pragma unroll
                for (int bj = 0; bj < 2; ++bj)
#pragma unroll
                    for (int n = 0; n < 2; ++n) *(f32x4*)(rr + EPI_COL(bj, n)) = acc[ai][bj][m][n]; }
    }
};
struct EpiSwiglu {
    bf16_t* HE;
    __device__ __forceinline__ void operator()(AccRef acc, const pg8::Unit& u, int wr, int wc, int fr, int fq) const {
#pragma unroll
        for (int ai = 0; ai < 2; ++ai)
#pragma unroll
            for (int m = 0; m < 4; ++m) { bf16_t* rr = HE + (size_t)EPI_ROW(u, ai, m) * 256 + u.pn * 128;
                u32x2 pk[2];
#pragma unroll
                for (int n = 0; n < 2; ++n) { const f32x4 a = acc[ai][0][m][n], g = acc[ai][1][m][n];
                    f32x4 o; o.x = siluf_(a.x) * g.x; o.y = siluf_(a.y) * g.y; o.z = siluf_(a.z) * g.z; o.w = siluf_(a.w) * g.w; pk[n] = pk4(o); }
                *(u32x4*)(rr + wc * 32 + 8 * fq) = (u32x4){pk[0].x, pk[0].y, pk[1].x, pk[1].y}; }
    }
};
constexpr float YB8_SCALE = 64.f;
__device__ __forceinline__ unsigned pk4_fp8(f32x4 v) { int w = 0; w = __builtin_amdgcn_cvt_pk_fp8_f32(v.x, v.y, w, false); w = __builtin_amdgcn_cvt_pk_fp8_f32(v.z, v.w, w, true); return (unsigned)w; }
__device__ __forceinline__ f32x4 unpk4_fp8(unsigned w) { return (f32x4){__builtin_amdgcn_cvt_f32_fp8((int)w, 0), __builtin_amdgcn_cvt_f32_fp8((int)w, 1), __builtin_amdgcn_cvt_f32_fp8((int)w, 2), __builtin_amdgcn_cvt_f32_fp8((int)w, 3)}; }
struct EpiScaleRow {
    bf16_t* YB; const float* roww;
    __device__ __forceinline__ void operator()(AccRef acc, const pg8::Unit& u, int wr, int wc, int fr, int fq) const {
        float w8[2][4];
#pragma unroll
        for (int ai = 0; ai < 2; ++ai)
#pragma unroll
            for (int m = 0; m < 4; ++m) w8[ai][m] = roww[EPI_ROW(u, ai, m)];
#pragma unroll
        for (int ai = 0; ai < 2; ++ai)
#pragma unroll
            for (int m = 0; m < 4; ++m) { const int row = EPI_ROW(u, ai, m); const float w0 = w8[ai][m], w = w0 * YB8_SCALE;
#pragma unroll
                for (int bj = 0; bj < 2; ++bj)
                    if (w0 >= 0.f) *(u32x2*)((unsigned char*)YB + (size_t)row * 1024 + u.pn * 256 + bj * 128 + wc * 32 + 8 * fq) = (u32x2){pk4_fp8(acc[ai][bj][m][0] * w), pk4_fp8(acc[ai][bj][m][1] * w)};
                asm volatile("" ::: "memory"); }
    }
};

namespace att {
constexpr int QBLK = 32, KVBLK = 64, LDX = 1024;
constexpr float SCALE = 0.125f, THR = 8.f;
constexpr size_t SHM_V = KVBLK * 128 * 2, SHM_K = KVBLK * 64 * 2, SHM_ATTN = 2 * SHM_V + 2 * SHM_K + NWAVES * 64 * 4;
#define KSWZ64(row, colB) ((row) * 128 + ((colB) ^ ((((row) >> 1) & 7) << 4)))
#define SBAR() __builtin_amdgcn_sched_barrier(0)
__device__ __forceinline__ int crow(int r, int hi) { return (r & 3) + 8 * (r >> 2) + 4 * hi; }
__device__ __forceinline__ unsigned cvtpk(float lo, float hi) { unsigned r; asm volatile("v_cvt_pk_bf16_f32 %0, %1, %2" : "=v"(r) : "v"(lo), "v"(hi)); return r; }
__device__ __forceinline__ void partialSM(f32x16& p0, f32x16& p1, float& m_reg, float& mn, float& alpha) {
  constexpr float C = SCALE * 1.4426950408889634f;
  float pmax = p0[0];
#pragma unroll
  for (int r = 1; r < 16; ++r) pmax = fmaxf(pmax, p0[r]);
#pragma unroll
  for (int r = 0; r < 16; ++r) pmax = fmaxf(pmax, p1[r]);
  { auto rr = __builtin_amdgcn_permlane32_swap(__float_as_uint(pmax), __float_as_uint(pmax), false, false);
    pmax = fmaxf(__uint_as_float(rr[0]), __uint_as_float(rr[1])); }
  if (__builtin_expect(__all(pmax - m_reg <= THR / SCALE), 1)) { mn = m_reg; alpha = 1.f; }
  else { mn = fmaxf(m_reg, pmax); alpha = __builtin_amdgcn_exp2f((m_reg - mn) * C); m_reg = mn; }
  float mnC = -mn * C;
#pragma unroll
  for (int r = 0; r < 16; ++r) p0[r] = fmaf(p0[r], C, mnC);
#pragma unroll
  for (int r = 0; r < 16; ++r) p1[r] = fmaf(p1[r], C, mnC);
#pragma unroll
  for (int r = 0; r < 16; ++r) p0[r] = __builtin_amdgcn_exp2f(p0[r]);
}
__device__ __forceinline__ void finishSM(f32x16& p0, f32x16& p1, float alpha, float& l_reg, bf16x8& pa0, bf16x8& pa1, bf16x8& pa2, bf16x8& pa3) {
#pragma unroll
  for (int r = 0; r < 16; ++r) p1[r] = __builtin_amdgcn_exp2f(p1[r]);
  float ps = 0;
#pragma unroll
  for (int r = 0; r < 16; ++r) ps += p0[r];
#pragma unroll
  for (int r = 0; r < 16; ++r) ps += p1[r];
  { auto rr = __builtin_amdgcn_permlane32_swap(__float_as_uint(ps), __float_as_uint(ps), false, false);
    ps = __uint_as_float(rr[0]) + __uint_as_float(rr[1]); }
  l_reg = l_reg * alpha + ps;
#define PK4(P, BASE, OUT) do { u32x4 w = {cvtpk(P[BASE + 0], P[BASE + 1]), cvtpk(P[BASE + 2], P[BASE + 3]), cvtpk(P[BASE + 4], P[BASE + 5]), cvtpk(P[BASE + 6], P[BASE + 7])}; \
    OUT = *reinterpret_cast<bf16x8*>(&w); } while (0)
  PK4(p0, 0, pa0); PK4(p0, 8, pa1); PK4(p1, 0, pa2); PK4(p1, 8, pa3);
#undef PK4
}
__device__ __forceinline__ void qkt(f32x16& p0, f32x16& p1, const char* Ks, const bf16x8* qr, int r32, int hi) {
  p0 = f32x16{}; p1 = f32x16{};
#pragma unroll
  for (int d0 = 0; d0 < 4; ++d0) { const int cb = (d0 * 16 + hi * 8) * 2;
    bf16x8 b0 = *reinterpret_cast<const bf16x8*>(Ks + KSWZ64(r32, cb));
    bf16x8 b1 = *reinterpret_cast<const bf16x8*>(Ks + KSWZ64(32 + r32, cb));
    p0 = __builtin_amdgcn_mfma_f32_32x32x16_bf16(b0, qr[d0], p0, 0, 0, 0);
    p1 = __builtin_amdgcn_mfma_f32_32x32x16_bf16(b1, qr[d0], p1, 0, 0, 0); }
}
__device__ __forceinline__ int v_st(int k, int c) { const int kk = (k & ~0xC) | ((k & 4) << 1) | ((k & 8) >> 1); return ((kk >> 3) * 4 + (c >> 5)) * 512 + ((kk & 7) * 32 + (c & 31)) * 2; }
__device__ __forceinline__ int v_rd_base(int lane) { return ((lane & 3) << 3) | (((lane >> 2) & 3) << 6) | (((lane >> 4) & 1) << 5) | (((lane >> 5) & 1) << 8); }
constexpr int v_rd_off(int d0, int ks, int half) { return d0 * 512 + ks * 4096 + half * 2048; }
template <int OFF> __device__ __forceinline__ s16x4 tr_read(int vb) {
  s16x4 r; asm volatile("ds_read_b64_tr_b16 %0, %1 offset:%2" : "=&v"(r) : "v"(vb), "i"(OFF) : "memory"); return r;
}
template <int I> __device__ __forceinline__ void pv_rd(s16x4& L, s16x4& H, int vb) { L = tr_read<v_rd_off(I >> 2, I & 3, 0)>(vb); H = tr_read<v_rd_off(I >> 2, I & 3, 1)>(vb); }
template <int N> __device__ __forceinline__ void pv_wait(s16x4& L, s16x4& H) { asm volatile("s_waitcnt lgkmcnt(%2)" : "+v"(L), "+v"(H) : "i"(N) : "memory"); }
__device__ __forceinline__ void pv_d0(f32x16* o, int vb, bf16x8 pa0, bf16x8 pa1, bf16x8 pa2, bf16x8 pa3) {
  s16x4 L0, H0, L1, H1, L2, H2, L3, H3;
#define PK(L, H) (bf16x8){L[0], L[1], L[2], L[3], H[0], H[1], H[2], H[3]}
#define PVM(I, PA, L, H, CNT) do { pv_wait<CNT>(L, H); o[(I) >> 2] = __builtin_amdgcn_mfma_f32_32x32x16_bf16(PA, PK(L, H), o[(I) >> 2], 0, 0, 0); } while (0)
  pv_rd<0>(L0, H0, vb); pv_rd<1>(L1, H1, vb); pv_rd<2>(L2, H2, vb);
  PVM(0, pa0, L0, H0, 4);  pv_rd<3>(L3, H3, vb);
  PVM(1, pa1, L1, H1, 4);  pv_rd<4>(L0, H0, vb);
  PVM(2, pa2, L2, H2, 4);  pv_rd<5>(L1, H1, vb);
  PVM(3, pa3, L3, H3, 4);  pv_rd<6>(L2, H2, vb);
  PVM(4, pa0, L0, H0, 4);  pv_rd<7>(L3, H3, vb);
  PVM(5, pa1, L1, H1, 4);  pv_rd<8>(L0, H0, vb);
  PVM(6, pa2, L2, H2, 4);  pv_rd<9>(L1, H1, vb);
  PVM(7, pa3, L3, H3, 4);  pv_rd<10>(L2, H2, vb);
  PVM(8, pa0, L0, H0, 4);  pv_rd<11>(L3, H3, vb);
  PVM(9, pa1, L1, H1, 4);  pv_rd<12>(L0, H0, vb);
  PVM(10, pa2, L2, H2, 4); pv_rd<13>(L1, H1, vb);
  PVM(11, pa3, L3, H3, 4); pv_rd<14>(L2, H2, vb);
  PVM(12, pa0, L0, H0, 4); pv_rd<15>(L3, H3, vb);
  PVM(13, pa1, L1, H1, 4);
  PVM(14, pa2, L2, H2, 2);
  PVM(15, pa3, L3, H3, 0);
#undef PVM
#undef PK
}
constexpr int NSLOT = 4, NVSLOT = 5, KSLOT = 8192, VSLOT = 16384, LDS_K = 0, LDS_V = NSLOT * KSLOT, LDS_WS = LDS_V + NVSLOT * VSLOT, LDS_END = LDS_WS + NWAVES * 64 * 4;
static_assert(LDS_END <= RING_BYTES, "attention LDS");
constexpr float THR2 = 8.f;
__device__ __forceinline__ void glds16(const void* sbase, unsigned voff, unsigned lds_dst) { unsigned keep;
  asm volatile("s_mov_b32 %0, m0\n\ts_mov_b32 m0, %3\n\ts_nop 2\n\tglobal_load_lds_dwordx4 %1, %2\n\ts_mov_b32 m0, %0" : "=&s"(keep) : "v"(voff), "s"(sbase), "s"(lds_dst) : "memory"); }
#define WAIT_BAR(N) asm volatile("s_waitcnt vmcnt(" #N ") lgkmcnt(0)\n\ts_barrier" ::: "memory")
__device__ __forceinline__ float rowmax32(const f32x16& p0, const f32x16& p1) {
  float a = fmaxf(fmaxf(p0[0], p0[1]), p1[0]), b = fmaxf(fmaxf(p0[2], p0[3]), p1[1]); a = fmaxf(fmaxf(a, p1[2]), p1[3]);
#pragma unroll
  for (int r = 4; r < 16; r += 4) { a = fmaxf(fmaxf(a, p0[r]), p0[r + 1]); b = fmaxf(fmaxf(b, p0[r + 2]), p0[r + 3]); a = fmaxf(fmaxf(a, p1[r]), p1[r + 1]); b = fmaxf(fmaxf(b, p1[r + 2]), p1[r + 3]); }
  float m = fmaxf(a, b);
  auto rr = __builtin_amdgcn_permlane32_swap(__float_as_uint(m), __float_as_uint(m), false, false);
  return fmaxf(__uint_as_float(rr[0]), __uint_as_float(rr[1]));
}
template <bool FIRST> __device__ __forceinline__ void partialSM2(f32x16& p0, f32x16& p1, float& m_reg, f32x16& negm, float& alpha) {
  const float pmax = rowmax32(p0, p1);
  if (FIRST || !__builtin_expect(__all(pmax <= THR2), 1)) {
    const float dl = FIRST ? pmax : fmaxf(pmax, 0.f); m_reg += dl;
#pragma unroll
    for (int r = 0; r < 16; ++r) { p0[r] -= dl; p1[r] -= dl; }
#pragma unroll
    for (int r = 0; r < 16; ++r) negm[r] = -m_reg;
    alpha = FIRST ? 1.f : __builtin_amdgcn_exp2f(-dl);
  } else alpha = 1.f;
#pragma unroll
  for (int r = 0; r < 16; ++r) p0[r] = __builtin_amdgcn_exp2f(p0[r]);
}
__device__ __forceinline__ void qkt2(f32x16& p0, f32x16& p1, const char* Ks, const bf16x8* qr, const f32x16& negm, int r32, int hi) {
#pragma unroll
  for (int d0 = 0; d0 < 4; ++d0) { const int cb = (d0 * 16 + hi * 8) * 2;
    bf16x8 b0 = *reinterpret_cast<const bf16x8*>(Ks + KSWZ64(r32, cb));
    bf16x8 b1 = *reinterpret_cast<const bf16x8*>(Ks + KSWZ64(32 + r32, cb));
    if (d0 == 0) { p0 = __builtin_amdgcn_mfma_f32_32x32x16_bf16(b0, qr[0], negm, 0, 0, 0); p1 = __builtin_amdgcn_mfma_f32_32x32x16_bf16(b1, qr[0], negm, 0, 0, 0); }
    else { p0 = __builtin_amdgcn_mfma_f32_32x32x16_bf16(b0, qr[d0], p0, 0, 0, 0); p1 = __builtin_amdgcn_mfma_f32_32x32x16_bf16(b1, qr[d0], p1, 0, 0, 0); } }
}
__device__ __forceinline__ int swap23(int k) { return (k & ~0xC) | ((k & 4) << 1) | ((k & 8) >> 1); }
__device__ __forceinline__ void attn_body(const bf16_t* __restrict__ Qb, const bf16_t* __restrict__ Kh, const bf16_t* __restrict__ Vh, bf16_t* __restrict__ Ob, int seq, char* lds) {
  const int tid = opaque_tid(), wid = __builtin_amdgcn_readfirstlane(tid >> 6), lane = tid & 63, r32 = lane & 31, hi = lane >> 5;
  const unsigned lds0 = (unsigned)(uintptr_t)lds;
  const char* K_lds = lds + LDS_K;
  float* ws = (float*)(lds + LDS_WS) + wid * 64; float* li_l = ws; float* al_l = ws + 32;
  float m_reg = 0.f, l_reg = 0.f; f32x16 o[4] = {}; bf16x8 qr[4]; f32x16 negm = {};
  const bf16_t* Qw = Qb + (long)(wid * QBLK + r32) * LDX + hi * 8;
#pragma unroll
  for (int d0 = 0; d0 < 4; ++d0) qr[d0] = *reinterpret_cast<const bf16x8*>(Qw + d0 * 16);
  const int rowK = tid >> 3, cK = (tid & 7) ^ ((rowK >> 1) & 7);
  const unsigned ksrc = (unsigned)(rowK * LDX + cK * 8) * 2u;
  const int U0 = tid, U1 = 512 + tid;
  const int sub0 = U0 >> 5, sub1 = U1 >> 5;
  const unsigned vsrc0 = (unsigned)(((sub0 >> 2) * 8 + ((U0 >> 2) & 7)) * LDX + (sub0 & 3) * 32 + (U0 & 3) * 8) * 2u;
  const unsigned vsrc1 = (unsigned)(((sub1 >> 2) * 8 + ((U1 >> 2) & 7)) * LDX + (sub1 & 3) * 32 + (U1 & 3) * 8) * 2u;
  const unsigned kdst = lds0 + LDS_K + wid * 1024, vdst = lds0 + LDS_V + wid * 1024;
#define DMA(t) do { const unsigned sl_ = (unsigned)((t) & 3), sv_ = (unsigned)((t) % NVSLOT); const long go_ = (long)(t) * KVBLK * LDX; \
    glds16(Kh + go_, ksrc, (unsigned)__builtin_amdgcn_readfirstlane(kdst + sl_ * KSLOT)); glds16(Vh + go_, vsrc0, (unsigned)__builtin_amdgcn_readfirstlane(vdst + sv_ * VSLOT)); \
    glds16(Vh + go_, vsrc1, (unsigned)__builtin_amdgcn_readfirstlane(vdst + sv_ * VSLOT + 8192)); } while (0)
#define RESC(a) do { if (__any((a) < 1.f)) { if (hi == 0) al_l[r32] = (a); asm volatile("s_waitcnt lgkmcnt(0)" ::: "memory"); \
    _Pragma("unroll") for (int d = 0; d < 4; ++d) _Pragma("unroll") for (int r = 0; r < 16; ++r) o[d][r] *= al_l[crow(r, hi)]; } } while (0)
  const int vb0 = (int)(lds0 + LDS_V) + v_rd_base(lane);
  f32x16 pA0, pA1, pB0, pB1; float alA, alB; bf16x8 pa0, pa1, pa2, pa3; const int NT = seq / KVBLK;
  asm volatile("s_waitcnt vmcnt(0)" ::: "memory");
  if (wid < 4) __builtin_amdgcn_s_setprio(3);
  DMA(0); DMA(1);
  WAIT_BAR(3);
  DMA(2);
#define VSL(t) ((int)((t) % NVSLOT) * VSLOT)
  if (wid < 4) {
    qkt2(pA0, pA1, K_lds, qr, negm, r32, hi); partialSM2<true>(pA0, pA1, m_reg, negm, alA);
#define STEP(C0, C1, alC, P0, P1, alP, jj, WN) do { WAIT_BAR(WN); if ((jj) + 2 < NT) DMA((jj) + 2); \
      SBAR(); qkt2(C0, C1, K_lds + ((jj) & 3) * KSLOT, qr, negm, r32, hi); finishSM(P0, P1, alP, l_reg, pa0, pa1, pa2, pa3); SBAR(); \
      pv_d0(o, vb0 + VSL((jj) - 1), pa0, pa1, pa2, pa3); partialSM2<false>(C0, C1, m_reg, negm, alC); RESC(alC); } while (0)
    int j = 1;
    for (; j + 1 < NT; j += 2) { STEP(pB0, pB1, alB, pA0, pA1, alA, j, 3); STEP(pA0, pA1, alA, pB0, pB1, alB, j + 1, 3); }
    STEP(pB0, pB1, alB, pA0, pA1, alA, NT - 1, 0);
#undef STEP
  } else {
    qkt2(pA0, pA1, K_lds, qr, negm, r32, hi);
    WAIT_BAR(3); if (3 < NT) DMA(3);
    partialSM2<true>(pA0, pA1, m_reg, negm, alA);
    SBAR(); qkt2(pB0, pB1, K_lds + KSLOT, qr, negm, r32, hi); finishSM(pA0, pA1, alA, l_reg, pa0, pa1, pa2, pa3); SBAR();
#define STEPL(C0, C1, P0, P1, alP, jj, WN) do { WAIT_BAR(WN); if ((jj) + 2 < NT) DMA((jj) + 2); \
      pv_d0(o, vb0 + VSL((jj) - 2), pa0, pa1, pa2, pa3); partialSM2<false>(P0, P1, m_reg, negm, alP); RESC(alP); \
      SBAR(); qkt2(C0, C1, K_lds + ((jj) & 3) * KSLOT, qr, negm, r32, hi); finishSM(P0, P1, alP, l_reg, pa0, pa1, pa2, pa3); SBAR(); } while (0)
    int j = 2;
    for (; j + 2 < NT; j += 2) { STEPL(pA0, pA1, pB0, pB1, alB, j, 3); STEPL(pB0, pB1, pA0, pA1, alA, j + 1, 3); }
    STEPL(pA0, pA1, pB0, pB1, alB, NT - 2, 3); STEPL(pB0, pB1, pA0, pA1, alA, NT - 1, 0);
#undef STEPL
    pv_d0(o, vb0 + VSL(NT - 2), pa0, pa1, pa2, pa3); partialSM2<false>(pB0, pB1, m_reg, negm, alB); RESC(alB);
  }
  finishSM(pB0, pB1, alB, l_reg, pa0, pa1, pa2, pa3); SBAR();
  pv_d0(o, vb0 + VSL(NT - 1), pa0, pa1, pa2, pa3);
#undef VSL
  if (hi == 0) li_l[r32] = l_reg; asm volatile("s_waitcnt lgkmcnt(0)" ::: "memory");
  float rli[16];
#pragma unroll
  for (int r = 0; r < 16; ++r) rli[r] = __builtin_amdgcn_rcpf(li_l[crow(r, hi)]);
  bf16_t* Ow = Ob + (long)(wid * QBLK) * 2048;
#pragma unroll
  for (int r = 0; r < 16; ++r) { const int orow = crow(r, hi);
#pragma unroll
    for (int d0 = 0; d0 < 4; ++d0) Ow[(long)orow * 2048 + d0 * 32 + r32] = (bf16_t)f2bf(o[d0][r] * rli[r]); }
  __builtin_amdgcn_s_setprio(0);
  asm volatile("s_waitcnt lgkmcnt(0)\n\ts_barrier" ::: "memory");
#undef DMA
#undef RESC
#undef STEP
}
#undef WAIT_BAR
#undef SBAR
}

__device__ __forceinline__ int pos_f(int jb) { return jb < 256 ? 4 + jb : jb - 256; }
__device__ __forceinline__ int pos_b(int jb) { return jb < 256 ? 4 + 255 - jb : 3 - (jb - 256); }
constexpr int KP = 72;
constexpr int QP = 136;
__device__ __forceinline__ bf16x8 lds_frag(const LAS unsigned char* base, int row, int pitch, int col) { return *(const LAS bf16x8*)(base + ((size_t)row * pitch + col) * 2); }

__device__ __forceinline__ void conv_silu8(u32x4 xm, u32x4 x0, u32x4 xp, const float* cw  , float scale, float (&o)[8]) {
    const f32x4 w0a = *(const f32x4*)(cw), w0b = *(const f32x4*)(cw + 4), w1a = *(const f32x4*)(cw + 1024), w1b = *(const f32x4*)(cw + 1028), w2a = *(const f32x4*)(cw + 2048), w2b = *(const f32x4*)(cw + 2052);
    const float w0[8] = {w0a.x, w0a.y, w0a.z, w0a.w, w0b.x, w0b.y, w0b.z, w0b.w}, w1[8] = {w1a.x, w1a.y, w1a.z, w1a.w, w1b.x, w1b.y, w1b.z, w1b.w}, w2[8] = {w2a.x, w2a.y, w2a.z, w2a.w, w2b.x, w2b.y, w2b.z, w2b.w};
    const unsigned am[4] = {xm.x, xm.y, xm.z, xm.w}, a0[4] = {x0.x, x0.y, x0.z, x0.w}, ap[4] = {xp.x, xp.y, xp.z, xp.w};
#pragma unroll
    for (int e = 0; e < 8; ++e) { const unsigned sh = (e & 1) * 16;
        const float vm = bf2f((am[e >> 1] >> sh) & 0xffffu), v0 = bf2f((a0[e >> 1] >> sh) & 0xffffu), vp = bf2f((ap[e >> 1] >> sh) & 0xffffu);
        o[e] = siluf_(vm * w0[e] + v0 * w1[e] + vp * w2[e]) * scale; }
}

struct MlstmArgs { const bf16_t* QKM; const bf16_t* VM; const bf16_t* OMS; const float* GATES; const float* conv; const float* norm_m; const unsigned* mstab;
                   bf16_t* ST; float* NU; float* ADEC; bf16_t* HM; unsigned char* U8; };
constexpr float U8_SCALE = 256.f;

__device__ __forceinline__ void mlstm_gates(const MlstmArgs& A, int bh, int row0, int lane, float& bfv, float& bbv, float& ifm, float& ibm, float& bend_f, float& bend_b) {
    const f32x4 g0 = *(const f32x4*)(A.GATES + (size_t)(row0 + lane) * 16), g1 = *(const f32x4*)(A.GATES + (size_t)(row0 + lane) * 16 + 4),
                g2 = *(const f32x4*)(A.GATES + (size_t)(row0 + lane) * 16 + 8), g3 = *(const f32x4*)(A.GATES + (size_t)(row0 + lane) * 16 + 12);
    const int h = bh & 3;
    const float i_f = h == 0 ? g0.x : h == 1 ? g0.y : h == 2 ? g0.z : g0.w, f_f = h == 0 ? g1.x : h == 1 ? g1.y : h == 2 ? g1.z : g1.w;
    const float i_b = h == 0 ? g2.x : h == 1 ? g2.y : h == 2 ? g2.z : g2.w, f_b = h == 0 ? g3.x : h == 1 ? g3.y : h == 2 ? g3.z : g3.w;
    float inc = logsigf_(f_f), suf = logsigf_(f_b);
#pragma unroll
    for (int o = 1; o < 64; o <<= 1) { const float t = __shfl_up(inc, o); if (lane >= o) inc += t; }
#pragma unroll
    for (int o = 1; o < 64; o <<= 1) { const float t = __shfl_down(suf, o); if (lane + o < 64) suf += t; }
    bend_f = __shfl(inc, 63); bend_b = __shfl(suf, 0);
    const float Mf = __uint_as_float(__hip_atomic_load(A.mstab + bh * 2 + 0, RLX_AGENT)), Mb = __uint_as_float(__hip_atomic_load(A.mstab + bh * 2 + 1, RLX_AGENT));
    bfv = inc; bbv = suf; ifm = i_f - Mf; ibm = i_b - Mb;
}
__device__ __forceinline__ void mlstm_stage_vt(const MlstmArgs& A, int h, int row0, LAS unsigned char* VT, int tid) {
#pragma unroll
    for (int i = 0; i < 4; ++i) { const int p = tid + 512 * i, s = p & 63, ec = p >> 6;
        const u32x4 v = *(const u32x4*)(A.VM + (size_t)(row0 + s) * 1024 + h * 256 + ec * 8);
        const unsigned a[4] = {v.x, v.y, v.z, v.w};
#pragma unroll
        for (int e = 0; e < 8; ++e) *(LAS bf16_t*)(VT + ((size_t)(ec * 8 + e) * KP + s) * 2) = (bf16_t)((a[e >> 1] >> ((e & 1) * 16)) & 0xffffu); }
}
__device__ __forceinline__ void mlstm_load3(const bf16_t* QKM, int row0, int s, int ch, bool hasL, bool hasR, u32x4& xm, u32x4& x0, u32x4& xp) {
    const bf16_t* p = QKM + (size_t)(row0 + s) * 1024 + ch;
    x0 = *(const u32x4*)p;
    xm = (s > 0 || hasL) ? *(const u32x4*)(p - 1024) : (u32x4){0u, 0u, 0u, 0u};
    xp = (s < 63 || hasR) ? *(const u32x4*)(p + 1024) : (u32x4){0u, 0u, 0u, 0u};
}

__device__ __forceinline__ void mlstm_d1_unit(const MlstmArgs& A, int bh, int jb, LAS unsigned char* lds) {
    const int tid = opaque_tid(), lane = tid & 63, wave = __builtin_amdgcn_readfirstlane(tid >> 6), fr = lane & 15, fq = lane >> 4;
    const int b = bh >> 2, h = bh & 3, row0 = b * TPB + jb * 64;
    const bool hasL = !(jb == 0 || jb == 256), hasR = !(jb == 255 || jb == 259);
    LAS float* WF = (LAS float*)lds; LAS float* WB = WF + 64;
    LAS unsigned char* KF = lds + 512; LAS unsigned char* KB = KF + 128 * KP * 2; LAS unsigned char* VT = KB + 128 * KP * 2;
    const int cf = bh * 2, cb = bh * 2 + 1, pf = pos_f(jb), pb = pos_b(jb);
    u32x4 xm_[2], x0_[2], xp_[2];
#pragma unroll
    for (int i = 0; i < 2; ++i) { const int p = tid + 512 * i, s = p & 63, dc = p >> 6; mlstm_load3(A.QKM, row0, s, 512 + h * 128 + dc * 8, hasL, hasR, xm_[i], x0_[i], xp_[i]); }
    mlstm_stage_vt(A, h, row0, VT, tid);
    if (wave == 0) {
        float bfv, bbv, ifm, ibm, bend_f, bend_b; mlstm_gates(A, bh, row0, lane, bfv, bbv, ifm, ibm, bend_f, bend_b);
        WF[lane] = __expf(bend_f - bfv + ifm); WB[lane] = __expf(bend_b - bbv + ibm);
        if (lane == 0) { st_wt(A.ADEC + cf * NCHUNK + pf, __expf(bend_f)); st_wt(A.ADEC + cb * NCHUNK + pb, __expf(bend_b)); }
    }
    __syncthreads();
#pragma unroll
    for (int i = 0; i < 2; ++i) { const int p = tid + 512 * i, s = p & 63, dc = p >> 6; const int ch = 512 + h * 128 + dc * 8;
        const u32x4 xm = xm_[i], x0 = x0_[i], xp = xp_[i];
        float k[8]; conv_silu8(xm, x0, xp, A.conv + ch, 0.08838834764831845f, k);
        const float wf = WF[s], wb = WB[s];
#pragma unroll
        for (int e = 0; e < 8; ++e) { *(LAS bf16_t*)(KF + ((size_t)(dc * 8 + e) * KP + s) * 2) = (bf16_t)f2bf(k[e] * wf); *(LAS bf16_t*)(KB + ((size_t)(dc * 8 + e) * KP + s) * 2) = (bf16_t)f2bf(k[e] * wb); } }
    __syncthreads();
    if (tid < 256) { const int dir = tid >> 7, d = tid & 127; const LAS unsigned char* src = (dir ? KB : KF) + (size_t)d * KP * 2; float s = 0.f;
#pragma unroll 8
        for (int i = 0; i < 64; ++i) s += bf2f(*(const LAS bf16_t*)(src + i * 2));
        A.NU[((size_t)(dir ? cb : cf) * NCHUNK + (dir ? pb : pf)) * 128 + d] = s; }
#pragma unroll
    for (int dir = 0; dir < 2; ++dir) {
        const LAS unsigned char* KW = dir ? KB : KF;
        f32x4 acc[8][2];
#pragma unroll
        for (int m = 0; m < 8; ++m) { acc[m][0] = (f32x4){0.f, 0.f, 0.f, 0.f}; acc[m][1] = (f32x4){0.f, 0.f, 0.f, 0.f}; }
#pragma unroll
        for (int ks = 0; ks < 2; ++ks) {
            const bf16x8 b0 = lds_frag(VT, (2 * wave) * 16 + fr, KP, ks * 32 + fq * 8), b1 = lds_frag(VT, (2 * wave + 1) * 16 + fr, KP, ks * 32 + fq * 8);
#pragma unroll
            for (int m = 0; m < 8; ++m) { const bf16x8 a = lds_frag(KW, m * 16 + fr, KP, ks * 32 + fq * 8);
                acc[m][0] = __builtin_amdgcn_mfma_f32_16x16x32_bf16(a, b0, acc[m][0], 0, 0, 0); acc[m][1] = __builtin_amdgcn_mfma_f32_16x16x32_bf16(a, b1, acc[m][1], 0, 0, 0); } }
        unsigned char* dst8 = A.U8 + ((size_t)(dir ? cb : cf) * NCHUNK + (dir ? pb : pf)) * 32768;
#pragma unroll
        for (int m = 0; m < 8; ++m)
#pragma unroll
            for (int n = 0; n < 2; ++n) { const int e = (2 * wave + n) * 16 + fr, d0 = m * 16 + fq * 4; *(unsigned*)(dst8 + (size_t)e * 128 + d0) = pk4_fp8(acc[m][n] * U8_SCALE); }
    }
    __syncthreads();
}

__device__ __forceinline__ void mlstm_scan(const MlstmArgs& A, int gtid, int nthreads, bf16_t* dryST = nullptr, float* dryNU = nullptr) {
    constexpr int PF = 20;
    for (int it = gtid; it < NCHAIN * 8192; it += nthreads) {
        const int chain = it >> 13, e4 = (it & 8191) * 4; bf16_t* __restrict__ p = A.ST + (size_t)chain * NCHUNK * 32768 + e4; const float* __restrict__ ad = A.ADEC + chain * NCHUNK; const unsigned char* __restrict__ q8 = A.U8 + (size_t)chain * NCHUNK * 32768 + e4;
        f32x4 s = (f32x4){0.f, 0.f, 0.f, 0.f};
        for (int c0 = 0; c0 < NCHUNK; c0 += PF) {
            unsigned u[PF]; float a[PF];
#pragma unroll
            for (int i = 0; i < PF; ++i) { u[i] = __builtin_nontemporal_load((const unsigned*)(q8 + (size_t)(c0 + i) * 32768)); a[i] = ad[c0 + i]; }
#pragma unroll
            for (int i = 0; i < PF; ++i) { *(u32x2*)((dryST ? dryST + (p - A.ST) : p) + (size_t)(c0 + i) * 32768) = pk4(s); s = s * a[i] + unpk4_fp8(u[i]) * (1.f / U8_SCALE); }
        }
    }
    for (int it = gtid; it < NCHAIN * 128; it += nthreads) {
        const int chain = it >> 7, d = it & 127; float* __restrict__ p = A.NU + (size_t)chain * NCHUNK * 128 + d; const float* __restrict__ ad = A.ADEC + chain * NCHUNK; float s = 0.f;
        for (int c0 = 0; c0 < NCHUNK; c0 += PF) {
            float u[PF], a[PF];
#pragma unroll
            for (int i = 0; i < PF; ++i) { u[i] = p[(c0 + i) * 128]; a[i] = ad[c0 + i]; }
#pragma unroll
            for (int i = 0; i < PF; ++i) { (dryNU ? dryNU + (p - A.NU) : p)[(c0 + i) * 128] = s; s = s * a[i] + u[i]; }
        }
    }
}

constexpr int D3_G = 0, D3_Q = 4096, D3_QF = D3_Q + 64 * QP * 2, D3_QB = D3_QF + 64 * QP * 2, D3_KT = D3_QB + 64 * QP * 2, D3_VT = D3_KT + 64 * QP * 2, D3_PF = D3_VT + 256 * KP * 2, D3_PB = D3_PF + 64 * KP * 2, D3_END = D3_PB + 64 * KP * 2;
static_assert(D3_END + 1024 <= RING_BYTES, "mLSTM D3 LDS");
__device__ __forceinline__ void mlstm_d3_unit(const MlstmArgs& A, int bh, int jb, LAS unsigned char* lds) {
    const int tid = opaque_tid(), lane = tid & 63, wave = __builtin_amdgcn_readfirstlane(tid >> 6), fr = lane & 15, fq = lane >> 4;
    const int b = bh >> 2, h = bh & 3, row0 = b * TPB + jb * 64;
    const bool hasL = !(jb == 0 || jb == 256), hasR = !(jb == 255 || jb == 259);
    LAS float* GF = (LAS float*)(lds + D3_G);
    LAS float* BF = GF, *BB = GF + 64, *IFM = GF + 128, *IBM = GF + 192, *EBF = GF + 256, *EBB = GF + 320, *DEN = GF + 384, *RS = GF + 512;
    LAS float* NPV = (LAS float*)(lds + D3_END);
    LAS unsigned char* Qs = lds + D3_Q; LAS unsigned char* QF = lds + D3_QF; LAS unsigned char* QB = lds + D3_QB; LAS unsigned char* KT = lds + D3_KT;
    LAS unsigned char* VT = lds + D3_VT; LAS unsigned char* PF = lds + D3_PF; LAS unsigned char* PB = lds + D3_PB;
    const int cf = bh * 2, cb = bh * 2 + 1, pf = pos_f(jb), pb = pos_b(jb);
    const float Mf = __uint_as_float(__hip_atomic_load(A.mstab + bh * 2 + 0, RLX_AGENT)), Mb = __uint_as_float(__hip_atomic_load(A.mstab + bh * 2 + 1, RLX_AGENT));
    u32x4 xm_[4], x0_[4], xp_[4];
#pragma unroll
    for (int i = 0; i < 4; ++i) { const int p = tid + 512 * i, dc = p & 15, s = (p >> 4) & 63, isk = p >> 10; mlstm_load3(A.QKM, row0, s, isk * 512 + h * 128 + dc * 8, hasL, hasR, xm_[i], x0_[i], xp_[i]); }
    mlstm_stage_vt(A, h, row0, VT, tid);
    if (wave == 0) {
        float bfv, bbv, ifm, ibm, bend_f, bend_b; mlstm_gates(A, bh, row0, lane, bfv, bbv, ifm, ibm, bend_f, bend_b);
        BF[lane] = bfv; BB[lane] = bbv; IFM[lane] = ifm; IBM[lane] = ibm; EBF[lane] = __expf(bfv); EBB[lane] = __expf(bbv);
    } else if (tid >= 256) { const int dir = (tid >> 7) & 1, d = tid & 127; NPV[dir * 128 + d] = A.NU[((size_t)(dir ? cb : cf) * NCHUNK + (dir ? pb : pf)) * 128 + d]; }
    __syncthreads();
#pragma unroll
    for (int i = 0; i < 4; ++i) { const int p = tid + 512 * i, dc = p & 15, s = (p >> 4) & 63, isk = p >> 10; const int ch = isk * 512 + h * 128 + dc * 8;
        const u32x4 xm = xm_[i], x0 = x0_[i], xp = xp_[i];
        float v[8]; conv_silu8(xm, x0, xp, A.conv + ch, isk ? 0.08838834764831845f : 1.f, v);
        if (isk) { u32x4 w; w.x = pk2(v[0], v[1]); w.y = pk2(v[2], v[3]); w.z = pk2(v[4], v[5]); w.w = pk2(v[6], v[7]); *(LAS u32x4*)(KT + ((size_t)s * QP + dc * 8) * 2) = w; }
        else { const float ef = EBF[s], eb = EBB[s]; u32x4 w;
            w.x = pk2(v[0], v[1]); w.y = pk2(v[2], v[3]); w.z = pk2(v[4], v[5]); w.w = pk2(v[6], v[7]); *(LAS u32x4*)(Qs + ((size_t)s * QP + dc * 8) * 2) = w;
            w.x = pk2(v[0] * ef, v[1] * ef); w.y = pk2(v[2] * ef, v[3] * ef); w.z = pk2(v[4] * ef, v[5] * ef); w.w = pk2(v[6] * ef, v[7] * ef); *(LAS u32x4*)(QF + ((size_t)s * QP + dc * 8) * 2) = w;
            w.x = pk2(v[0] * eb, v[1] * eb); w.y = pk2(v[2] * eb, v[3] * eb); w.z = pk2(v[4] * eb, v[5] * eb); w.w = pk2(v[6] * eb, v[7] * eb); *(LAS u32x4*)(QB + ((size_t)s * QP + dc * 8) * 2) = w; } }
    __syncthreads();
    {
        const int mt = wave >> 1, nt0 = (wave & 1) * 2;
        f32x4 S0 = (f32x4){0.f, 0.f, 0.f, 0.f}, S1 = S0;
#pragma unroll
        for (int ks = 0; ks < 4; ++ks) { const bf16x8 a = lds_frag(Qs, mt * 16 + fr, QP, ks * 32 + fq * 8);
            S0 = __builtin_amdgcn_mfma_f32_16x16x32_bf16(a, lds_frag(KT, nt0 * 16 + fr, QP, ks * 32 + fq * 8), S0, 0, 0, 0);
            S1 = __builtin_amdgcn_mfma_f32_16x16x32_bf16(a, lds_frag(KT, (nt0 + 1) * 16 + fr, QP, ks * 32 + fq * 8), S1, 0, 0, 0); }
#pragma unroll
        for (int n = 0; n < 2; ++n) { const int s = (nt0 + n) * 16 + fr; const float bfs = BF[s], bbs = BB[s], ifs = IFM[s], ibs = IBM[s];
#pragma unroll
            for (int r = 0; r < 4; ++r) { const int t = mt * 16 + fq * 4 + r; const float sv = n ? S1[r] : S0[r];
                const float pf_ = (s <= t) ? sv * __expf(BF[t] - bfs + ifs) : 0.f, pb_ = (s >= t) ? sv * __expf(BB[t] - bbs + ibs) : 0.f;
                *(LAS bf16_t*)(PF + ((size_t)t * KP + s) * 2) = (bf16_t)f2bf(pf_); *(LAS bf16_t*)(PB + ((size_t)t * KP + s) * 2) = (bf16_t)f2bf(pb_); } }
    }
    __syncthreads();
    {
        const int t = tid >> 3, part = tid & 7;
        const u32x4 pfv = *(const LAS u32x4*)(PF + ((size_t)t * KP + part * 8) * 2), pbv = *(const LAS u32x4*)(PB + ((size_t)t * KP + part * 8) * 2);
        const u32x4 q0v = *(const LAS u32x4*)(Qs + ((size_t)t * QP + part * 16) * 2), q1v = *(const LAS u32x4*)(Qs + ((size_t)t * QP + part * 16 + 8) * 2);
        const unsigned pw[4] = {pfv.x, pfv.y, pfv.z, pfv.w}, pwb[4] = {pbv.x, pbv.y, pbv.z, pbv.w}, qw[8] = {q0v.x, q0v.y, q0v.z, q0v.w, q1v.x, q1v.y, q1v.z, q1v.w};
        float sf = 0.f, sb = 0.f, dqf = 0.f, dqb = 0.f;
#pragma unroll
        for (int i = 0; i < 4; ++i) { sf += bf2f(pw[i] & 0xffffu) + bf2f(pw[i] >> 16); sb += bf2f(pwb[i] & 0xffffu) + bf2f(pwb[i] >> 16); }
#pragma unroll
        for (int i = 0; i < 8; ++i) { const float qa = bf2f(qw[i] & 0xffffu), qb2 = bf2f(qw[i] >> 16); const int d = part * 16 + 2 * i;
            dqf += qa * NPV[d] + qb2 * NPV[d + 1]; dqb += qa * NPV[128 + d] + qb2 * NPV[128 + d + 1]; }
#pragma unroll
        for (int o = 1; o < 8; o <<= 1) { sf += __shfl_xor(sf, o); sb += __shfl_xor(sb, o); dqf += __shfl_xor(dqf, o); dqb += __shfl_xor(dqb, o); }
        if (part == 0) { DEN[t] = fmaxf(fabsf(sf + EBF[t] * dqf), __expf(-Mf)); DEN[64 + t] = fmaxf(fabsf(sb + EBB[t] * dqb), __expf(-Mb)); }
    }
    f32x4 acc[2][2][4];
#pragma unroll
    for (int dir = 0; dir < 2; ++dir) {
        const LAS unsigned char* P = dir ? PB : PF; const LAS unsigned char* QD = dir ? QB : QF;
        const bf16_t* CT = A.ST + ((size_t)(dir ? cb : cf) * NCHUNK + (dir ? pb : pf)) * 32768;
#pragma unroll
        for (int m = 0; m < 2; ++m)
#pragma unroll
            for (int n = 0; n < 4; ++n) acc[dir][m][n] = (f32x4){0.f, 0.f, 0.f, 0.f};
#pragma unroll
        for (int ks = 0; ks < 2; ++ks) {
            const bf16x8 a0 = lds_frag(VT, (2 * wave) * 16 + fr, KP, ks * 32 + fq * 8), a1 = lds_frag(VT, (2 * wave + 1) * 16 + fr, KP, ks * 32 + fq * 8);
#pragma unroll
            for (int n = 0; n < 4; ++n) { const bf16x8 bq = lds_frag(P, n * 16 + fr, KP, ks * 32 + fq * 8);
                acc[dir][0][n] = __builtin_amdgcn_mfma_f32_16x16x32_bf16(a0, bq, acc[dir][0][n], 0, 0, 0); acc[dir][1][n] = __builtin_amdgcn_mfma_f32_16x16x32_bf16(a1, bq, acc[dir][1][n], 0, 0, 0); } }
#pragma unroll
        for (int ks = 0; ks < 4; ++ks) {
            const bf16x8 a0 = *(const bf16x8*)(CT + (size_t)((2 * wave) * 16 + fr) * 128 + ks * 32 + fq * 8), a1 = *(const bf16x8*)(CT + (size_t)((2 * wave + 1) * 16 + fr) * 128 + ks * 32 + fq * 8);
#pragma unroll
            for (int n = 0; n < 4; ++n) { const bf16x8 bq = lds_frag(QD, n * 16 + fr, QP, ks * 32 + fq * 8);
                acc[dir][0][n] = __builtin_amdgcn_mfma_f32_16x16x32_bf16(a0, bq, acc[dir][0][n], 0, 0, 0); acc[dir][1][n] = __builtin_amdgcn_mfma_f32_16x16x32_bf16(a1, bq, acc[dir][1][n], 0, 0, 0); } }
    }
    __syncthreads();
    f32x4 gq[2]; u32x2 ogq[4][2];
#pragma unroll
    for (int m = 0; m < 2; ++m) gq[m] = *(const f32x4*)(A.norm_m + h * 256 + (2 * wave + m) * 16 + fq * 4);
#pragma unroll
    for (int n = 0; n < 4; ++n)
#pragma unroll
        for (int m = 0; m < 2; ++m) ogq[n][m] = *(const u32x2*)(A.OMS + (size_t)(row0 + n * 16 + fr) * 1024 + h * 256 + (2 * wave + m) * 16 + fq * 4);
    f32x4 hv[2][4];
#pragma unroll
    for (int n = 0; n < 4; ++n) { const int t = n * 16 + fr; const float rf = 1.f / DEN[t], rb = 1.f / DEN[64 + t]; float ss = 0.f;
#pragma unroll
        for (int m = 0; m < 2; ++m) { hv[m][n] = acc[0][m][n] * rf + acc[1][m][n] * rb; ss += hv[m][n].x * hv[m][n].x + hv[m][n].y * hv[m][n].y + hv[m][n].z * hv[m][n].z + hv[m][n].w * hv[m][n].w; }
        ss += __shfl_xor(ss, 16); ss += __shfl_xor(ss, 32);
        if (fq == 0) RS[wave * 64 + t] = ss; }
    __syncthreads();
#pragma unroll
    for (int n = 0; n < 4; ++n) { const int t = n * 16 + fr; float ss = 0.f;
#pragma unroll
        for (int w = 0; w < 8; ++w) ss += RS[w * 64 + t];
        const float rstd = 1.f / sqrtf(ss * (1.f / 256.f) + RMS_EPS);
#pragma unroll
        for (int m = 0; m < 2; ++m) { const int e0 = (2 * wave + m) * 16 + fq * 4; const size_t o = (size_t)(row0 + t) * 1024 + h * 256 + e0;
            *(u32x2*)(A.HM + o) = pk4(hv[m][n] * rstd * gq[m] * unpk4(ogq[n][m])); } }
    __syncthreads();
}

__device__ __forceinline__ void tr_load(const float* W, size_t ldw, int k0, int n0, int nvalid, LAS float* scr, int lane) {
#pragma unroll 8
    for (int i = 0; i < 32; ++i) { const int kk = 2 * i + (lane >> 5), n = lane & 31; scr[kk * 33 + n] = (n < nvalid) ? W[(size_t)(k0 + kk) * ldw + n0 + n] : 0.f; }
    LDS_WAIT(); asm volatile("" ::: "memory");
}
__device__ __forceinline__ int perm32(int n) { return (n & ~31) | (((n >> 2) & 1) << 4) | (((n >> 3) & 3) << 2) | (n & 3); }
template <int MODE  >
__device__ __forceinline__ void tr_store(bf16_t* WT, size_t ldt, int drow0, int dcol0, int nvalid, const LAS float* scr, int lane, bool perm = false) {
    const int c = lane & 7;
#pragma unroll
    for (int j = 0; j < 4; ++j) { const int n = (lane >> 3) + 8 * j; const LAS float* s = scr + (8 * c) * 33 + n; float v[8];
#pragma unroll
        for (int e = 0; e < 8; ++e) { v[e] = s[e * 33]; if (MODE == 1) v[e] = v[e] - bf2f(f2bf(v[e])); }
        u32x4 o; o.x = pk2(v[0], v[1]); o.y = pk2(v[2], v[3]); o.z = pk2(v[4], v[5]); o.w = pk2(v[6], v[7]);
        if (n < nvalid) *(u32x4*)(WT + (size_t)(drow0 + (perm ? perm32(n) : n)) * ldt + dcol0 + 8 * c) = o; }
}

__device__ __forceinline__ void tr_load64(const float* W, size_t ldw, int k0, int n0, LAS float* scr, int lane) {
    float v[64];
    const float* p = W + (size_t)k0 * ldw + n0 + lane;
#pragma unroll
    for (int i = 0; i < 64; ++i) v[i] = __builtin_nontemporal_load(p + (size_t)i * ldw);
#pragma unroll
    for (int i = 0; i < 64; ++i) scr[i * 65 + lane] = v[i];
    LDS_WAIT(); asm volatile("" ::: "memory");
}
template <bool PERM = false>
__device__ __forceinline__ void tr_store64(bf16_t* WT, size_t ldt, int drow0, int dcol0, const LAS float* scr, int lane) {
    const int c = lane & 7;
#pragma unroll
    for (int j = 0; j < 8; ++j) { const int nl = (lane >> 3) + 8 * j; const LAS float* s = scr + (8 * c) * 65 + nl; const int n = PERM ? perm32(nl) : nl;
        u32x4 o; o.x = pk2(s[0], s[65]); o.y = pk2(s[2 * 65], s[3 * 65]); o.z = pk2(s[4 * 65], s[5 * 65]); o.w = pk2(s[6 * 65], s[7 * 65]);
        *(u32x4*)(WT + (size_t)(drow0 + n) * ldt + dcol0 + 8 * c) = o; }
    LDS_WAIT(); asm volatile("" ::: "memory");
}
struct KArgs { const float* in[25]; float* out; unsigned char* ws; int dbg; int pad; };

__device__ __forceinline__ void ln_row(f32x4 (&v)[4], const float* g, const float* bta, int lane) {
    float s = 0.f;
#pragma unroll
    for (int j = 0; j < 4; ++j) s += (v[j].x + v[j].y) + (v[j].z + v[j].w);
    const float mean = wave_sum(s) * (1.f / 1024.f); float s2 = 0.f;
#pragma unroll
    for (int j = 0; j < 4; ++j) { v[j] = v[j] - mean; s2 += (v[j].x * v[j].x + v[j].y * v[j].y) + (v[j].z * v[j].z + v[j].w * v[j].w); }
    const float rstd = 1.f / sqrtf(wave_sum(s2) * (1.f / 1024.f) + LN_EPS);
#pragma unroll
    for (int j = 0; j < 4; ++j) { const f32x4 gg = *(const f32x4*)(g + 4 * lane + 256 * j), bb = *(const f32x4*)(bta + 4 * lane + 256 * j); v[j] = v[j] * rstd * gg + bb; }
}

#define C8(j) (8 * lane + 512 * ((j) >> 1) + 4 * ((j) & 1))
__device__ __forceinline__ void ln_row8(f32x4 (&v)[4], const float* g, const float* bta, int lane) {
    float s = 0.f;
#pragma unroll
    for (int j = 0; j < 4; ++j) s += (v[j].x + v[j].y) + (v[j].z + v[j].w);
    const float mean = wave_sum(s) * (1.f / 1024.f); float s2 = 0.f;
#pragma unroll
    for (int j = 0; j < 4; ++j) { v[j] = v[j] - mean; s2 += (v[j].x * v[j].x + v[j].y * v[j].y) + (v[j].z * v[j].z + v[j].w * v[j].w); }
    const float rstd = 1.f / sqrtf(wave_sum(s2) * (1.f / 1024.f) + LN_EPS);
#pragma unroll
    for (int j = 0; j < 4; ++j) { const f32x4 gg = *(const f32x4*)(g + C8(j)), bb = *(const f32x4*)(bta + C8(j)); v[j] = v[j] * rstd * gg + bb; }
}

#define AS4 __attribute__((address_space(4)))
__device__ __forceinline__ const char AS4* kargp() { const char AS4* p = (const char AS4*)__builtin_amdgcn_kernarg_segment_ptr(); asm volatile("" : "+s"(p)); return p; }
#define INP(k) (*(const float* const AS4*)(kargp() + 8 * (k)))
#define OUTP() (*(float* const AS4*)(kargp() + 200))
#define WSB() (*(unsigned char* const AS4*)(kargp() + 208))
enum { I_X = 0, I_C, I_CTX, I_CCTX, I_ADAW, I_ADAB, I_WIN, I_BG, I_CONV, I_LAM, I_SUBLN, I_NORMM, I_WBRA, I_WBRM, I_WOUT, I_LN1G, I_LN1B, I_LN2G, I_LN2B, I_WR, I_EB, I_WEIN, I_WEOUT, I_WSIN, I_WSOUT };

__global__ void __launch_bounds__(NTHR, 2) mega_fwd(KArgs args) {
    extern __shared__ __attribute__((aligned(16))) unsigned char lds_raw[];
    LAS unsigned char* lds = (LAS unsigned char*)lds_raw;
    for (int u = threadIdx.x; u < (LDS_BYTES - MISC_OFF) / 4; u += NTHR) ((LAS unsigned*)(lds + MISC_OFF))[u] = 0u;
    __syncthreads();
    (void)xcd_barrier_post((unsigned*)(WSB() + WS_CTL) + CW_BAR, (volatile LAS unsigned*)(lds + MISC_OFF) + 8);
#define GRID_BAR() do { for (int xb_ = 0; xb_ < 1 + XBAR; ++xb_) { XcdBarrier b_; b_.bar = (unsigned*)(WSB() + WS_CTL) + CW_BAR; b_.x = xb_xcc_id(); b_.st = (volatile LAS unsigned*)(lds + MISC_OFF) + 8; if (xb_ == 0) xcd_barrier<true, false>(b_); else xcd_barrier<false, true>(b_); } } while (0)
#define PHASE_LOCALS() const int tid = opaque_tid(), lane = tid & 63, wave = __builtin_amdgcn_readfirstlane(tid >> 6); int G = (int)gridDim.x; asm volatile("" : "+s"(G)); \
    const int bx = (int)blockIdx.x, vcu = (G % 8 == 0) ? (bx % 8) * (G / 8) + bx / 8 : bx, gw = vcu * NWAVES + wave, NGW = G * NWAVES; (void)tid; (void)lane; (void)wave; (void)gw; (void)NGW; (void)vcu

#if PROBE
#define STAMP(cat) do { if (blockIdx.x == 0 && threadIdx.x == 0) { LAS unsigned long long* ts_ = (LAS unsigned long long*)(lds + MISC_OFF + 64); const unsigned long long t_ = __builtin_amdgcn_s_memrealtime(); ts_[1 + (cat)] += t_ - ts_[0]; ts_[0] = t_; } } while (0)
    if (blockIdx.x == 0 && threadIdx.x == 0) ((LAS unsigned long long*)(lds + MISC_OFF + 64))[0] = __builtin_amdgcn_s_memrealtime();
#else
#define STAMP(cat) do { } while (0)
#endif
    for (int rep_ = 0; rep_ < NREP(1); ++rep_) {
        PHASE_LOCALS(); unsigned char* ws = WSB();
        LAS float* scr = (LAS float*)(lds + wave * 16640);
        constexpr int IT_IN = 257 * 16;
        constexpr int IT_SQ = 32 * 16;
        constexpr int IT_RT = 8 * 16;
        constexpr int IT_E1 = 8 * 16, IT_E2 = 16 * 4;
        constexpr int IT_LAYER = IT_IN + 3 * IT_SQ + IT_RT + 257 * IT_E1 + 257 * IT_E2;
        for (int it = gw; it < 2 * IT_LAYER; it += NGW) {
            const int l = it / IT_LAYER; int r = it % IT_LAYER; unsigned char* WL = ws + WS_W0 + (size_t)l * WL_SIZE;
            if (r < IT_IN) { const int nb = r / 16, kb = r % 16; int n0, drow, nv = 32;
                if (nb < 192) { n0 = nb * 32; drow = n0; } else if (nb == 192) { n0 = 6144; drow = 8192; nv = 16; } else { n0 = 6160 + (nb - 193) * 32; drow = 6144 + (nb - 193) * 32; }
                tr_load(INP(I_WIN) + (size_t)l * 1024 * INW, INW, kb * 64, n0, nv, scr, lane); tr_store<0>((bf16_t*)(WL + WL_IN), 1024, drow, kb * 64, nv, scr, lane, drow >= 2048 && drow < 8192); continue; }
            r -= IT_IN;
            if (r < 3 * IT_SQ) { const int w = r / IT_SQ, q = r % IT_SQ, nb = q / 16, kb = q % 16; const float* src = (w == 0 ? INP(I_WBRA) : w == 1 ? INP(I_WBRM) : INP(I_WOUT)) + (size_t)l * 1024 * 1024;
                tr_load(src, 1024, kb * 64, nb * 32, 32, scr, lane); tr_store<0>((bf16_t*)(WL + (w == 0 ? WL_BRA : w == 1 ? WL_BRM : WL_OUT)), 1024, nb * 32, kb * 64, 32, scr, lane, true); continue; }
            r -= 3 * IT_SQ;
            if (r < IT_RT) { const int nb = r / 16, kb = r % 16; tr_load(INP(I_WR) + (size_t)l * 1024 * 256, 256, kb * 64, nb * 32, 32, scr, lane);
                bf16_t* dst = (bf16_t*)(WL + WL_R3); tr_store<0>(dst, 3072, nb * 32, kb * 64, 32, scr, lane); tr_store<0>(dst, 3072, nb * 32, 1024 + kb * 64, 32, scr, lane); tr_store<1>(dst, 3072, nb * 32, 2048 + kb * 64, 32, scr, lane); continue; }
            r -= IT_RT;
            if (r < 257 * IT_E1) { const int e = r / IT_E1, q = r % IT_E1, kb = q / 8, nb = q % 8, n0 = nb * 64;
                const float* src = e < 256 ? INP(I_WEIN) + ((size_t)l * 256 + e) * 1024 * 512 : INP(I_WSIN) + (size_t)l * 1024 * 512;
                const int isg = n0 >= 256, j0 = n0 & 255, drow = (j0 >> 7) * 256 + isg * 128 + (j0 & 127);
                tr_load64(src, 512, kb * 64, n0, scr, lane); tr_store64<true>((bf16_t*)(WL + WL_E1) + (size_t)e * 512 * 1024, 1024, drow, kb * 64, scr, lane); continue; }
            r -= 257 * IT_E1;
            { const int e = r / IT_E2, q = r % IT_E2, kb = q / 16, nb = q % 16;
                const float* src = e < 256 ? INP(I_WEOUT) + ((size_t)l * 256 + e) * 256 * 1024 : INP(I_WSOUT) + (size_t)l * 256 * 1024;
                tr_load64(src, 1024, kb * 64, nb * 64, scr, lane); tr_store64<true>((bf16_t*)(WL + WL_E2) + (size_t)e * 1024 * 256, 256, nb * 64, kb * 64, scr, lane); }
        }
        { const float* in_c = INP(I_C); const float* in_cctx = INP(I_CCTX); const float* ada_w = INP(I_ADAW); const float* ada_b = INP(I_ADAB); float* MODV = (float*)(ws + WS_MODV);
        for (int it = bx * NTHR + tid; it < 2 * 6144; it += G * NTHR) { const int l = it / 6144, j = it % 6144; const float* wcol = ada_w + (size_t)l * 1024 * 6144 + j; float a0 = 0.f, a1 = 0.f, a2 = 0.f;
#pragma unroll 4
            for (int k = 0; k < 1024; ++k) { const float w = wcol[(size_t)k * 6144]; a0 += siluf_(in_c[k]) * w; a1 += siluf_(in_c[1024 + k]) * w; a2 += siluf_(in_cctx[k]) * w; }
            const float bb = ada_b[l * 6144 + j]; MODV[(l * 3 + 0) * 6144 + j] = a0 + bb; MODV[(l * 3 + 1) * 6144 + j] = a1 + bb; MODV[(l * 3 + 2) * 6144 + j] = a2 + bb; } }
        { f32x2* ROPE = (f32x2*)(ws + WS_ROPE);
        for (int it = bx * NTHR + tid; it < 256 * 16; it += G * NTHR) { const int pos = it >> 4, i = it & 15; const float inv = powf(10000.f, -(float)i / 16.f); const float ang = (float)pos * inv; float s, c; sincosf(ang, &s, &c); ROPE[it] = (f32x2){c, s}; } }
    }
    GRID_BAR(); STAMP(0);

    for (int l = 0; l < 2; ++l) {
        if (l == 0) for (int rep_ = 0; rep_ < NREP(2); ++rep_) {
            PHASE_LOCALS(); unsigned char* ws = WSB(); const float* modv = (const float*)(ws + WS_MODV); bf16_t* HMOD = (bf16_t*)(ws + WS_HMOD);
            XSrc xs{INP(I_X), INP(I_CTX), (const float*)(ws + WS_XCUR), 0};
            for (int r = gw; r < MALL; r += NGW) { const int b = r / TPB, set = (r % TPB) < SEQ ? b : 2; const float* xr = xs.row(r); const float* mv = modv + set * 6144;
#pragma unroll
                for (int j = 0; j < 4; ++j) { const int c = 4 * lane + 256 * j; const f32x4 v = *(const f32x4*)(xr + c), sh = *(const f32x4*)(mv + c), sc = *(const f32x4*)(mv + 1024 + c);
                    *(u32x2*)(HMOD + (size_t)r * 1024 + c) = pk4(v * (sc + 1.f) + sh); } }
            GRID_BAR(); STAMP(0);
        }
        for (int rep_ = 0; rep_ < NREP(4); ++rep_) {
            PHASE_LOCALS(); unsigned char* ws = WSB(); unsigned char* WL = ws + WS_W0 + (size_t)l * WL_SIZE;
            pg8::DenseOrder S; S.init(NRT, INW_PAD / 256, G, bx, WL + WL_IN, 1024);
            EpiInProj E{(bf16_t*)(ws + WS_Q), (bf16_t*)(ws + WS_K), (bf16_t*)(ws + WS_V), (bf16_t*)(ws + WS_QKM), (bf16_t*)(ws + WS_VM), (bf16_t*)(ws + WS_OMS), (bf16_t*)(ws + WS_GA), (bf16_t*)(ws + WS_GB),
                        (float*)(ws + WS_GATES), INP(I_BG) + l * 16, (const f32x2*)(ws + WS_ROPE), (unsigned*)(ws + WS_CTL) + CW_MSTAB + l * 16};
            pg8::gemm_phase(lds, (const bf16_t*)(ws + WS_HMOD), 1024, 1024, S, E);
        }
        GRID_BAR(); STAMP(1);
        for (int rep_ = 0; rep_ < NREP(8); ++rep_) {
            PHASE_LOCALS(); unsigned char* ws = WSB();
            MlstmArgs MA{(const bf16_t*)(ws + WS_QKM), (const bf16_t*)(ws + WS_VM), (const bf16_t*)(ws + WS_OMS), (const float*)(ws + WS_GATES), INP(I_CONV) + (size_t)l * 3 * 1024, INP(I_NORMM) + l * 1024,
                         (const unsigned*)(ws + WS_CTL) + CW_MSTAB + l * 16, (bf16_t*)(ws + WS_ST), (float*)(ws + WS_NU), (float*)(ws + WS_ADEC), (bf16_t*)(ws + WS_HM), ws + WS_X1};
            for (int u = bx; u < 8 * NCHUNK; u += G) mlstm_d1_unit(MA, u / NCHUNK, u % NCHUNK, lds);
        }
        GRID_BAR(); STAMP(2);
        for (int rep_ = 0; rep_ < NREP(16); ++rep_) {
            PHASE_LOCALS(); unsigned char* ws = WSB();
            MlstmArgs MA{nullptr, nullptr, nullptr, nullptr, nullptr, nullptr, nullptr, (bf16_t*)(ws + WS_ST), (float*)(ws + WS_NU), (float*)(ws + WS_ADEC), nullptr, ws + WS_X1};
            mlstm_scan(MA, bx * NTHR + tid, G * NTHR);
            if (XSCAN) { GRID_BAR(); mlstm_scan(MA, bx * NTHR + tid, G * NTHR, (bf16_t*)(ws + WS_YB), (float*)(ws + WS_HE)); }
        }
        GRID_BAR(); STAMP(3);
        for (int rep_ = 0; rep_ < NREP(32); ++rep_) {
            PHASE_LOCALS(); unsigned char* ws = WSB(); const bf16_t* Qb_ = (const bf16_t*)(ws + WS_Q); const bf16_t* Kb_ = (const bf16_t*)(ws + WS_K); const bf16_t* Vb_ = (const bf16_t*)(ws + WS_V); bf16_t* OJ = (bf16_t*)(ws + WS_OJ);
            const int nun = (G == 256) ? 8 : (2048 + G - 1) / G;
            for (int r = 0; r < nun; ++r) {
                int grp, qb;
                if (G == 256) { const int xg = vcu >> 5, ii = vcu & 31; grp = xg + 8 * (r >> 1); qb = ii + 32 * (r & 1); }
                else { const int u = bx + r * G; if (u >= 2048) break; grp = u >> 6; qb = u & 63; }
                const int b = grp >> 4, h = (grp >> 1) & 7, j = grp & 1; const size_t q0 = (size_t)b * TPB + qb * 256, k0 = (size_t)b * TPB;
                att::attn_body(Qb_ + q0 * 1024 + h * 128 + j * 64, Kb_ + k0 * 1024 + h * 128 + j * 64, Vb_ + k0 * 1024 + h * 128, OJ + q0 * 2048 + h * 256 + j * 128, TPB, (char*)lds_raw);
            }
            if (l == 0) for (int u = bx; u < 32; u += G) { const int b = u >> 4, h = (u >> 1) & 7, j = u & 1; const size_t q0 = (size_t)b * TPB + SEQ;
                att::attn_body(Qb_ + q0 * 1024 + h * 128 + j * 64, Kb_ + q0 * 1024 + h * 128 + j * 64, Vb_ + q0 * 1024 + h * 128, OJ + q0 * 2048 + h * 256 + j * 128, CTX, (char*)lds_raw); }
        }
        STAMP(4);
        for (int rep_ = 0; rep_ < NREP(64); ++rep_) {
            PHASE_LOCALS(); unsigned char* ws = WSB();
            MlstmArgs MA{(const bf16_t*)(ws + WS_QKM), (const bf16_t*)(ws + WS_VM), (const bf16_t*)(ws + WS_OMS), (const float*)(ws + WS_GATES), INP(I_CONV) + (size_t)l * 3 * 1024, INP(I_NORMM) + l * 1024,
                         (const unsigned*)(ws + WS_CTL) + CW_MSTAB + l * 16, (bf16_t*)(ws + WS_ST), (float*)(ws + WS_NU), (float*)(ws + WS_ADEC), (bf16_t*)(ws + WS_HM)};
            for (int u = bx; u < 8 * NCHUNK; u += G) mlstm_d3_unit(MA, u / NCHUNK, u % NCHUNK, lds);
        }
        GRID_BAR(); STAMP(5);
        for (int rep_ = 0; rep_ < NREP(128); ++rep_) {
            PHASE_LOCALS(); unsigned char* ws = WSB(); const bf16_t* OJ = (const bf16_t*)(ws + WS_OJ); bf16_t* OA = (bf16_t*)(ws + WS_OA);
            const float lam_init = l == 0 ? 0.2f : (0.8f - 0.6f * 0.7408182206817179f);
            const float* lm = INP(I_LAM) + l * 256;
            const float lv = __expf(wave_sum(lm[lane] * lm[64 + lane])) - __expf(wave_sum(lm[128 + lane] * lm[192 + lane])) + lam_init;
            const int hh = lane >> 3, e0 = (lane & 7) * 16; f32x4 sgv[4];
#pragma unroll
            for (int q = 0; q < 4; ++q) sgv[q] = *(const f32x4*)(INP(I_SUBLN) + l * 128 + e0 + 4 * q);
            for (int r0 = gw; r0 < MALL; r0 += 2 * NGW) { const int r1 = r0 + NGW; const bool has1 = r1 < MALL; const int rr[2] = {r0, has1 ? r1 : r0};
                u32x4 ra[2][2], rb[2][2];
#pragma unroll
                for (int x = 0; x < 2; ++x) { const bf16_t* p = OJ + (size_t)rr[x] * 2048 + hh * 256 + e0; ra[x][0] = *(const u32x4*)p; ra[x][1] = *(const u32x4*)(p + 8); rb[x][0] = *(const u32x4*)(p + 128); rb[x][1] = *(const u32x4*)(p + 136); }
#pragma unroll
                for (int x = 0; x < 2; ++x) { if (x == 1 && !has1) break;
                    float d[16]; float ss = 0.f;
#pragma unroll
                    for (int q = 0; q < 2; ++q) { const unsigned a4[4] = {ra[x][q].x, ra[x][q].y, ra[x][q].z, ra[x][q].w}, b4[4] = {rb[x][q].x, rb[x][q].y, rb[x][q].z, rb[x][q].w};
#pragma unroll
                        for (int e = 0; e < 4; ++e) { const float lo = bf2f(a4[e] & 0xffffu) - lv * bf2f(b4[e] & 0xffffu), hi_ = bf2f(a4[e] >> 16) - lv * bf2f(b4[e] >> 16); d[q * 8 + 2 * e] = lo; d[q * 8 + 2 * e + 1] = hi_; ss += lo * lo + hi_ * hi_; } }
                    ss += __shfl_xor(ss, 1); ss += __shfl_xor(ss, 2); ss += __shfl_xor(ss, 4);
                    const float rstd = __builtin_amdgcn_rsqf(ss * (1.f / 128.f) + RMS_EPS) * (1.f - lam_init);
                    u32x4 o0, o1;
                    o0.x = pk2(d[0] * rstd * sgv[0].x, d[1] * rstd * sgv[0].y); o0.y = pk2(d[2] * rstd * sgv[0].z, d[3] * rstd * sgv[0].w); o0.z = pk2(d[4] * rstd * sgv[1].x, d[5] * rstd * sgv[1].y); o0.w = pk2(d[6] * rstd * sgv[1].z, d[7] * rstd * sgv[1].w);
                    o1.x = pk2(d[8] * rstd * sgv[2].x, d[9] * rstd * sgv[2].y); o1.y = pk2(d[10] * rstd * sgv[2].z, d[11] * rstd * sgv[2].w); o1.z = pk2(d[12] * rstd * sgv[3].x, d[13] * rstd * sgv[3].y); o1.w = pk2(d[14] * rstd * sgv[3].z, d[15] * rstd * sgv[3].w);
                    bf16_t* po = OA + (size_t)rr[x] * 1024 + hh * 128 + e0; *(u32x4*)po = o0; *(u32x4*)(po + 8) = o1; } }
        }
        GRID_BAR(); STAMP(6);
        for (int rep_ = 0; rep_ < NREP(256); ++rep_) { PHASE_LOCALS(); unsigned char* ws = WSB(); unsigned char* WL = ws + WS_W0 + (size_t)l * WL_SIZE;
            pg8::DenseOrder S; S.init(l ? NRT - 2 : NRT, 4, G, bx, WL + WL_BRA, 1024, l); EpiGate1 E{(const bf16_t*)(ws + WS_GA), (bf16_t*)(ws + WS_T1)}; pg8::gemm_phase(lds, (const bf16_t*)(ws + WS_OA), 1024, 1024, S, E); }
        GRID_BAR(); STAMP(7);
        for (int rep_ = 0; rep_ < NREP(512); ++rep_) { PHASE_LOCALS(); unsigned char* ws = WSB(); unsigned char* WL = ws + WS_W0 + (size_t)l * WL_SIZE;
            pg8::DenseOrder S; S.init(l ? NRT - 2 : NRT, 4, G, bx, WL + WL_BRM, 1024, l); EpiGate2 E{(const bf16_t*)(ws + WS_GB), (const bf16_t*)(ws + WS_T1), (bf16_t*)(ws + WS_Y)}; pg8::gemm_phase(lds, (const bf16_t*)(ws + WS_HM), 1024, 1024, S, E); }
        GRID_BAR(); STAMP(7);
        for (int rep_ = 0; rep_ < NREP(1024); ++rep_) { PHASE_LOCALS(); unsigned char* ws = WSB(); unsigned char* WL = ws + WS_W0 + (size_t)l * WL_SIZE;
            XSrc xs{INP(I_X), INP(I_CTX), (const float*)(ws + WS_XCUR), l};
            pg8::DenseOrder S; S.init(l ? NRT - 2 : NRT, 4, G, bx, WL + WL_OUT, 1024, l); EpiOut E{xs, (const float*)(ws + WS_MODV) + l * 3 * 6144, (float*)(ws + WS_R)}; pg8::gemm_phase(lds, (const bf16_t*)(ws + WS_Y), 1024, 1024, S, E); }
        GRID_BAR(); STAMP(7);
        for (int rep_ = 0; rep_ < NREP(2048); ++rep_) {
            PHASE_LOCALS(); unsigned char* ws = WSB(); const float* modv = (const float*)(ws + WS_MODV) + l * 3 * 6144; const float* Rf = (const float*)(ws + WS_R); float* X1 = (float*)(ws + WS_X1); bf16_t* H2A = (bf16_t*)(ws + WS_H2A);
            const float* g1 = INP(I_LN1G) + l * 1024; const float* b1 = INP(I_LN1B) + l * 1024;
            for (int r0 = gw; r0 < MALL; r0 += 2 * NGW) { const int r1 = r0 + NGW; const bool has1 = r1 < MALL; const int rr[2] = {r0, has1 ? r1 : r0}; f32x4 vv[2][4];
#pragma unroll
                for (int x = 0; x < 2; ++x)
#pragma unroll
                    for (int j = 0; j < 4; ++j) vv[x][j] = unpk4(*(const u32x2*)((const bf16_t*)Rf + (size_t)rr[x] * 1024 + 4 * lane + 256 * j));
#pragma unroll
                for (int x = 0; x < 2; ++x) { if (x == 1 && !has1) break;
                    const int r = rr[x]; const int b = r / TPB, set = (r % TPB) < SEQ ? b : 2; const float* mv = modv + set * 6144;
                    ln_row(vv[x], g1, b1, lane);
#pragma unroll
                    for (int j = 0; j < 4; ++j) { const int c = 4 * lane + 256 * j;
                        const f32x4 sh = *(const f32x4*)(mv + 3 * 1024 + c), sc = *(const f32x4*)(mv + 4 * 1024 + c); const f32x4 hh = vv[x][j] * (sc + 1.f) + sh;
                        *(u32x2*)(H2A + (size_t)r * 1024 + c) = pk4(hh); } } }
        }
        GRID_BAR(); STAMP(8);
        for (int rep_ = 0; rep_ < NREP(4096); ++rep_) { PHASE_LOCALS(); unsigned char* ws = WSB(); unsigned char* WL = ws + WS_W0 + (size_t)l * WL_SIZE;
            pg8::DenseOrder S; S.init(NRT, 1, G, bx, WL + WL_R3, 3072); EpiLogits E{(float*)(ws + WS_LOG)}; pg8::gemm_phase(lds, (const bf16_t*)(ws + WS_H2A), 1024, ROUTER_K, S, E, 3072); }
        GRID_BAR(); STAMP(9);
        for (int rep_ = 0; rep_ < NREP(8192); ++rep_) {
            PHASE_LOCALS(); unsigned char* ws = WSB(); const float* LOGITS = (const float*)(ws + WS_LOG); const float* e_bias = INP(I_EB) + l * 256; unsigned* ecnt = (unsigned*)(ws + WS_CTL) + CW_CNT + l * 256;
            for (int xt_ = 0; xt_ < 1 + XTOPK; ++xt_) {
            if (xt_) ecnt += 2048;
            int* TOPI = (int*)(ws + (xt_ ? WS_YB : WS_TOPI)); float* TOPW = (float*)(ws + (xt_ ? WS_YB + 2 * MiB : WS_TOPW)); int* POS = (int*)(ws + (xt_ ? WS_YB + 4 * MiB : WS_POS));
            for (int r4 = gw * 4; r4 < MALL; r4 += NGW * 4) {
                const int r = r4 + (lane >> 4), sub = lane & 15; float sc[16], bs[16];
#pragma unroll
                for (int q = 0; q < 4; ++q) { const f32x4 lg = *(const f32x4*)(LOGITS + (size_t)r * 256 + sub * 16 + 4 * q), eb = *(const f32x4*)(e_bias + sub * 16 + 4 * q);
                    sc[4 * q] = sigmoidf_(lg.x); sc[4 * q + 1] = sigmoidf_(lg.y); sc[4 * q + 2] = sigmoidf_(lg.z); sc[4 * q + 3] = sigmoidf_(lg.w);
                    bs[4 * q] = sc[4 * q] + eb.x; bs[4 * q + 1] = sc[4 * q + 1] + eb.y; bs[4 * q + 2] = sc[4 * q + 2] + eb.z; bs[4 * q + 3] = sc[4 * q + 3] + eb.w; }
                int myi = 0; float myw = 0.f, wsum = 0.f;
#pragma unroll
                for (int k = 0; k < 8; ++k) {
                    float bv = bs[0], bsc = sc[0]; int bi = 0;
#pragma unroll
                    for (int e = 1; e < 16; ++e) if (bs[e] > bv) { bv = bs[e]; bsc = sc[e]; bi = e; }
                    int gi = sub * 16 + bi;
#pragma unroll
                    for (int o = 1; o < 16; o <<= 1) { const float ov = __shfl_xor(bv, o), os = __shfl_xor(bsc, o); const int oi = __shfl_xor(gi, o); if (ov > bv || (ov == bv && oi < gi)) { bv = ov; gi = oi; bsc = os; } }
                    if ((gi >> 4) == sub) { const int oe = gi & 15;
#pragma unroll
                        for (int e = 0; e < 16; ++e) if (e == oe) bs[e] = -1e30f; }
                    wsum += bsc;
                    if (sub == k) { myi = gi; myw = bsc; }
                }
                if (sub < 8) { const float w = myw / wsum * 2.5f; const int p = (int)atomicAdd(ecnt + myi, 1u);
                    TOPI[(size_t)r * 8 + sub] = myi; TOPW[(size_t)r * 8 + sub] = w; POS[(size_t)r * 8 + sub] = p; }
            }
            }
        }
        GRID_BAR(); STAMP(10);
        for (int rep_ = 0; rep_ < NREP(16384); ++rep_) {
            PHASE_LOCALS(); unsigned char* ws = WSB(); unsigned* ecnt = (unsigned*)(ws + WS_CTL) + CW_CNT + l * 256;
            const int* TOPI = (const int*)(ws + WS_TOPI); const float* TOPW = (const float*)(ws + WS_TOPW); const int* POS = (const int*)(ws + WS_POS); int* SLOT = (int*)(ws + WS_SLOT);
            int* ROWTOK = (int*)(ws + WS_ROWTOK); float* ROWW = (float*)(ws + WS_ROWW); int* BLKEXP = (int*)(ws + WS_BLKEXP);
            LAS int* cntL = (LAS int*)lds; LAS int* bst = cntL + 256; LAS int* tot = bst + 256;
            if (tid < 256) cntL[tid] = (int)__hip_atomic_load(ecnt + tid, RLX_AGENT);
            __syncthreads();
            if (tid == 0) { int s = 0; for (int e = 0; e < 256; ++e) { bst[e] = s; s += (cntL[e] + 255) >> 8; } tot[0] = s; }
            __syncthreads();
            const int NB = tot[0]; const int gt = bx * NTHR + tid, GT = G * NTHR;
            for (int i = gt; i < MALL * 8; i += GT) { const int e = TOPI[i]; const int slot = bst[e] * 256 + POS[i]; SLOT[i] = slot; st_wt(ROWTOK + slot, i >> 3); st_wt(ROWW + slot, TOPW[i]); }
            for (int i = gt; i < 256 * 256; i += GT) { const int e = i >> 8, p = i & 255, c = cntL[e]; if ((c & 255) != 0 && p >= (c & 255)) { const int slot = (bst[e] + (c >> 8)) * 256 + p; st_wt(ROWTOK + slot, 0); st_wt(ROWW + slot, -1.f); } }
            for (int i = gt; i < 256 * 160; i += GT) { const int e = i / 160, j = i % 160; if (j < ((cntL[e] + 255) >> 8)) st_wt(BLKEXP + bst[e] + j, e); }
            for (int i = gt; i < NRT * 256; i += GT) { const int slot = NB * 256 + i; ROWTOK[slot] = i; ROWW[slot] = 1.f; if ((i & 255) == 0) st_wt(BLKEXP + NB + (i >> 8), 256); }
            if (gt == 0) st_wt(BLKEXP + MAXBLK, NB + NRT);
            __syncthreads();
        }
        GRID_BAR(); STAMP(10);
        for (int rep_ = 0; rep_ < NREP(32768); ++rep_) {
            PHASE_LOCALS(); unsigned char* ws = WSB(); unsigned char* WL = ws + WS_W0 + (size_t)l * WL_SIZE; const int* ROWTOK = (const int*)(ws + WS_ROWTOK); const int* BLKEXP = (const int*)(ws + WS_BLKEXP);
            LAS int* rowtab = (LAS int*)(lds + TAB_OFF); LAS int* etab = rowtab + 12 * 256;
            const int nunits = BLKEXP[MAXBLK] * 2;
            for (int i = 0; i < 12; ++i) { const int L = i * G + vcu; if (L >= nunits) break; const int bi = L >> 1;
                if (tid < 256) rowtab[i * 256 + tid] = ROWTOK[(size_t)bi * 256 + tid]; if (tid == 256) etab[i] = BLKEXP[bi]; }
            __syncthreads();
            pg8::MoeOrder<2, true> S{nunits, G, vcu, (const char*)(WL + WL_E1), (size_t)512 * 1024 * 2, (size_t)256 * 1024 * 2, rowtab, etab};
            EpiSwiglu E{(bf16_t*)(ws + WS_HE)}; pg8::gemm_phase(lds, (const bf16_t*)(ws + WS_H2A), 1024, 1024, S, E);
        }
        GRID_BAR(); STAMP(11);
        for (int rep_ = 0; rep_ < NREP(65536); ++rep_) {
            PHASE_LOCALS(); unsigned char* ws = WSB(); unsigned char* WL = ws + WS_W0 + (size_t)l * WL_SIZE; const int* BLKEXP = (const int*)(ws + WS_BLKEXP);
            LAS int* rowtab = (LAS int*)(lds + TAB_OFF); LAS int* etab = rowtab + 12 * 256;
            const int nunits = BLKEXP[MAXBLK] * 4;
            for (int i = tid; i < 64; i += NTHR) { const int L = i * G + vcu; if (L < nunits) etab[i] = BLKEXP[L >> 2]; }
            __syncthreads();
            pg8::MoeOrder<4, false> S{nunits, G, vcu, (const char*)(WL + WL_E2), (size_t)1024 * 256 * 2, (size_t)256 * 256 * 2, rowtab, etab};
            EpiScaleRow E{(bf16_t*)(ws + WS_YB), (const float*)(ws + WS_ROWW)}; pg8::gemm_phase(lds, (const bf16_t*)(ws + WS_HE), 256, 256, S, E);
        }
        GRID_BAR(); STAMP(12);
        for (int rep_ = 0; rep_ < NREP(131072); ++rep_) {
            PHASE_LOCALS(); unsigned char* ws = WSB(); const float* MODV = (const float*)(ws + WS_MODV); const float* modv = MODV + l * 3 * 6144; const bf16_t* YB = (const bf16_t*)(ws + WS_YB); const int* SLOT = (const int*)(ws + WS_SLOT);
            const float* X1 = (const float*)(ws + WS_R); float* XCUR = (float*)(ws + WS_XCUR); bf16_t* HMOD = (bf16_t*)(ws + WS_HMOD); float* outp = OUTP();
            const float* g2 = INP(I_LN2G) + l * 1024; const float* b2 = INP(I_LN2B) + l * 1024; const float* g1 = INP(I_LN1G) + l * 1024; const float* b1 = INP(I_LN1B) + l * 1024;
            const int NB = ((const int*)(ws + WS_BLKEXP))[MAXBLK] - NRT;
            for (int r0 = gw; r0 < MALL; r0 += 2 * NGW) { const int r1 = r0 + NGW; const bool has1 = r1 < MALL; const int rr[2] = {r0, has1 ? r1 : r0};
                int sl[2]; u32x2 yb[2][9][2]; u32x4 rx[2][2];
#pragma unroll
                for (int x = 0; x < 2; ++x) sl[x] = SLOT[(size_t)rr[x] * 8 + (lane & 7)];
#pragma unroll
                for (int x = 0; x < 2; ++x) {
#pragma unroll
                    for (int j2 = 0; j2 < 2; ++j2) { yb[x][8][j2] = *(const u32x2*)((const unsigned char*)YB + ((size_t)NB * 256 + rr[x]) * 1024 + 8 * lane + 512 * j2); rx[x][j2] = *(const u32x4*)((const bf16_t*)X1 + (size_t)rr[x] * 1024 + 8 * lane + 512 * j2); }
#pragma unroll
                    for (int k = 0; k < 8; ++k) { const size_t so = (size_t)__shfl(sl[x], k) * 1024;
#pragma unroll
                        for (int j2 = 0; j2 < 2; ++j2) yb[x][k][j2] = *(const u32x2*)((const unsigned char*)YB + so + 8 * lane + 512 * j2); } }
#pragma unroll
                for (int x = 0; x < 2; ++x) { if (x == 1 && !has1) break;
                    const int r = rr[x]; const int b = r / TPB, t = r % TPB, set = t < SEQ ? b : 2; const float* mv = modv + set * 6144; f32x4 xv[4], v[4];
#pragma unroll
                    for (int j2 = 0; j2 < 2; ++j2) { xv[2 * j2] = unpk4((u32x2){rx[x][j2].x, rx[x][j2].y}); xv[2 * j2 + 1] = unpk4((u32x2){rx[x][j2].z, rx[x][j2].w}); }
                    ln_row8(xv, g1, b1, lane);
#pragma unroll
                    for (int j = 0; j < 4; ++j) { const int j2 = j >> 1, hf = j & 1; f32x4 f = unpk4_fp8(hf ? yb[x][8][j2].y : yb[x][8][j2].x);
#pragma unroll
                        for (int k = 0; k < 8; ++k) f = f + unpk4_fp8(hf ? yb[x][k][j2].y : yb[x][k][j2].x);
                        f = f * (1.f / YB8_SCALE);
                        v[j] = xv[j] * ALPHA_RES + *(const f32x4*)(mv + 5 * 1024 + C8(j)) * f; }
                    ln_row8(v, g2, b2, lane);
                    if (l == 0) { const float* mn = MODV + 3 * 6144 + set * 6144;
#pragma unroll
                        for (int j2 = 0; j2 < 2; ++j2) { u32x2 pk[2];
#pragma unroll
                            for (int hf = 0; hf < 2; ++hf) { const int j = 2 * j2 + hf, c = C8(j); *(f32x4*)(XCUR + (size_t)r * 1024 + c) = v[j];
                                const f32x4 sh = *(const f32x4*)(mn + c), sc = *(const f32x4*)(mn + 1024 + c); pk[hf] = pk4(v[j] * (sc + 1.f) + sh); }
                            *(u32x4*)(HMOD + (size_t)r * 1024 + 8 * lane + 512 * j2) = (u32x4){pk[0].x, pk[0].y, pk[1].x, pk[1].y}; } }
                    else if (t < SEQ) {
#pragma unroll
                        for (int j = 0; j < 4; ++j) *(f32x4*)(outp + ((size_t)b * SEQ + t) * 1024 + C8(j)) = v[j]; } } }
        }
        if (l == 0 || PROBE) { GRID_BAR(); STAMP(13); }
    }
#if PROBE
    {
        unsigned char* ws = WSB(); unsigned* ctl = (unsigned*)(ws + WS_CTL);
        if (blockIdx.x == 0 && threadIdx.x == 0) { LAS unsigned long long* ts_ = (LAS unsigned long long*)(lds + MISC_OFF + 64);
            unsigned long long sa = 0, sb = 0; for (int c = 0; c < 14; ++c) { if ((PROBE_A >> c) & 1) sa += ts_[1 + c]; if ((PROBE_B >> c) & 1) sb += ts_[1 + c]; }
            __hip_atomic_store(ctl + 20000, (unsigned)(sa / 100ull), RLX_AGENT); __hip_atomic_store(ctl + 20001, (unsigned)(sb / 100ull), RLX_AGENT); }
        GRID_BAR();
        const float va = sqrtf((float)__hip_atomic_load(ctl + 20000, RLX_AGENT)), vb = (float)__hip_atomic_load(ctl + 20001, RLX_AGENT);
        float* outp = OUTP();
        for (size_t i = (size_t)blockIdx.x * NTHR + threadIdx.x; i < (size_t)BATCH * SEQ * 1024; i += (size_t)gridDim.x * NTHR) outp[i] = (i == 0) ? vb : va;
    }
#endif
}

extern "C" void kernel_launch(void* const* d_in, const int* in_sizes, int n_in, void* d_out, int out_size, void* d_ws, size_t ws_size, hipStream_t stream) {
    static int grid = 0;
    if (grid == 0) {
        if (n_in != 25 || ws_size < WS_END) { fprintf(stderr, "kernel_launch: need 25 inputs and >= %zu bytes of workspace; got %d, %zu\n", (size_t)WS_END, n_in, ws_size); grid = -1; return; }
        int dev = 0, cus = 0, per_cu = 0;
        if (hipGetDevice(&dev) != hipSuccess || hipDeviceGetAttribute(&cus, hipDeviceAttributeMultiprocessorCount, dev) != hipSuccess) { grid = -1; return; }
        if (hipFuncSetAttribute((const void*)mega_fwd, hipFuncAttributeMaxDynamicSharedMemorySize, LDS_BYTES) != hipSuccess) { fprintf(stderr, "kernel_launch: hipFuncSetAttribute failed\n"); grid = -1; return; }
        if (hipOccupancyMaxActiveBlocksPerMultiprocessor(&per_cu, (const void*)mega_fwd, NTHR, LDS_BYTES) != hipSuccess || per_cu < 1) { fprintf(stderr, "kernel_launch: occupancy query says %d\n", per_cu); (void)hipGetLastError(); per_cu = 1; }
        grid = cus;
    }
    if (grid < 0) return;
    if (hipMemsetAsync((char*)d_ws + WS_CTL, 0, CTL_ZERO_BYTES, stream) != hipSuccess) return;
    KArgs a{};
    for (int i = 0; i < 25; ++i) a.in[i] = (const float*)d_in[i];
    a.out = (float*)d_out; a.ws = (unsigned char*)d_ws; a.dbg = 0; a.pad = 0;
    hipLaunchKernelGGL(mega_fwd, dim3(grid), dim3(NTHR), LDS_BYTES, stream, a);
}
```

```cpp
#include <hip/hip_runtime.h>
#include <cstdio>
#include <cstdint>

#define GAS __attribute__((address_space(1)))
#define LAS __attribute__((address_space(3)))
typedef unsigned short bf16_t;
typedef short bf16x8 __attribute__((ext_vector_type(8)));
typedef short s16x4 __attribute__((ext_vector_type(4)));
typedef float f32x4 __attribute__((ext_vector_type(4)));
typedef float f32x2 __attribute__((ext_vector_type(2)));
typedef float f32x8 __attribute__((ext_vector_type(8)));
typedef float f32x16 __attribute__((ext_vector_type(16)));
typedef unsigned u32x4 __attribute__((ext_vector_type(4)));
typedef unsigned u32x2 __attribute__((ext_vector_type(2)));
typedef GAS unsigned gu32;
#define RLX_AGENT __ATOMIC_RELAXED, __HIP_MEMORY_SCOPE_AGENT
#define LDS_WAIT() asm volatile("s_waitcnt lgkmcnt(0)" ::: "memory")
#define VM_WAIT() asm volatile("s_waitcnt vmcnt(0)" ::: "memory")

constexpr int D = 1024, BATCH = 2, SEQ = 16384, CTX = 256, TPB = SEQ + CTX  , MALL = BATCH * TPB  ;
constexpr int NRT = MALL / 256;
constexpr int NWAVES = 8, NTHR = 512;
constexpr int INW = 8208, INW_PAD = 8448;
constexpr int NEXP = 256, TOPK = 8;
constexpr float ALPHA_RES = 1.4142135623730951f;
constexpr float LN_EPS = 1e-5f, RMS_EPS = 1e-6f;
constexpr float QSCALE = 0.125f * 1.4426950408889634f;
constexpr int MAXBLK = 1040 + 256 + 130;
constexpr int NCHUNK = TPB / 64;
constexpr int NCHAIN = 16;
#ifndef PHM
#define PHM 0x3ffff
#endif
#ifndef PROBE
#define PROBE 0
#endif
#ifndef REPM
#define REPM 0
#endif
#ifndef XBAR
#define XBAR 1
#endif
#ifndef ROUTER_K
#define ROUTER_K 1024
#endif
#ifndef XTOPK
#define XTOPK 0
#endif
#ifndef XSCAN
#define XSCAN 0
#endif
#define NREP(bit) (((PHM) & (bit)) ? (((REPM) & (bit)) ? 2 : 1) : 0)
#ifndef PROBE_A
#define PROBE_A 0x10
#endif
#ifndef PROBE_B
#define PROBE_B 0x2c
#endif

__device__ __forceinline__ unsigned pk2(float lo, float hi) { unsigned r; asm("v_cvt_pk_bf16_f32 %0, %1, %2" : "=v"(r) : "v"(lo), "v"(hi)); return r; }
__device__ __forceinline__ unsigned f2bf(float f) { return pk2(f, 0.f) & 0xffffu; }
__device__ __forceinline__ float bf2f(unsigned h) { return __builtin_bit_cast(float, h << 16); }

__device__ __forceinline__ u32x2 pk4(f32x4 v) { u32x2 r; r.x = pk2(v.x, v.y); r.y = pk2(v.z, v.w); return r; }
__device__ __forceinline__ f32x4 unpk4(u32x2 w) { f32x4 r; r.x = bf2f(w.x & 0xffffu); r.y = bf2f(w.x >> 16); r.z = bf2f(w.y & 0xffffu); r.w = bf2f(w.y >> 16); return r; }
__device__ __forceinline__ float sigmoidf_(float x) { return __builtin_amdgcn_rcpf(1.f + __expf(-x)); }
__device__ __forceinline__ float siluf_(float x) { return x * __builtin_amdgcn_rcpf(1.f + __expf(-x)); }
__device__ __forceinline__ float logsigf_(float x) { return fminf(x, 0.f) - log1pf(__expf(-fabsf(x))); }
__device__ __forceinline__ void st_wt(int* p, int v) { __hip_atomic_store(p, v, __ATOMIC_RELAXED, __HIP_MEMORY_SCOPE_AGENT); }
__device__ __forceinline__ void st_wt(float* p, float v) { __hip_atomic_store(p, v, __ATOMIC_RELAXED, __HIP_MEMORY_SCOPE_AGENT); }
__device__ __forceinline__ int opaque_tid() { int t = threadIdx.x; asm volatile("" : "+v"(t)); return t; }
__device__ __forceinline__ float wave_sum(float v) {
    v += __builtin_bit_cast(float, __builtin_amdgcn_mov_dpp(__builtin_bit_cast(int, v), 0xB1, 0xF, 0xF, true));
    v += __builtin_bit_cast(float, __builtin_amdgcn_mov_dpp(__builtin_bit_cast(int, v), 0x4E, 0xF, 0xF, true));
    v += __builtin_bit_cast(float, __builtin_amdgcn_mov_dpp(__builtin_bit_cast(int, v), 0x141, 0xF, 0xF, true));
    v += __builtin_bit_cast(float, __builtin_amdgcn_mov_dpp(__builtin_bit_cast(int, v), 0x140, 0xF, 0xF, true));
    { auto a = __builtin_amdgcn_permlane16_swap(__float_as_uint(v), __float_as_uint(v), false, false); v = __uint_as_float(a[0]) + __uint_as_float(a[1]); }
    { auto b = __builtin_amdgcn_permlane32_swap(__float_as_uint(v), __float_as_uint(v), false, false); v = __uint_as_float(b[0]) + __uint_as_float(b[1]); }
    return v;
}

constexpr size_t MiB = 1u << 20;
constexpr size_t WS_CTL = 0, CTL_ZERO_BYTES = 1 * MiB;
constexpr size_t WS_MODV = 1 * MiB;
constexpr size_t WS_ROPE = WS_MODV + 256 * 1024;
constexpr size_t WS_W0 = 2 * MiB;
constexpr size_t WL_IN = 0;
constexpr size_t WL_BRA = WL_IN + (size_t)INW_PAD * 1024 * 2;
constexpr size_t WL_BRM = WL_BRA + 2 * MiB;
constexpr size_t WL_OUT = WL_BRM + 2 * MiB;
constexpr size_t WL_R3 = WL_OUT + 2 * MiB;
constexpr size_t WL_E1 = WL_R3 + (size_t)256 * 3072 * 2;
constexpr size_t WL_E2 = WL_E1 + (size_t)257 * 512 * 1024 * 2;
constexpr size_t WL_SIZE = WL_E2 + (size_t)257 * 1024 * 256 * 2;
constexpr size_t ACT0 = WS_W0 + 2 * WL_SIZE;
constexpr size_t SZ_B16 = (size_t)MALL * 1024 * 2;
constexpr size_t WS_HMOD = ACT0;
constexpr size_t WS_Q = WS_HMOD + SZ_B16, WS_K = WS_Q + SZ_B16, WS_V = WS_K + SZ_B16, WS_QKM = WS_V + SZ_B16, WS_VM = WS_QKM + SZ_B16;
constexpr size_t WS_OMS = WS_VM + SZ_B16, WS_GA = WS_OMS + SZ_B16, WS_GB = WS_GA + SZ_B16;
constexpr size_t WS_GATES = WS_GB + SZ_B16;
constexpr size_t WS_OJ = WS_GATES + (size_t)MALL * 16 * 4 + 61440;
constexpr size_t WS_OA = WS_OJ + 2 * SZ_B16;
constexpr size_t WS_ST = WS_OA + SZ_B16;
constexpr size_t WS_NU = WS_ST + (size_t)NCHAIN * NCHUNK * 65536;
constexpr size_t WS_ADEC = WS_NU + (size_t)NCHAIN * NCHUNK * 128 * 4;
constexpr size_t WS_HM = WS_ADEC + 65536;
constexpr size_t WS_T1 = WS_HM + SZ_B16, WS_Y = WS_T1 + SZ_B16;
constexpr size_t WS_R = WS_Y + SZ_B16;
constexpr size_t WS_X1 = WS_R + 2 * SZ_B16, WS_XCUR = WS_X1 + 2 * SZ_B16;
constexpr size_t WS_H2A = WS_XCUR + 2 * SZ_B16;
constexpr size_t WS_LOG = WS_H2A + 3 * SZ_B16;
constexpr size_t WS_TOPI = WS_LOG + (size_t)MALL * 256 * 4;
constexpr size_t WS_TOPW = WS_TOPI + 2 * MiB, WS_POS = WS_TOPW + 2 * MiB, WS_SLOT = WS_POS + 2 * MiB;
constexpr size_t WS_ROWTOK = WS_SLOT + 2 * MiB;
constexpr size_t WS_ROWW = WS_ROWTOK + 2 * MiB;
constexpr size_t WS_BLKEXP = WS_ROWW + 2 * MiB;
constexpr size_t WS_HE = WS_BLKEXP + 1 * MiB;
constexpr size_t WS_YB = WS_HE + (size_t)MAXBLK * 256 * 256 * 2;
constexpr size_t WS_END = WS_YB + (size_t)MAXBLK * 256 * 1024 * 2;
static_assert(WS_END <= (size_t)4096 * MiB, "d_ws map fits 4 GiB");
constexpr int CW_BAR = 4096;
constexpr int CW_CNT = 16384;
constexpr int CW_MSTAB = 17408;

constexpr int RING_BYTES = 131072;
constexpr int TAB_OFF = RING_BYTES;
constexpr int TAB_BYTES = 12 * 1024 + 256;
constexpr int MISC_OFF = TAB_OFF + TAB_BYTES;
constexpr int LDS_BYTES = 147456;
static_assert(MISC_OFF + 128 <= LDS_BYTES, "LDS map");

#define XB_TMO      128
#define XB_XCNT(j)  (256  + 64 * (j))
#define XB_XSUB(j)  (1280 + 64 * (j))
#define XB_XGEN(j)  (2304 + 64 * (j))
#define XB_TOP      3328
#define XB_TOPGEN   3392
#define XCD_BAR_WORDS 3456
#define XB_SPIN_CAP (1u << 22)
__device__ __forceinline__ unsigned xb_ld(unsigned* p)              { return __hip_atomic_load(p, __ATOMIC_RELAXED, __HIP_MEMORY_SCOPE_AGENT); }
__device__ __forceinline__ unsigned xb_add(unsigned* p, unsigned v) { return __hip_atomic_fetch_add(p, v, __ATOMIC_RELAXED, __HIP_MEMORY_SCOPE_AGENT); }
__device__ __forceinline__ unsigned xb_xcc_id() { return (unsigned)__builtin_amdgcn_s_getreg((3 << 11) | 20) & 0xFu; }
#define XB_SPIN(cond, bar) do { unsigned _sp = 0; while (cond) { __builtin_amdgcn_s_sleep(1); \
    if ((++_sp & 255u) == 0u) { if (xb_ld(&(bar)[XB_TMO])) break; if (_sp > XB_SPIN_CAP) { atomicAdd(&(bar)[XB_TMO], 1u); break; } } } } while (0)
struct XcdBarrier { unsigned* bar; unsigned x; volatile LAS unsigned* st; };
__device__ __forceinline__ XcdBarrier xcd_barrier_post(unsigned* bar, volatile LAS unsigned* st) {
    XcdBarrier b; b.bar = bar; b.x = xb_xcc_id(); b.st = st;
    if (threadIdx.x == 0) (void)xb_add(&bar[XB_XCNT(b.x)], 1u);
    return b;
}
__device__ __forceinline__ void xcd_barrier_complete(unsigned* bar, unsigned x, unsigned& nloc, unsigned& nx) {
    const unsigned G = gridDim.x * gridDim.y * gridDim.z;
    unsigned sum, cnt, mine, sp = 0u;
    for (;;) {
        sum = 0u; cnt = 0u; mine = 0u;
#pragma unroll
        for (unsigned j = 0; j < 16; ++j) { const unsigned c = xb_ld(&bar[XB_XCNT(j)]); sum += c; cnt += (c > 0u) ? 1u : 0u; mine = (j == x) ? c : mine; }
        if (sum == G) break;
        __builtin_amdgcn_s_sleep(1);
        if ((++sp & 255u) == 0u) { if (xb_ld(&bar[XB_TMO])) break; if (sp > XB_SPIN_CAP) { atomicAdd(&bar[XB_TMO], 1u); break; } }
    }
    nloc = mine > 0u ? mine : 1u; nx = cnt > 0u ? cnt : 1u;
}
template <bool FENCES, bool LOCAL>
__device__ __forceinline__ void xcd_barrier(const XcdBarrier& b) {
    asm volatile("s_waitcnt vmcnt(0)" ::: "memory");
    __syncthreads();
    if (threadIdx.x == 0) {
        unsigned* bar = b.bar;
        __builtin_amdgcn_s_waitcnt(0);
        unsigned nloc = b.st[0], nx = b.st[1];
        if (nloc == 0u) { xcd_barrier_complete(bar, b.x, nloc, nx); b.st[0] = nloc; b.st[1] = nx; }
        const unsigned old = xb_add(&bar[XB_XSUB(b.x)], 1u);
        const unsigned gen = old / nloc;
        if (old + 1u == (gen + 1u) * nloc) {
            if (FENCES) __builtin_amdgcn_fence(__ATOMIC_RELEASE, "agent");
            asm volatile("s_waitcnt vmcnt(0)" ::: "memory");
            if (!LOCAL) { const unsigned og = xb_add(&bar[XB_TOP], 1u);
                const unsigned tg = og / nx;
                if (og + 1u == (tg + 1u) * nx) xb_add(&bar[XB_TOPGEN], 1u);
                else XB_SPIN(xb_ld(&bar[XB_TOPGEN]) == tg, bar); }
            if (FENCES) __builtin_amdgcn_fence(__ATOMIC_ACQUIRE, "agent");
            xb_add(&bar[XB_XGEN(b.x)], 1u);
            asm volatile("s_waitcnt vmcnt(0)" ::: "memory");
        } else {
            XB_SPIN(xb_ld(&bar[XB_XGEN(b.x)]) == gen, bar);
            if (FENCES) __builtin_amdgcn_fence(__ATOMIC_ACQUIRE, "agent");
            asm volatile("s_waitcnt vmcnt(0)" ::: "memory");
        }
    }
    __syncthreads();
}

namespace pg8 {
constexpr int BM = 256, BK = 64, HALF = 128, HTB = HALF * BK * 2, STAGE_BYTES = 8 * HTB, NXCD = 8, WGM = 8;
__host__ __device__ __forceinline__ int lds_byte(int r, int c) { const int st = (r >> 4) * 2 + (c >> 5), rr = r & 15, cc = c & 31, ob = rr * 64 + cc * 2; return st * 1024 + (ob ^ (((ob >> 9) & 1) << 5)); }
__host__ __device__ __forceinline__ void stage_rc(int b, int& R, int& C) { const int st = b / 1024, sb = b % 1024, swz = sb ^ (((sb >> 9) & 1) << 5); R = (st >> 1) * 16 + swz / 64; C = (st & 1) * 32 + (swz % 64) / 2; }
struct Unit { int pm, pn, aux; };

struct DenseOrder {
    static constexpr bool GATHER = false;
    int nM, nN, nwg, G, c, skipctx; const char* Bt; size_t btile;
    __device__ __forceinline__ void init(int nM_, int nN_, int G_, int c_, const void* Bt_, int K, int skipctx_ = 0) { nM = nM_; nN = nN_; nwg = nM * nN; G = G_; c = c_; Bt = (const char*)Bt_; btile = (size_t)256 * K * 2; skipctx = skipctx_; }
    __device__ __forceinline__ bool next(int i, Unit& u) const {
        const long L = (long)i * G + c; if (L >= nwg) return false;
        int wgid = (int)L; { const int q = nwg / NXCD, r = nwg % NXCD, xcd = wgid % NXCD, off = wgid / NXCD; wgid = (xcd < r ? xcd * (q + 1) : r * (q + 1) + (xcd - r) * q) + off; }
        const int nig = WGM * nN, gid = wgid / nig, fm = gid * WGM, gsz = (nM - fm) < WGM ? (nM - fm) : WGM;
        u.pm = fm + ((wgid % nig) % gsz); u.pn = (wgid % nig) / gsz; u.aux = 0; if (skipctx && u.pm >= 64) u.pm += 1; return true;
    }
    __device__ __forceinline__ unsigned arow(const Unit& u, int r) const { return 0u; }
    __device__ __forceinline__ const char* bptr(const Unit& u) const { return Bt + (size_t)u.pn * btile; }
};
template <int NPN, bool GATHER_> struct MoeOrder {
    static constexpr bool GATHER = GATHER_;
    int nunits, G, vcu; const char* W; size_t estride, btile; const LAS int* rowtab; const LAS int* etab;
    __device__ __forceinline__ bool next(int i, Unit& u) const {
        const int L = i * G + vcu; if (L >= nunits) return false;
        u.pm = L / NPN; u.pn = L % NPN; u.aux = i; return true;
    }
    __device__ __forceinline__ unsigned arow(const Unit& u, int r) const { return (unsigned)rowtab[u.aux * 256 + r]; }
    __device__ __forceinline__ const char* bptr(const Unit& u) const { return W + (size_t)etab[u.aux] * estride + (size_t)u.pn * btile; }
};

template <class Epi, class Sched>
__device__ __forceinline__ void gemm_phase(LAS unsigned char* lds, const bf16_t* A, int lda, int K, const Sched& S, const Epi& E, int ldb = 0) {
    if (ldb == 0) ldb = K;
    constexpr bool GATHER = Sched::GATHER;
    const int tid = opaque_tid(), wid = __builtin_amdgcn_readfirstlane(tid >> 6), lane = tid & 63, wr = wid >> 2, wc = wid & 3, fr = lane & 15, fq = lane >> 4;
    const int nt = K / BK;
    int R0, C0, R1, C1; stage_rc(tid * 16, R0, C0); stage_rc(tid * 16 + 8192, R1, C1);
    const unsigned vb0 = (unsigned)(R0 * ldb + C0) * 2u, vb1 = (unsigned)(R1 * ldb + C1) * 2u;
    const unsigned lda2 = (unsigned)lda * 2u;
    const size_t kstep = (size_t)(BK * 2);
    const size_t hstepB = (size_t)HALF * ldb * 2;
    const size_t hstepA = GATHER ? (size_t)0 : (size_t)HALF * lda2, tstepA = GATHER ? (size_t)0 : (size_t)256 * lda2;
    const unsigned ldsw = (unsigned)wid * 1024u;
    const int aoff = lds_byte(wr * 64 + fr, fq * 8), boff = lds_byte(wc * 32 + fr, fq * 8);
    const char* gA = (const char*)A;
#define PG8_SA(b, h) (((b) * 2 + (h)) * HTB)
#define PG8_SB(b, h) ((4 + (b) * 2 + (h)) * HTB)
#define PG8_STAGE(bufoff, gbase, o0, o1) do { \
        __builtin_amdgcn_global_load_lds((const unsigned*)((const char*)(gbase) + (o0)), (LAS unsigned*)(lds + (bufoff) + ldsw), 16, 0, 0); \
        __builtin_amdgcn_global_load_lds((const unsigned*)((const char*)(gbase) + (o1)), (LAS unsigned*)(lds + (bufoff) + ldsw + 8192), 16, 0, 0); } while (0)
#define PG8_LDA(dst, b, h) do { _Pragma("unroll") for (int m = 0; m < 4; ++m) _Pragma("unroll") for (int k = 0; k < 2; ++k) dst[m][k] = *(const LAS bf16x8*)(lds + PG8_SA(b, h) + aoff + m * 2048 + k * 1024); } while (0)
#define PG8_LDB(dst, b, h) do { _Pragma("unroll") for (int n = 0; n < 2; ++n) _Pragma("unroll") for (int k = 0; k < 2; ++k) dst[n][k] = *(const LAS bf16x8*)(lds + PG8_SB(b, h) + boff + n * 2048 + k * 1024); } while (0)
#define PG8_MMA(ai, bj, At, Bt) do { __builtin_amdgcn_s_setprio(1); _Pragma("unroll") for (int m = 0; m < 4; ++m) _Pragma("unroll") for (int n = 0; n < 2; ++n) _Pragma("unroll") for (int k = 0; k < 2; ++k) \
        acc[ai][bj][m][n] = __builtin_amdgcn_mfma_f32_16x16x32_bf16(Bt[n][k], At[m][k], acc[ai][bj][m][n], 0, 0, 0); __builtin_amdgcn_s_setprio(0); } while (0)
#define PG8_WAIT_V(n) asm volatile("s_waitcnt vmcnt(" #n ")" ::: "memory")
#define PG8_WAIT_L(n) asm volatile("s_waitcnt lgkmcnt(" #n ")" ::: "memory")
#define PG8_BAR __builtin_amdgcn_s_barrier()
#define PG8_SCHED __builtin_amdgcn_sched_barrier(0)
    Unit cur, nxt; int ui = 0;
    if (!S.next(0, cur)) return;
    f32x4 acc[2][2][4][2];
#pragma unroll
    for (int a = 0; a < 2; ++a)
#pragma unroll
        for (int b = 0; b < 2; ++b)
#pragma unroll
            for (int m = 0; m < 4; ++m)
#pragma unroll
                for (int n = 0; n < 2; ++n) acc[a][b][m][n] = (f32x4){0.f, 0.f, 0.f, 0.f};
    bf16x8 At[4][2], B0[2][2], B1[2][2];
    unsigned o00, o01, o10, o11;
    if constexpr (GATHER) { o00 = S.arow(cur, R0) * lda2 + (unsigned)(C0 * 2); o01 = S.arow(cur, R1) * lda2 + (unsigned)(C1 * 2); o10 = S.arow(cur, 128 + R0) * lda2 + (unsigned)(C0 * 2); o11 = S.arow(cur, 128 + R1) * lda2 + (unsigned)(C1 * 2); }
    else { o00 = (unsigned)R0 * lda2 + (unsigned)(C0 * 2); o01 = (unsigned)R1 * lda2 + (unsigned)(C1 * 2); o10 = o00; o11 = o01; }
    const char* cA = gA + (size_t)cur.pm * tstepA;
    const char* cB = S.bptr(cur);
    PG8_STAGE(PG8_SB(0, 0), cB, vb0, vb1); PG8_STAGE(PG8_SB(0, 1), cB + hstepB, vb0, vb1); PG8_STAGE(PG8_SA(0, 0), cA, o00, o01); PG8_STAGE(PG8_SA(0, 1), cA + hstepA, o10, o11);
    if (wr == 1) PG8_BAR;
    PG8_WAIT_V(2); PG8_BAR;
    PG8_STAGE(PG8_SB(1, 0), cB + kstep, vb0, vb1); PG8_STAGE(PG8_SA(1, 0), cA + kstep, o00, o01); PG8_STAGE(PG8_SB(1, 1), cB + hstepB + kstep, vb0, vb1);
    PG8_WAIT_V(6); PG8_BAR;
    for (;;) {
        const bool has_next = S.next(ui + 1, nxt);
        const char* nA = has_next ? gA + (size_t)nxt.pm * tstepA : cA; const char* nB = has_next ? S.bptr(nxt) : cB;
        for (int t = 0; t < nt; t += 2) {
            const bool last = (t == nt - 2);
            const char* a1 = cA + (size_t)(t + 1) * kstep;
            const char* a2 = last ? nA : cA + (size_t)(t + 2) * kstep; const char* b2 = last ? nB : cB + (size_t)(t + 2) * kstep;
            const char* a3 = a2 + kstep; const char* b3 = b2 + kstep;
            unsigned s00 = o00, s01 = o01, s10 = o10, s11 = o11;
            if constexpr (GATHER) { if (last && has_next) { s00 = S.arow(nxt, R0) * lda2 + (unsigned)(C0 * 2); s01 = S.arow(nxt, R1) * lda2 + (unsigned)(C1 * 2); s10 = S.arow(nxt, 128 + R0) * lda2 + (unsigned)(C0 * 2); s11 = S.arow(nxt, 128 + R1) * lda2 + (unsigned)(C1 * 2); } }
            PG8_LDB(B0, 0, 0); PG8_LDB(B1, 0, 1); PG8_SCHED; PG8_LDA(At, 0, 0); PG8_STAGE(PG8_SA(1, 1), a1 + hstepA, o10, o11);
            PG8_WAIT_V(8); PG8_WAIT_L(0); PG8_BAR; PG8_MMA(0, 0, At, B0); PG8_MMA(0, 1, At, B1); PG8_BAR; PG8_SCHED;
            PG8_LDA(At, 0, 1); PG8_STAGE(PG8_SB(0, 0), b2, vb0, vb1); PG8_STAGE(PG8_SB(0, 1), b2 + hstepB, vb0, vb1); PG8_STAGE(PG8_SA(0, 0), a2, s00, s01);
            PG8_WAIT_V(8); PG8_WAIT_L(0); PG8_BAR; PG8_MMA(1, 0, At, B0); PG8_MMA(1, 1, At, B1); PG8_BAR; PG8_SCHED;
            PG8_LDB(B0, 1, 0); PG8_LDB(B1, 1, 1); PG8_SCHED; PG8_LDA(At, 1, 0); PG8_STAGE(PG8_SA(0, 1), a2 + hstepA, s10, s11);
            PG8_WAIT_V(8); PG8_WAIT_L(0); PG8_BAR; PG8_MMA(0, 0, At, B0); PG8_MMA(0, 1, At, B1); PG8_BAR; PG8_SCHED;
            PG8_LDA(At, 1, 1); PG8_STAGE(PG8_SB(1, 0), b3, vb0, vb1); PG8_STAGE(PG8_SB(1, 1), b3 + hstepB, vb0, vb1); PG8_STAGE(PG8_SA(1, 0), a3, s00, s01);
            PG8_WAIT_V(8); PG8_WAIT_L(0); PG8_BAR; PG8_MMA(1, 0, At, B0); PG8_MMA(1, 1, At, B1); PG8_BAR; PG8_SCHED;
        }
        if (wr == 0) PG8_BAR;
        { const int t2 = opaque_tid(), w2 = __builtin_amdgcn_readfirstlane(t2 >> 6); E(acc, cur, w2 >> 2, w2 & 3, t2 & 15, (t2 & 63) >> 4); }
        if (!has_next) break;
#pragma unroll
        for (int a = 0; a < 2; ++a)
#pragma unroll
            for (int b = 0; b < 2; ++b)
#pragma unroll
                for (int m = 0; m < 4; ++m)
#pragma unroll
                    for (int n = 0; n < 2; ++n) acc[a][b][m][n] = (f32x4){0.f, 0.f, 0.f, 0.f};
        cur = nxt; cA = nA; cB = nB; ++ui;
        if constexpr (GATHER) { o00 = S.arow(cur, R0) * lda2 + (unsigned)(C0 * 2); o01 = S.arow(cur, R1) * lda2 + (unsigned)(C1 * 2); o10 = S.arow(cur, 128 + R0) * lda2 + (unsigned)(C0 * 2); o11 = S.arow(cur, 128 + R1) * lda2 + (unsigned)(C1 * 2); }
        if (wr == 1) PG8_BAR;
    }
    PG8_WAIT_V(0);
    PG8_BAR;
#undef PG8_SA
#undef PG8_SB
#undef PG8_STAGE
#undef PG8_LDA
#undef PG8_LDB
#undef PG8_MMA
#undef PG8_WAIT_V
#undef PG8_WAIT_L
#undef PG8_BAR
#undef PG8_SCHED
}
}

typedef const f32x4 (&AccRef)[2][2][4][2];
#define EPI_ROW(u, ai, m) ((u).pm * 256 + (ai) * 128 + wr * 64 + (m) * 16 + fr)
#define EPI_COL(bj, n) ((bj) * 128 + wc * 32 + (n) * 16 + 4 * fq)

struct EpiInProj {
    bf16_t *Q, *K, *V, *QKM, *VM, *OMS, *GA, *GB; float* GATES; const float* b_gates; const f32x2* rope; unsigned* mstab;
    __device__ __forceinline__ void operator()(AccRef acc, const pg8::Unit& u, int wr, int wc, int fr, int fq) const {
        const int b = u.pm / 65, tile = u.pm % 65; const bool is_ctx = (tile == 64);
        if (u.pn == 32) {
            if (wc != 0) return;
            const f32x4 bg = *(const f32x4*)(b_gates + 4 * fq);
            f32x4 mx = (f32x4){0.f, 0.f, 0.f, 0.f};
#pragma unroll
            for (int ai = 0; ai < 2; ++ai)
#pragma unroll
                for (int m = 0; m < 4; ++m) { const f32x4 g = acc[ai][0][m][0] + bg; *(f32x4*)(GATES + (size_t)EPI_ROW(u, ai, m) * 16 + 4 * fq) = g;
                    mx.x = fmaxf(mx.x, g.x); mx.y = fmaxf(mx.y, g.y); mx.z = fmaxf(mx.z, g.z); mx.w = fmaxf(mx.w, g.w); }
#pragma unroll
            for (int o = 1; o < 16; o <<= 1) { mx.x = fmaxf(mx.x, __shfl_xor(mx.x, o)); mx.y = fmaxf(mx.y, __shfl_xor(mx.y, o)); mx.z = fmaxf(mx.z, __shfl_xor(mx.z, o)); mx.w = fmaxf(mx.w, __shfl_xor(mx.w, o)); }
            if (fr == 0 && (fq == 0 || fq == 2)) { const int dir = fq >> 1;
                const unsigned r0 = atomicMax(mstab + (b * 4 + 0) * 2 + dir, __float_as_uint(mx.x)), r1 = atomicMax(mstab + (b * 4 + 1) * 2 + dir, __float_as_uint(mx.y));
                const unsigned r2 = atomicMax(mstab + (b * 4 + 2) * 2 + dir, __float_as_uint(mx.z)), r3 = atomicMax(mstab + (b * 4 + 3) * 2 + dir, __float_as_uint(mx.w));
                asm volatile("" :: "v"(r0), "v"(r1), "v"(r2), "v"(r3)); }
            return;
        }
        const int grp = u.pn >> 2, cbase = (u.pn & 3) * 256;
        bf16_t* dst = grp == 0 ? Q : grp == 1 ? K : grp == 2 ? V : grp == 3 ? QKM : grp == 4 ? VM : grp == 5 ? OMS : grp == 6 ? GA : GB;
        if (grp <= 1 && !is_ctx) {
            const bool colrot = (wc & 1) != 0; const float qs = grp == 0 ? QSCALE : 1.f;
#pragma unroll
            for (int ai = 0; ai < 2; ++ai) { f32x4 csa[4], csb[4];
#pragma unroll
                for (int m = 0; m < 4; ++m) { const int t = tile * 256 + ai * 128 + wr * 64 + m * 16 + fr; const int pos = colrot ? (t & 63) : (t >> 6);
                    csa[m] = *(const f32x4*)(rope + pos * 16 + 4 * fq); csb[m] = *(const f32x4*)(rope + pos * 16 + 4 * fq + 2); }
#pragma unroll
                for (int m = 0; m < 4; ++m) { const int row = EPI_ROW(u, ai, m);
                    const f32x4 cs0 = csa[m], cs1 = csb[m];
                    const f32x4 cv = (f32x4){cs0.x, cs0.z, cs1.x, cs1.z}, sv = (f32x4){cs0.y, cs0.w, cs1.y, cs1.w};
#pragma unroll
                    for (int bj = 0; bj < 2; ++bj) { const f32x4 x0 = acc[ai][bj][m][0], x1 = acc[ai][bj][m][1];
                        const f32x4 o0 = (x0 * cv - x1 * sv) * qs, o1 = (x1 * cv + x0 * sv) * qs;
                        bf16_t* p = dst + (size_t)row * 1024 + cbase + EPI_COL(bj, 0);
                        *(u32x2*)p = pk4(o0); *(u32x2*)(p + 16) = pk4(o1); } } }
            return;
        }
        const bool sig = grp >= 5; const float qs2 = grp == 0 ? QSCALE : 1.f;
#pragma unroll
        for (int ai = 0; ai < 2; ++ai)
#pragma unroll
            for (int m = 0; m < 4; ++m) { const int row = EPI_ROW(u, ai, m);
#pragma unroll
                for (int bj = 0; bj < 2; ++bj) { u32x2 pk[2];
#pragma unroll
                    for (int n = 0; n < 2; ++n) { f32x4 v = acc[ai][bj][m][n] * qs2;
                        if (sig) { v.x = sigmoidf_(v.x); v.y = sigmoidf_(v.y); v.z = sigmoidf_(v.z); v.w = sigmoidf_(v.w); }
                        pk[n] = pk4(v); }
                    bf16_t* p = dst + (size_t)row * 1024 + cbase;
                    if (grp >= 2) *(u32x4*)(p + bj * 128 + wc * 32 + 8 * fq) = (u32x4){pk[0].x, pk[0].y, pk[1].x, pk[1].y};
                    else { *(u32x2*)(p + EPI_COL(bj, 0)) = pk[0]; *(u32x2*)(p + EPI_COL(bj, 1)) = pk[1]; } } }
    }
};
struct EpiGate1 {
    const bf16_t* G; bf16_t* O;
    __device__ __forceinline__ void operator()(AccRef acc, const pg8::Unit& u, int wr, int wc, int fr, int fq) const {
#pragma unroll
        for (int ai = 0; ai < 2; ++ai) { u32x4 gw[4][2];
#pragma unroll
            for (int m = 0; m < 4; ++m) { const size_t ro = (size_t)EPI_ROW(u, ai, m) * 1024 + u.pn * 256;
#pragma unroll
                for (int bj = 0; bj < 2; ++bj) gw[m][bj] = *(const u32x4*)(G + ro + bj * 128 + wc * 32 + 8 * fq); }
#pragma unroll
            for (int m = 0; m < 4; ++m) { const size_t ro = (size_t)EPI_ROW(u, ai, m) * 1024 + u.pn * 256;
#pragma unroll
                for (int bj = 0; bj < 2; ++bj) { const u32x4 g = gw[m][bj];
                    const u32x2 lo = pk4(unpk4((u32x2){g.x, g.y}) * acc[ai][bj][m][0]), hi = pk4(unpk4((u32x2){g.z, g.w}) * acc[ai][bj][m][1]);
                    *(u32x4*)(O + ro + bj * 128 + wc * 32 + 8 * fq) = (u32x4){lo.x, lo.y, hi.x, hi.y}; } } }
    }
};
struct EpiGate2 {
    const bf16_t* G; const bf16_t* T1; bf16_t* O;
    __device__ __forceinline__ void operator()(AccRef acc, const pg8::Unit& u, int wr, int wc, int fr, int fq) const {
#pragma unroll
        for (int ai = 0; ai < 2; ++ai) { u32x4 gw[4][2], tw[4][2];
#pragma unroll
            for (int m = 0; m < 4; ++m) { const size_t ro = (size_t)EPI_ROW(u, ai, m) * 1024 + u.pn * 256;
#pragma unroll
                for (int bj = 0; bj < 2; ++bj) { gw[m][bj] = *(const u32x4*)(G + ro + bj * 128 + wc * 32 + 8 * fq); tw[m][bj] = *(const u32x4*)(T1 + ro + bj * 128 + wc * 32 + 8 * fq); } }
#pragma unroll
            for (int m = 0; m < 4; ++m) { const size_t ro = (size_t)EPI_ROW(u, ai, m) * 1024 + u.pn * 256;
#pragma unroll
                for (int bj = 0; bj < 2; ++bj) { const u32x4 g = gw[m][bj], t = tw[m][bj];
                    const u32x2 lo = pk4(unpk4((u32x2){t.x, t.y}) + unpk4((u32x2){g.x, g.y}) * acc[ai][bj][m][0]), hi = pk4(unpk4((u32x2){t.z, t.w}) + unpk4((u32x2){g.z, g.w}) * acc[ai][bj][m][1]);
                    *(u32x4*)(O + ro + bj * 128 + wc * 32 + 8 * fq) = (u32x4){lo.x, lo.y, hi.x, hi.y}; } } }
    }
};
struct XSrc {
    const float* x; const float* ctx; const float* xcur; int layer;
    __device__ __forceinline__ const float* row(int r) const {
        if (layer) return xcur + (size_t)r * 1024;
        const int b = r / TPB, t = r % TPB;
        return t < SEQ ? x + ((size_t)b * SEQ + t) * 1024 : ctx + ((size_t)b * CTX + (t - SEQ)) * 1024;
    }
};
struct EpiOut {
    XSrc xs; const float* modv  ; float* R;
    __device__ __forceinline__ void operator()(AccRef acc, const pg8::Unit& u, int wr, int wc, int fr, int fq) const {
        const int b = u.pm / 65, set = (u.pm % 65 == 64) ? 2 : b; const float* gate = modv + set * 6144 + 2 * 1024 + u.pn * 256;
        f32x4 g[2][2];
#pragma unroll
        for (int bj = 0; bj < 2; ++bj)
#pragma unroll
            for (int n = 0; n < 2; ++n) g[bj][n] = *(const f32x4*)(gate + bj * 128 + wc * 32 + 8 * fq + 4 * n);
#pragma unroll
        for (int ai = 0; ai < 2; ++ai) { f32x4 xv[4][2][2];
#pragma unroll
            for (int m = 0; m < 4; ++m) { const float* xr = xs.row(EPI_ROW(u, ai, m)) + u.pn * 256;
#pragma unroll
                for (int bj = 0; bj < 2; ++bj)
#pragma unroll
                    for (int n = 0; n < 2; ++n) xv[m][bj][n] = *(const f32x4*)(xr + bj * 128 + wc * 32 + 8 * fq + 4 * n); }
#pragma unroll
            for (int m = 0; m < 4; ++m) { bf16_t* rr = (bf16_t*)R + (size_t)EPI_ROW(u, ai, m) * 1024 + u.pn * 256;
#pragma unroll
                for (int bj = 0; bj < 2; ++bj) { const u32x2 lo = pk4(xv[m][bj][0] * ALPHA_RES + g[bj][0] * acc[ai][bj][m][0]), hi = pk4(xv[m][bj][1] * ALPHA_RES + g[bj][1] * acc[ai][bj][m][1]);
                    *(u32x4*)(rr + bj * 128 + wc * 32 + 8 * fq) = (u32x4){lo.x, lo.y, hi.x, hi.y}; } } }
    }
};
struct EpiLogits {
    float* O;
    __device__ __forceinline__ void operator()(AccRef acc, const pg8::Unit& u, int wr, int wc, int fr, int fq) const {
#pragma unroll
        for (int ai = 0; ai < 2; ++ai)
#pragma unroll
            for (int m = 0; m < 4; ++m) { float* rr = O + (size_t)EPI_ROW(u, ai, m) * 256;
#pragma unroll
                for (int bj = 0; bj < 2; ++bj)
#pragma unroll
                    for (int n = 0; n < 2; ++n) *(f32x4*)(rr + EPI_COL(bj, n)) = acc[ai][bj][m][n]; }
    }
};
struct EpiSwiglu {
    bf16_t* HE;
    __device__ __forceinline__ void operator()(AccRef acc, const pg8::Unit& u, int wr, int wc, int fr, int fq) const {
#pragma unroll
        for (int ai = 0; ai < 2; ++ai)
#pragma unroll
            for (int m = 0; m < 4; ++m) { bf16_t* rr = HE + (size_t)EPI_ROW(u, ai, m) * 256 + u.pn * 128;
                u32x2 pk[2];
#pragma unroll
                for (int n = 0; n < 2; ++n) { const f32x4 a = acc[ai][0][m][n], g = acc[ai][1][m][n];
                    f32x4 o; o.x = siluf_(a.x) * g.x; o.y = siluf_(a.y) * g.y; o.z = siluf_(a.z) * g.z; o.w = siluf_(a.w) * g.w; pk[n] = pk4(o); }
                *(u32x4*)(rr + wc * 32 + 8 * fq) = (u32x4){pk[0].x, pk[0].y, pk[1].x, pk[1].y}; }
    }
};
constexpr float YB8_SCALE = 64.f;
__device__ __forceinline__ unsigned pk4_fp8(f32x4 v) { int w = 0; w = __builtin_amdgcn_cvt_pk_fp8_f32(v.x, v.y, w, false); w = __builtin_amdgcn_cvt_pk_fp8_f32(v.z, v.w, w, true); return (unsigned)w; }
__device__ __forceinline__ f32x4 unpk4_fp8(unsigned w) { return (f32x4){__builtin_amdgcn_cvt_f32_fp8((int)w, 0), __builtin_amdgcn_cvt_f32_fp8((int)w, 1), __builtin_amdgcn_cvt_f32_fp8((int)w, 2), __builtin_amdgcn_cvt_f32_fp8((int)w, 3)}; }
struct EpiScaleRow {
    bf16_t* YB; const float* roww;
    __device__ __forceinline__ void operator()(AccRef acc, const pg8::Unit& u, int wr, int wc, int fr, int fq) const {
        float w8[2][4];
#pragma unroll
        for (int ai = 0; ai < 2; ++ai)
#pragma unroll
            for (int m = 0; m < 4; ++m) w8[ai][m] = roww[EPI_ROW(u, ai, m)];
#pragma unroll
        for (int ai = 0; ai < 2; ++ai)
#pragma unroll
            for (int m = 0; m < 4; ++m) { const int row = EPI_ROW(u, ai, m); const float w0 = w8[ai][m], w = w0 * YB8_SCALE;
#pragma unroll
                for (int bj = 0; bj < 2; ++bj)
                    if (w0 >= 0.f) *(u32x2*)((unsigned char*)YB + (size_t)row * 1024 + u.pn * 256 + bj * 128 + wc * 32 + 8 * fq) = (u32x2){pk4_fp8(acc[ai][bj][m][0] * w), pk4_fp8(acc[ai][bj][m][1] * w)};
                asm volatile("" ::: "memory"); }
    }
};

namespace att {
constexpr int QBLK = 32, KVBLK = 64, LDX = 1024;
constexpr float SCALE = 0.125f, THR = 8.f;
constexpr size_t SHM_V = KVBLK * 128 * 2, SHM_K = KVBLK * 64 * 2, SHM_ATTN = 2 * SHM_V + 2 * SHM_K + NWAVES * 64 * 4;
#define KSWZ64(row, colB) ((row) * 128 + ((colB) ^ ((((row) >> 1) & 7) << 4)))
#define SBAR() __builtin_amdgcn_sched_barrier(0)
__device__ __forceinline__ int crow(int r, int hi) { return (r & 3) + 8 * (r >> 2) + 4 * hi; }
__device__ __forceinline__ unsigned cvtpk(float lo, float hi) { unsigned r; asm volatile("v_cvt_pk_bf16_f32 %0, %1, %2" : "=v"(r) : "v"(lo), "v"(hi)); return r; }
__device__ __forceinline__ void partialSM(f32x16& p0, f32x16& p1, float& m_reg, float& mn, float& alpha) {
  constexpr float C = SCALE * 1.4426950408889634f;
  float pmax = p0[0];
#pragma unroll
  for (int r = 1; r < 16; ++r) pmax = fmaxf(pmax, p0[r]);
#pragma unroll
  for (int r = 0; r < 16; ++r) pmax = fmaxf(pmax, p1[r]);
  { auto rr = __builtin_amdgcn_permlane32_swap(__float_as_uint(pmax), __float_as_uint(pmax), false, false);
    pmax = fmaxf(__uint_as_float(rr[0]), __uint_as_float(rr[1])); }
  if (__builtin_expect(__all(pmax - m_reg <= THR / SCALE), 1)) { mn = m_reg; alpha = 1.f; }
  else { mn = fmaxf(m_reg, pmax); alpha = __builtin_amdgcn_exp2f((m_reg - mn) * C); m_reg = mn; }
  float mnC = -mn * C;
#pragma unroll
  for (int r = 0; r < 16; ++r) p0[r] = fmaf(p0[r], C, mnC);
#pragma unroll
  for (int r = 0; r < 16; ++r) p1[r] = fmaf(p1[r], C, mnC);
#pragma unroll
  for (int r = 0; r < 16; ++r) p0[r] = __builtin_amdgcn_exp2f(p0[r]);
}
__device__ __forceinline__ void finishSM(f32x16& p0, f32x16& p1, float alpha, float& l_reg, bf16x8& pa0, bf16x8& pa1, bf16x8& pa2, bf16x8& pa3) {
#pragma unroll
  for (int r = 0; r < 16; ++r) p1[r] = __builtin_amdgcn_exp2f(p1[r]);
  float ps = 0;
#pragma unroll
  for (int r = 0; r < 16; ++r) ps += p0[r];
#pragma unroll
  for (int r = 0; r < 16; ++r) ps += p1[r];
  { auto rr = __builtin_amdgcn_permlane32_swap(__float_as_uint(ps), __float_as_uint(ps), false, false);
    ps = __uint_as_float(rr[0]) + __uint_as_float(rr[1]); }
  l_reg = l_reg * alpha + ps;
#define PK4(P, BASE, OUT) do { u32x4 w = {cvtpk(P[BASE + 0], P[BASE + 1]), cvtpk(P[BASE + 2], P[BASE + 3]), cvtpk(P[BASE + 4], P[BASE + 5]), cvtpk(P[BASE + 6], P[BASE + 7])}; \
    OUT = *reinterpret_cast<bf16x8*>(&w); } while (0)
  PK4(p0, 0, pa0); PK4(p0, 8, pa1); PK4(p1, 0, pa2); PK4(p1, 8, pa3);
#undef PK4
}
__device__ __forceinline__ void qkt(f32x16& p0, f32x16& p1, const char* Ks, const bf16x8* qr, int r32, int hi) {
  p0 = f32x16{}; p1 = f32x16{};
#pragma unroll
  for (int d0 = 0; d0 < 4; ++d0) { const int cb = (d0 * 16 + hi * 8) * 2;
    bf16x8 b0 = *reinterpret_cast<const bf16x8*>(Ks + KSWZ64(r32, cb));
    bf16x8 b1 = *reinterpret_cast<const bf16x8*>(Ks + KSWZ64(32 + r32, cb));
    p0 = __builtin_amdgcn_mfma_f32_32x32x16_bf16(b0, qr[d0], p0, 0, 0, 0);
    p1 = __builtin_amdgcn_mfma_f32_32x32x16_bf16(b1, qr[d0], p1, 0, 0, 0); }
}
__device__ __forceinline__ int v_st(int k, int c) { const int kk = (k & ~0xC) | ((k & 4) << 1) | ((k & 8) >> 1); return ((kk >> 3) * 4 + (c >> 5)) * 512 + ((kk & 7) * 32 + (c & 31)) * 2; }
__device__ __forceinline__ int v_rd_base(int lane) { return ((lane & 3) << 3) | (((lane >> 2) & 3) << 6) | (((lane >> 4) & 1) << 5) | (((lane >> 5) & 1) << 8); }
constexpr int v_rd_off(int d0, int ks, int half) { return d0 * 512 + ks * 4096 + half * 2048; }
template <int OFF> __device__ __forceinline__ s16x4 tr_read(int vb) {
  s16x4 r; asm volatile("ds_read_b64_tr_b16 %0, %1 offset:%2" : "=&v"(r) : "v"(vb), "i"(OFF) : "memory"); return r;
}
template <int I> __device__ __forceinline__ void pv_rd(s16x4& L, s16x4& H, int vb) { L = tr_read<v_rd_off(I >> 2, I & 3, 0)>(vb); H = tr_read<v_rd_off(I >> 2, I & 3, 1)>(vb); }
template <int N> __device__ __forceinline__ void pv_wait(s16x4& L, s16x4& H) { asm volatile("s_waitcnt lgkmcnt(%2)" : "+v"(L), "+v"(H) : "i"(N) : "memory"); }
__device__ __forceinline__ void pv_d0(f32x16* o, int vb, bf16x8 pa0, bf16x8 pa1, bf16x8 pa2, bf16x8 pa3) {
  s16x4 L0, H0, L1, H1, L2, H2, L3, H3;
#define PK(L, H) (bf16x8){L[0], L[1], L[2], L[3], H[0], H[1], H[2], H[3]}
#define PVM(I, PA, L, H, CNT) do { pv_wait<CNT>(L, H); o[(I) >> 2] = __builtin_amdgcn_mfma_f32_32x32x16_bf16(PA, PK(L, H), o[(I) >> 2], 0, 0, 0); } while (0)
  pv_rd<0>(L0, H0, vb); pv_rd<1>(L1, H1, vb); pv_rd<2>(L2, H2, vb);
  PVM(0, pa0, L0, H0, 4);  pv_rd<3>(L3, H3, vb);
  PVM(1, pa1, L1, H1, 4);  pv_rd<4>(L0, H0, vb);
  PVM(2, pa2, L2, H2, 4);  pv_rd<5>(L1, H1, vb);
  PVM(3, pa3, L3, H3, 4);  pv_rd<6>(L2, H2, vb);
  PVM(4, pa0, L0, H0, 4);  pv_rd<7>(L3, H3, vb);
  PVM(5, pa1, L1, H1, 4);  pv_rd<8>(L0, H0, vb);
  PVM(6, pa2, L2, H2, 4);  pv_rd<9>(L1, H1, vb);
  PVM(7, pa3, L3, H3, 4);  pv_rd<10>(L2, H2, vb);
  PVM(8, pa0, L0, H0, 4);  pv_rd<11>(L3, H3, vb);
  PVM(9, pa1, L1, H1, 4);  pv_rd<12>(L0, H0, vb);
  PVM(10, pa2, L2, H2, 4); pv_rd<13>(L1, H1, vb);
  PVM(11, pa3, L3, H3, 4); pv_rd<14>(L2, H2, vb);
  PVM(12, pa0, L0, H0, 4); pv_rd<15>(L3, H3, vb);
  PVM(13, pa1, L1, H1, 4);
  PVM(14, pa2, L2, H2, 2);
  PVM(15, pa3, L3, H3, 0);
#undef PVM
#undef PK
}
constexpr int NSLOT = 4, NVSLOT = 5, KSLOT = 8192, VSLOT = 16384, LDS_K = 0, LDS_V = NSLOT * KSLOT, LDS_WS = LDS_V + NVSLOT * VSLOT, LDS_END = LDS_WS + NWAVES * 64 * 4;
static_assert(LDS_END <= RING_BYTES, "attention LDS");
constexpr float THR2 = 8.f;
__device__ __forceinline__ void glds16(const void* sbase, unsigned voff, unsigned lds_dst) { unsigned keep;
  asm volatile("s_mov_b32 %0, m0\n\ts_mov_b32 m0, %3\n\ts_nop 2\n\tglobal_load_lds_dwordx4 %1, %2\n\ts_mov_b32 m0, %0" : "=&s"(keep) : "v"(voff), "s"(sbase), "s"(lds_dst) : "memory"); }
#define WAIT_BAR(N) asm volatile("s_waitcnt vmcnt(" #N ") lgkmcnt(0)\n\ts_barrier" ::: "memory")
__device__ __forceinline__ float rowmax32(const f32x16& p0, const f32x16& p1) {
  float a = fmaxf(fmaxf(p0[0], p0[1]), p1[0]), b = fmaxf(fmaxf(p0[2], p0[3]), p1[1]); a = fmaxf(fmaxf(a, p1[2]), p1[3]);
#pragma unroll
  for (int r = 4; r < 16; r += 4) { a = fmaxf(fmaxf(a, p0[r]), p0[r + 1]); b = fmaxf(fmaxf(b, p0[r + 2]), p0[r + 3]); a = fmaxf(fmaxf(a, p1[r]), p1[r + 1]); b = fmaxf(fmaxf(b, p1[r + 2]), p1[r + 3]); }
  float m = fmaxf(a, b);
  auto rr = __builtin_amdgcn_permlane32_swap(__float_as_uint(m), __float_as_uint(m), false, false);
  return fmaxf(__uint_as_float(rr[0]), __uint_as_float(rr[1]));
}
template <bool FIRST> __device__ __forceinline__ void partialSM2(f32x16& p0, f32x16& p1, float& m_reg, f32x16& negm, float& alpha) {
  const float pmax = rowmax32(p0, p1);
  if (FIRST || !__builtin_expect(__all(pmax <= THR2), 1)) {
    const float dl = FIRST ? pmax : fmaxf(pmax, 0.f); m_reg += dl;
#pragma unroll
    for (int r = 0; r < 16; ++r) { p0[r] -= dl; p1[r] -= dl; }
#pragma unroll
    for (int r = 0; r < 16; ++r) negm[r] = -m_reg;
    alpha = FIRST ? 1.f : __builtin_amdgcn_exp2f(-dl);
  } else alpha = 1.f;
#pragma unroll
  for (int r = 0; r < 16; ++r) p0[r] = __builtin_amdgcn_exp2f(p0[r]);
}
__device__ __forceinline__ void qkt2(f32x16& p0, f32x16& p1, const char* Ks, const bf16x8* qr, const f32x16& negm, int r32, int hi) {
#pragma unroll
  for (int d0 = 0; d0 < 4; ++d0) { const int cb = (d0 * 16 + hi * 8) * 2;
    bf16x8 b0 = *reinterpret_cast<const bf16x8*>(Ks + KSWZ64(r32, cb));
    bf16x8 b1 = *reinterpret_cast<const bf16x8*>(Ks + KSWZ64(32 + r32, cb));
    if (d0 == 0) { p0 = __builtin_amdgcn_mfma_f32_32x32x16_bf16(b0, qr[0], negm, 0, 0, 0); p1 = __builtin_amdgcn_mfma_f32_32x32x16_bf16(b1, qr[0], negm, 0, 0, 0); }
    else { p0 = __builtin_amdgcn_mfma_f32_32x32x16_bf16(b0, qr[d0], p0, 0, 0, 0); p1 = __builtin_amdgcn_mfma_f32_32x32x16_bf16(b1, qr[d0], p1, 0, 0, 0); } }
}
__device__ __forceinline__ int swap23(int k) { return (k & ~0xC) | ((k & 4) << 1) | ((k & 8) >> 1); }
__device__ __forceinline__ void attn_body(const bf16_t* __restrict__ Qb, const bf16_t* __restrict__ Kh, const bf16_t* __restrict__ Vh, bf16_t* __restrict__ Ob, int seq, char* lds) {
  const int tid = opaque_tid(), wid = __builtin_amdgcn_readfirstlane(tid >> 6), lane = tid & 63, r32 = lane & 31, hi = lane >> 5;
  const unsigned lds0 = (unsigned)(uintptr_t)lds;
  const char* K_lds = lds + LDS_K;
  float* ws = (float*)(lds + LDS_WS) + wid * 64; float* li_l = ws; float* al_l = ws + 32;
  float m_reg = 0.f, l_reg = 0.f; f32x16 o[4] = {}; bf16x8 qr[4]; f32x16 negm = {};
  const bf16_t* Qw = Qb + (long)(wid * QBLK + r32) * LDX + hi * 8;
#pragma unroll
  for (int d0 = 0; d0 < 4; ++d0) qr[d0] = *reinterpret_cast<const bf16x8*>(Qw + d0 * 16);
  const int rowK = tid >> 3, cK = (tid & 7) ^ ((rowK >> 1) & 7);
  const unsigned ksrc = (unsigned)(rowK * LDX + cK * 8) * 2u;
  const int U0 = tid, U1 = 512 + tid;
  const int sub0 = U0 >> 5, sub1 = U1 >> 5;
  const unsigned vsrc0 = (unsigned)(((sub0 >> 2) * 8 + ((U0 >> 2) & 7)) * LDX + (sub0 & 3) * 32 + (U0 & 3) * 8) * 2u;
  const unsigned vsrc1 = (unsigned)(((sub1 >> 2) * 8 + ((U1 >> 2) & 7)) * LDX + (sub1 & 3) * 32 + (U1 & 3) * 8) * 2u;
  const unsigned kdst = lds0 + LDS_K + wid * 1024, vdst = lds0 + LDS_V + wid * 1024;
#define DMA(t) do { const unsigned sl_ = (unsigned)((t) & 3), sv_ = (unsigned)((t) % NVSLOT); const long go_ = (long)(t) * KVBLK * LDX; \
    glds16(Kh + go_, ksrc, (unsigned)__builtin_amdgcn_readfirstlane(kdst + sl_ * KSLOT)); glds16(Vh + go_, vsrc0, (unsigned)__builtin_amdgcn_readfirstlane(vdst + sv_ * VSLOT)); \
    glds16(Vh + go_, vsrc1, (unsigned)__builtin_amdgcn_readfirstlane(vdst + sv_ * VSLOT + 8192)); } while (0)
#define RESC(a) do { if (__any((a) < 1.f)) { if (hi == 0) al_l[r32] = (a); asm volatile("s_waitcnt lgkmcnt(0)" ::: "memory"); \
    _Pragma("unroll") for (int d = 0; d < 4; ++d) _Pragma("unroll") for (int r = 0; r < 16; ++r) o[d][r] *= al_l[crow(r, hi)]; } } while (0)
  const int vb0 = (int)(lds0 + LDS_V) + v_rd_base(lane);
  f32x16 pA0, pA1, pB0, pB1; float alA, alB; bf16x8 pa0, pa1, pa2, pa3; const int NT = seq / KVBLK;
  asm volatile("s_waitcnt vmcnt(0)" ::: "memory");
  if (wid < 4) __builtin_amdgcn_s_setprio(3);
  DMA(0); DMA(1);
  WAIT_BAR(3);
  DMA(2);
#define VSL(t) ((int)((t) % NVSLOT) * VSLOT)
  if (wid < 4) {
    qkt2(pA0, pA1, K_lds, qr, negm, r32, hi); partialSM2<true>(pA0, pA1, m_reg, negm, alA);
#define STEP(C0, C1, alC, P0, P1, alP, jj, WN) do { WAIT_BAR(WN); if ((jj) + 2 < NT) DMA((jj) + 2); \
      SBAR(); qkt2(C0, C1, K_lds + ((jj) & 3) * KSLOT, qr, negm, r32, hi); finishSM(P0, P1, alP, l_reg, pa0, pa1, pa2, pa3); SBAR(); \
      pv_d0(o, vb0 + VSL((jj) - 1), pa0, pa1, pa2, pa3); partialSM2<false>(C0, C1, m_reg, negm, alC); RESC(alC); } while (0)
    int j = 1;
    for (; j + 1 < NT; j += 2) { STEP(pB0, pB1, alB, pA0, pA1, alA, j, 3); STEP(pA0, pA1, alA, pB0, pB1, alB, j + 1, 3); }
    STEP(pB0, pB1, alB, pA0, pA1, alA, NT - 1, 0);
#undef STEP
  } else {
    qkt2(pA0, pA1, K_lds, qr, negm, r32, hi);
    WAIT_BAR(3); if (3 < NT) DMA(3);
    partialSM2<true>(pA0, pA1, m_reg, negm, alA);
    SBAR(); qkt2(pB0, pB1, K_lds + KSLOT, qr, negm, r32, hi); finishSM(pA0, pA1, alA, l_reg, pa0, pa1, pa2, pa3); SBAR();
#define STEPL(C0, C1, P0, P1, alP, jj, WN) do { WAIT_BAR(WN); if ((jj) + 2 < NT) DMA((jj) + 2); \
      pv_d0(o, vb0 + VSL((jj) - 2), pa0, pa1, pa2, pa3); partialSM2<false>(P0, P1, m_reg, negm, alP); RESC(alP); \
      SBAR(); qkt2(C0, C1, K_lds + ((jj) & 3) * KSLOT, qr, negm, r32, hi); finishSM(P0, P1, alP, l_reg, pa0, pa1, pa2, pa3); SBAR(); } while (0)
    int j = 2;
    for (; j + 2 < NT; j += 2) { STEPL(pA0, pA1, pB0, pB1, alB, j, 3); STEPL(pB0, pB1, pA0, pA1, alA, j + 1, 3); }
    STEPL(pA0, pA1, pB0, pB1, alB, NT - 2, 3); STEPL(pB0, pB1, pA0, pA1, alA, NT - 1, 0);
#undef STEPL
    pv_d0(o, vb0 + VSL(NT - 2), pa0, pa1, pa2, pa3); partialSM2<false>(pB0, pB1, m_reg, negm, alB); RESC(alB);
  }
  finishSM(pB0, pB1, alB, l_reg, pa0, pa1, pa2, pa3); SBAR();
  pv_d0(o, vb0 + VSL(NT - 1), pa0, pa1, pa2, pa3);
#undef VSL
  if (hi == 0) li_l[r32] = l_reg; asm volatile("s_waitcnt lgkmcnt(0)" ::: "memory");
  float rli[16];
#pragma unroll
  for (int r = 0; r < 16; ++r) rli[r] = __builtin_amdgcn_rcpf(li_l[crow(r, hi)]);
  bf16_t* Ow = Ob + (long)(wid * QBLK) * 2048;
#pragma unroll
  for (int r = 0; r < 16; ++r) { const int orow = crow(r, hi);
#pragma unroll
    for (int d0 = 0; d0 < 4; ++d0) Ow[(long)orow * 2048 + d0 * 32 + r32] = (bf16_t)f2bf(o[d0][r] * rli[r]); }
  __builtin_amdgcn_s_setprio(0);
  asm volatile("s_waitcnt lgkmcnt(0)\n\ts_barrier" ::: "memory");
#undef DMA
#undef RESC
#undef STEP
}
#undef WAIT_BAR
#undef SBAR
}

__device__ __forceinline__ int pos_f(int jb) { return jb < 256 ? 4 + jb : jb - 256; }
__device__ __forceinline__ int pos_b(int jb) { return jb < 256 ? 4 + 255 - jb : 3 - (jb - 256); }
constexpr int KP = 72;
constexpr int QP = 136;
__device__ __forceinline__ bf16x8 lds_frag(const LAS unsigned char* base, int row, int pitch, int col) { return *(const LAS bf16x8*)(base + ((size_t)row * pitch + col) * 2); }

__device__ __forceinline__ void conv_silu8(u32x4 xm, u32x4 x0, u32x4 xp, const float* cw  , float scale, float (&o)[8]) {
    const f32x4 w0a = *(const f32x4*)(cw), w0b = *(const f32x4*)(cw + 4), w1a = *(const f32x4*)(cw + 1024), w1b = *(const f32x4*)(cw + 1028), w2a = *(const f32x4*)(cw + 2048), w2b = *(const f32x4*)(cw + 2052);
    const float w0[8] = {w0a.x, w0a.y, w0a.z, w0a.w, w0b.x, w0b.y, w0b.z, w0b.w}, w1[8] = {w1a.x, w1a.y, w1a.z, w1a.w, w1b.x, w1b.y, w1b.z, w1b.w}, w2[8] = {w2a.x, w2a.y, w2a.z, w2a.w, w2b.x, w2b.y, w2b.z, w2b.w};
    const unsigned am[4] = {xm.x, xm.y, xm.z, xm.w}, a0[4] = {x0.x, x0.y, x0.z, x0.w}, ap[4] = {xp.x, xp.y, xp.z, xp.w};
#pragma unroll
    for (int e = 0; e < 8; ++e) { const unsigned sh = (e & 1) * 16;
        const float vm = bf2f((am[e >> 1] >> sh) & 0xffffu), v0 = bf2f((a0[e >> 1] >> sh) & 0xffffu), vp = bf2f((ap[e >> 1] >> sh) & 0xffffu);
        o[e] = siluf_(vm * w0[e] + v0 * w1[e] + vp * w2[e]) * scale; }
}

struct MlstmArgs { const bf16_t* QKM; const bf16_t* VM; const bf16_t* OMS; const float* GATES; const float* conv; const float* norm_m; const unsigned* mstab;
                   bf16_t* ST; float* NU; float* ADEC; bf16_t* HM; unsigned char* U8; };
constexpr float U8_SCALE = 256.f, C8_SCALE = 64.f;
constexpr float U8_SCALE_UNUSED_ = 0.f;

__device__ __forceinline__ void mlstm_gates(const MlstmArgs& A, int bh, int row0, int lane, float& bfv, float& bbv, float& ifm, float& ibm, float& bend_f, float& bend_b) {
    const f32x4 g0 = *(const f32x4*)(A.GATES + (size_t)(row0 + lane) * 16), g1 = *(const f32x4*)(A.GATES + (size_t)(row0 + lane) * 16 + 4),
                g2 = *(const f32x4*)(A.GATES + (size_t)(row0 + lane) * 16 + 8), g3 = *(const f32x4*)(A.GATES + (size_t)(row0 + lane) * 16 + 12);
    const int h = bh & 3;
    const float i_f = h == 0 ? g0.x : h == 1 ? g0.y : h == 2 ? g0.z : g0.w, f_f = h == 0 ? g1.x : h == 1 ? g1.y : h == 2 ? g1.z : g1.w;
    const float i_b = h == 0 ? g2.x : h == 1 ? g2.y : h == 2 ? g2.z : g2.w, f_b = h == 0 ? g3.x : h == 1 ? g3.y : h == 2 ? g3.z : g3.w;
    float inc = logsigf_(f_f), suf = logsigf_(f_b);
#pragma unroll
    for (int o = 1; o < 64; o <<= 1) { const float t = __shfl_up(inc, o); if (lane >= o) inc += t; }
#pragma unroll
    for (int o = 1; o < 64; o <<= 1) { const float t = __shfl_down(suf, o); if (lane + o < 64) suf += t; }
    bend_f = __shfl(inc, 63); bend_b = __shfl(suf, 0);
    const float Mf = __uint_as_float(__hip_atomic_load(A.mstab + bh * 2 + 0, RLX_AGENT)), Mb = __uint_as_float(__hip_atomic_load(A.mstab + bh * 2 + 1, RLX_AGENT));
    bfv = inc; bbv = suf; ifm = i_f - Mf; ibm = i_b - Mb;
}
__device__ __forceinline__ void mlstm_stage_vt(const MlstmArgs& A, int h, int row0, LAS unsigned char* VT, int tid) {
#pragma unroll
    for (int i = 0; i < 4; ++i) { const int p = tid + 512 * i, s = p & 63, ec = p >> 6;
        const u32x4 v = *(const u32x4*)(A.VM + (size_t)(row0 + s) * 1024 + h * 256 + ec * 8);
        const unsigned a[4] = {v.x, v.y, v.z, v.w};
#pragma unroll
        for (int e = 0; e < 8; ++e) *(LAS bf16_t*)(VT + ((size_t)(ec * 8 + e) * KP + s) * 2) = (bf16_t)((a[e >> 1] >> ((e & 1) * 16)) & 0xffffu); }
}
__device__ __forceinline__ void mlstm_load3(const bf16_t* QKM, int row0, int s, int ch, bool hasL, bool hasR, u32x4& xm, u32x4& x0, u32x4& xp) {
    const bf16_t* p = QKM + (size_t)(row0 + s) * 1024 + ch;
    x0 = *(const u32x4*)p;
    xm = (s > 0 || hasL) ? *(const u32x4*)(p - 1024) : (u32x4){0u, 0u, 0u, 0u};
    xp = (s < 63 || hasR) ? *(const u32x4*)(p + 1024) : (u32x4){0u, 0u, 0u, 0u};
}

__device__ __forceinline__ void mlstm_d1_unit(const MlstmArgs& A, int bh, int jb, LAS unsigned char* lds) {
    const int tid = opaque_tid(), lane = tid & 63, wave = __builtin_amdgcn_readfirstlane(tid >> 6), fr = lane & 15, fq = lane >> 4;
    const int b = bh >> 2, h = bh & 3, row0 = b * TPB + jb * 64;
    const bool hasL = !(jb == 0 || jb == 256), hasR = !(jb == 255 || jb == 259);
    LAS float* WF = (LAS float*)lds; LAS float* WB = WF + 64;
    LAS unsigned char* KF = lds + 512; LAS unsigned char* KB = KF + 128 * KP * 2; LAS unsigned char* VT = KB + 128 * KP * 2;
    const int cf = bh * 2, cb = bh * 2 + 1, pf = pos_f(jb), pb = pos_b(jb);
    u32x4 xm_[2], x0_[2], xp_[2];
#pragma unroll
    for (int i = 0; i < 2; ++i) { const int p = tid + 512 * i, s = p & 63, dc = p >> 6; mlstm_load3(A.QKM, row0, s, 512 + h * 128 + dc * 8, hasL, hasR, xm_[i], x0_[i], xp_[i]); }
    mlstm_stage_vt(A, h, row0, VT, tid);
    if (wave == 0) {
        float bfv, bbv, ifm, ibm, bend_f, bend_b; mlstm_gates(A, bh, row0, lane, bfv, bbv, ifm, ibm, bend_f, bend_b);
        WF[lane] = __expf(bend_f - bfv + ifm); WB[lane] = __expf(bend_b - bbv + ibm);
        if (lane == 0) { st_wt(A.ADEC + cf * NCHUNK + pf, __expf(bend_f)); st_wt(A.ADEC + cb * NCHUNK + pb, __expf(bend_b)); }
    }
    __syncthreads();
#pragma unroll
    for (int i = 0; i < 2; ++i) { const int p = tid + 512 * i, s = p & 63, dc = p >> 6; const int ch = 512 + h * 128 + dc * 8;
        const u32x4 xm = xm_[i], x0 = x0_[i], xp = xp_[i];
        float k[8]; conv_silu8(xm, x0, xp, A.conv + ch, 0.08838834764831845f, k);
        const float wf = WF[s], wb = WB[s];
#pragma unroll
        for (int e = 0; e < 8; ++e) { *(LAS bf16_t*)(KF + ((size_t)(dc * 8 + e) * KP + s) * 2) = (bf16_t)f2bf(k[e] * wf); *(LAS bf16_t*)(KB + ((size_t)(dc * 8 + e) * KP + s) * 2) = (bf16_t)f2bf(k[e] * wb); } }
    __syncthreads();
    if (tid < 256) { const int dir = tid >> 7, d = tid & 127; const LAS unsigned char* src = (dir ? KB : KF) + (size_t)d * KP * 2; float s = 0.f;
#pragma unroll 8
        for (int i = 0; i < 64; ++i) s += bf2f(*(const LAS bf16_t*)(src + i * 2));
        A.NU[((size_t)(dir ? cb : cf) * NCHUNK + (dir ? pb : pf)) * 128 + d] = s; }
#pragma unroll
    for (int dir = 0; dir < 2; ++dir) {
        const LAS unsigned char* KW = dir ? KB : KF;
        f32x4 acc[8][2];
#pragma unroll
        for (int m = 0; m < 8; ++m) { acc[m][0] = (f32x4){0.f, 0.f, 0.f, 0.f}; acc[m][1] = (f32x4){0.f, 0.f, 0.f, 0.f}; }
#pragma unroll
        for (int ks = 0; ks < 2; ++ks) {
            const bf16x8 b0 = lds_frag(VT, (2 * wave) * 16 + fr, KP, ks * 32 + fq * 8), b1 = lds_frag(VT, (2 * wave + 1) * 16 + fr, KP, ks * 32 + fq * 8);
#pragma unroll
            for (int m = 0; m < 8; ++m) { const bf16x8 a = lds_frag(KW, m * 16 + fr, KP, ks * 32 + fq * 8);
                acc[m][0] = __builtin_amdgcn_mfma_f32_16x16x32_bf16(a, b0, acc[m][0], 0, 0, 0); acc[m][1] = __builtin_amdgcn_mfma_f32_16x16x32_bf16(a, b1, acc[m][1], 0, 0, 0); } }
        unsigned char* dst8 = A.U8 + ((size_t)(dir ? cb : cf) * NCHUNK + (dir ? pb : pf)) * 32768;
#pragma unroll
        for (int m = 0; m < 8; ++m)
#pragma unroll
            for (int n = 0; n < 2; ++n) { const int e = (2 * wave + n) * 16 + fr, d0 = m * 16 + fq * 4; *(unsigned*)(dst8 + (size_t)e * 128 + d0) = pk4_fp8(acc[m][n] * U8_SCALE); }
    }
    __syncthreads();
}

__device__ __forceinline__ void mlstm_scan(const MlstmArgs& A, int gtid, int nthreads, bf16_t* dryST = nullptr, float* dryNU = nullptr) {
    constexpr int PF = 20;
    for (int it = gtid; it < NCHAIN * 8192; it += nthreads) {
        const int chain = it >> 13, e4 = (it & 8191) * 4; bf16_t* __restrict__ p = A.ST + (size_t)chain * NCHUNK * 32768 + e4; const float* __restrict__ ad = A.ADEC + chain * NCHUNK; const unsigned char* q8 = A.U8 + (size_t)chain * NCHUNK * 32768 + e4; unsigned char* w8 = A.U8 + (size_t)chain * NCHUNK * 32768 + e4;
        f32x4 s = (f32x4){0.f, 0.f, 0.f, 0.f};
        for (int c0 = 0; c0 < NCHUNK; c0 += PF) {
            unsigned u[PF]; float a[PF];
#pragma unroll
            for (int i = 0; i < PF; ++i) { u[i] = __builtin_nontemporal_load((const unsigned*)(q8 + (size_t)(c0 + i) * 32768)); a[i] = ad[c0 + i]; }
#pragma unroll
            for (int i = 0; i < PF; ++i) { if (dryST) *(u32x2*)(dryST + (p - A.ST) + (size_t)(c0 + i) * 32768) = pk4(s); else *(unsigned*)(w8 + (size_t)(c0 + i) * 32768) = pk4_fp8(s * C8_SCALE); s = s * a[i] + unpk4_fp8(u[i]) * (1.f / U8_SCALE); }
        }
    }
    for (int it = gtid; it < NCHAIN * 128; it += nthreads) {
        const int chain = it >> 7, d = it & 127; float* __restrict__ p = A.NU + (size_t)chain * NCHUNK * 128 + d; const float* __restrict__ ad = A.ADEC + chain * NCHUNK; float s = 0.f;
        for (int c0 = 0; c0 < NCHUNK; c0 += PF) {
            float u[PF], a[PF];
#pragma unroll
            for (int i = 0; i < PF; ++i) { u[i] = p[(c0 + i) * 128]; a[i] = ad[c0 + i]; }
#pragma unroll
            for (int i = 0; i < PF; ++i) { (dryNU ? dryNU + (p - A.NU) : p)[(c0 + i) * 128] = s; s = s * a[i] + u[i]; }
        }
    }
}

constexpr int D3_G = 0, D3_Q = 4096, D3_QF = D3_Q + 64 * QP * 2, D3_QB = D3_QF + 64 * QP * 2, D3_KT = D3_QB + 64 * QP * 2, D3_VT = D3_KT + 64 * QP * 2, D3_PF = D3_VT + 256 * KP * 2, D3_PB = D3_PF + 64 * KP * 2, D3_END = D3_PB + 64 * KP * 2;
static_assert(D3_END + 1024 <= RING_BYTES, "mLSTM D3 LDS");
__device__ __forceinline__ void mlstm_d3_unit(const MlstmArgs& A, int bh, int jb, LAS unsigned char* lds) {
    const int tid = opaque_tid(), lane = tid & 63, wave = __builtin_amdgcn_readfirstlane(tid >> 6), fr = lane & 15, fq = lane >> 4;
    const int b = bh >> 2, h = bh & 3, row0 = b * TPB + jb * 64;
    const bool hasL = !(jb == 0 || jb == 256), hasR = !(jb == 255 || jb == 259);
    LAS float* GF = (LAS float*)(lds + D3_G);
    LAS float* BF = GF, *BB = GF + 64, *IFM = GF + 128, *IBM = GF + 192, *EBF = GF + 256, *EBB = GF + 320, *DEN = GF + 384, *RS = GF + 512;
    LAS float* NPV = (LAS float*)(lds + D3_END);
    LAS unsigned char* Qs = lds + D3_Q; LAS unsigned char* QF = lds + D3_QF; LAS unsigned char* QB = lds + D3_QB; LAS unsigned char* KT = lds + D3_KT;
    LAS unsigned char* VT = lds + D3_VT; LAS unsigned char* PF = lds + D3_PF; LAS unsigned char* PB = lds + D3_PB;
    const int cf = bh * 2, cb = bh * 2 + 1, pf = pos_f(jb), pb = pos_b(jb);
    const float Mf = __uint_as_float(__hip_atomic_load(A.mstab + bh * 2 + 0, RLX_AGENT)), Mb = __uint_as_float(__hip_atomic_load(A.mstab + bh * 2 + 1, RLX_AGENT));
    u32x4 xm_[4], x0_[4], xp_[4];
#pragma unroll
    for (int i = 0; i < 4; ++i) { const int p = tid + 512 * i, dc = p & 15, s = (p >> 4) & 63, isk = p >> 10; mlstm_load3(A.QKM, row0, s, isk * 512 + h * 128 + dc * 8, hasL, hasR, xm_[i], x0_[i], xp_[i]); }
    mlstm_stage_vt(A, h, row0, VT, tid);
    if (wave == 0) {
        float bfv, bbv, ifm, ibm, bend_f, bend_b; mlstm_gates(A, bh, row0, lane, bfv, bbv, ifm, ibm, bend_f, bend_b);
        BF[lane] = bfv; BB[lane] = bbv; IFM[lane] = ifm; IBM[lane] = ibm; EBF[lane] = __expf(bfv); EBB[lane] = __expf(bbv);
    } else if (tid >= 256) { const int dir = (tid >> 7) & 1, d = tid & 127; NPV[dir * 128 + d] = A.NU[((size_t)(dir ? cb : cf) * NCHUNK + (dir ? pb : pf)) * 128 + d]; }
    __syncthreads();
#pragma unroll
    for (int i = 0; i < 4; ++i) { const int p = tid + 512 * i, dc = p & 15, s = (p >> 4) & 63, isk = p >> 10; const int ch = isk * 512 + h * 128 + dc * 8;
        const u32x4 xm = xm_[i], x0 = x0_[i], xp = xp_[i];
        float v[8]; conv_silu8(xm, x0, xp, A.conv + ch, isk ? 0.08838834764831845f : 1.f, v);
        if (isk) { u32x4 w; w.x = pk2(v[0], v[1]); w.y = pk2(v[2], v[3]); w.z = pk2(v[4], v[5]); w.w = pk2(v[6], v[7]); *(LAS u32x4*)(KT + ((size_t)s * QP + dc * 8) * 2) = w; }
        else { const float ef = EBF[s], eb = EBB[s]; u32x4 w;
            w.x = pk2(v[0], v[1]); w.y = pk2(v[2], v[3]); w.z = pk2(v[4], v[5]); w.w = pk2(v[6], v[7]); *(LAS u32x4*)(Qs + ((size_t)s * QP + dc * 8) * 2) = w;
            w.x = pk2(v[0] * ef, v[1] * ef); w.y = pk2(v[2] * ef, v[3] * ef); w.z = pk2(v[4] * ef, v[5] * ef); w.w = pk2(v[6] * ef, v[7] * ef); *(LAS u32x4*)(QF + ((size_t)s * QP + dc * 8) * 2) = w;
            w.x = pk2(v[0] * eb, v[1] * eb); w.y = pk2(v[2] * eb, v[3] * eb); w.z = pk2(v[4] * eb, v[5] * eb); w.w = pk2(v[6] * eb, v[7] * eb); *(LAS u32x4*)(QB + ((size_t)s * QP + dc * 8) * 2) = w; } }
    __syncthreads();
    {
        const int mt = wave >> 1, nt0 = (wave & 1) * 2;
        f32x4 S0 = (f32x4){0.f, 0.f, 0.f, 0.f}, S1 = S0;
#pragma unroll
        for (int ks = 0; ks < 4; ++ks) { const bf16x8 a = lds_frag(Qs, mt * 16 + fr, QP, ks * 32 + fq * 8);
            S0 = __builtin_amdgcn_mfma_f32_16x16x32_bf16(a, lds_frag(KT, nt0 * 16 + fr, QP, ks * 32 + fq * 8), S0, 0, 0, 0);
            S1 = __builtin_amdgcn_mfma_f32_16x16x32_bf16(a, lds_frag(KT, (nt0 + 1) * 16 + fr, QP, ks * 32 + fq * 8), S1, 0, 0, 0); }
#pragma unroll
        for (int n = 0; n < 2; ++n) { const int s = (nt0 + n) * 16 + fr; const float bfs = BF[s], bbs = BB[s], ifs = IFM[s], ibs = IBM[s];
#pragma unroll
            for (int r = 0; r < 4; ++r) { const int t = mt * 16 + fq * 4 + r; const float sv = n ? S1[r] : S0[r];
                const float pf_ = (s <= t) ? sv * __expf(BF[t] - bfs + ifs) : 0.f, pb_ = (s >= t) ? sv * __expf(BB[t] - bbs + ibs) : 0.f;
                *(LAS bf16_t*)(PF + ((size_t)t * KP + s) * 2) = (bf16_t)f2bf(pf_); *(LAS bf16_t*)(PB + ((size_t)t * KP + s) * 2) = (bf16_t)f2bf(pb_); } }
    }
    __syncthreads();
    {
        const int t = tid >> 3, part = tid & 7;
        const u32x4 pfv = *(const LAS u32x4*)(PF + ((size_t)t * KP + part * 8) * 2), pbv = *(const LAS u32x4*)(PB + ((size_t)t * KP + part * 8) * 2);
        const u32x4 q0v = *(const LAS u32x4*)(Qs + ((size_t)t * QP + part * 16) * 2), q1v = *(const LAS u32x4*)(Qs + ((size_t)t * QP + part * 16 + 8) * 2);
        const unsigned pw[4] = {pfv.x, pfv.y, pfv.z, pfv.w}, pwb[4] = {pbv.x, pbv.y, pbv.z, pbv.w}, qw[8] = {q0v.x, q0v.y, q0v.z, q0v.w, q1v.x, q1v.y, q1v.z, q1v.w};
        float sf = 0.f, sb = 0.f, dqf = 0.f, dqb = 0.f;
#pragma unroll
        for (int i = 0; i < 4; ++i) { sf += bf2f(pw[i] & 0xffffu) + bf2f(pw[i] >> 16); sb += bf2f(pwb[i] & 0xffffu) + bf2f(pwb[i] >> 16); }
#pragma unroll
        for (int i = 0; i < 8; ++i) { const float qa = bf2f(qw[i] & 0xffffu), qb2 = bf2f(qw[i] >> 16); const int d = part * 16 + 2 * i;
            dqf += qa * NPV[d] + qb2 * NPV[d + 1]; dqb += qa * NPV[128 + d] + qb2 * NPV[128 + d + 1]; }
#pragma unroll
        for (int o = 1; o < 8; o <<= 1) { sf += __shfl_xor(sf, o); sb += __shfl_xor(sb, o); dqf += __shfl_xor(dqf, o); dqb += __shfl_xor(dqb, o); }
        if (part == 0) { DEN[t] = fmaxf(fabsf(sf + EBF[t] * dqf), __expf(-Mf)); DEN[64 + t] = fmaxf(fabsf(sb + EBB[t] * dqb), __expf(-Mb)); }
    }
    f32x4 acc[2][2][4];
#pragma unroll
    for (int dir = 0; dir < 2; ++dir) {
        const LAS unsigned char* P = dir ? PB : PF; const LAS unsigned char* QD = dir ? QB : QF;
        const unsigned char* CT = A.U8 + ((size_t)(dir ? cb : cf) * NCHUNK + (dir ? pb : pf)) * 32768;
#pragma unroll
        for (int m = 0; m < 2; ++m)
#pragma unroll
            for (int n = 0; n < 4; ++n) acc[dir][m][n] = (f32x4){0.f, 0.f, 0.f, 0.f};
#pragma unroll
        for (int ks = 0; ks < 2; ++ks) {
            const bf16x8 a0 = lds_frag(VT, (2 * wave) * 16 + fr, KP, ks * 32 + fq * 8), a1 = lds_frag(VT, (2 * wave + 1) * 16 + fr, KP, ks * 32 + fq * 8);
#pragma unroll
            for (int n = 0; n < 4; ++n) { const bf16x8 bq = lds_frag(P, n * 16 + fr, KP, ks * 32 + fq * 8);
                acc[dir][0][n] = __builtin_amdgcn_mfma_f32_16x16x32_bf16(a0, bq, acc[dir][0][n], 0, 0, 0); acc[dir][1][n] = __builtin_amdgcn_mfma_f32_16x16x32_bf16(a1, bq, acc[dir][1][n], 0, 0, 0); } }
#pragma unroll
        for (int ks = 0; ks < 4; ++ks) {
            const u32x2 c0_ = *(const u32x2*)(CT + (size_t)((2 * wave) * 16 + fr) * 128 + ks * 32 + fq * 8), c1_ = *(const u32x2*)(CT + (size_t)((2 * wave + 1) * 16 + fr) * 128 + ks * 32 + fq * 8);
            const u32x2 l0_ = pk4(unpk4_fp8(c0_.x) * (1.f / C8_SCALE)), h0_ = pk4(unpk4_fp8(c0_.y) * (1.f / C8_SCALE)), l1_ = pk4(unpk4_fp8(c1_.x) * (1.f / C8_SCALE)), h1_ = pk4(unpk4_fp8(c1_.y) * (1.f / C8_SCALE));
            const u32x4 w0_ = {l0_.x, l0_.y, h0_.x, h0_.y}, w1_ = {l1_.x, l1_.y, h1_.x, h1_.y};
            const bf16x8 a0 = *reinterpret_cast<const bf16x8*>(&w0_), a1 = *reinterpret_cast<const bf16x8*>(&w1_);
#pragma unroll
            for (int n = 0; n < 4; ++n) { const bf16x8 bq = lds_frag(QD, n * 16 + fr, QP, ks * 32 + fq * 8);
                acc[dir][0][n] = __builtin_amdgcn_mfma_f32_16x16x32_bf16(a0, bq, acc[dir][0][n], 0, 0, 0); acc[dir][1][n] = __builtin_amdgcn_mfma_f32_16x16x32_bf16(a1, bq, acc[dir][1][n], 0, 0, 0); } }
    }
    __syncthreads();
    f32x4 gq[2]; u32x2 ogq[4][2];
#pragma unroll
    for (int m = 0; m < 2; ++m) gq[m] = *(const f32x4*)(A.norm_m + h * 256 + (2 * wave + m) * 16 + fq * 4);
#pragma unroll
    for (int n = 0; n < 4; ++n)
#pragma unroll
        for (int m = 0; m < 2; ++m) ogq[n][m] = *(const u32x2*)(A.OMS + (size_t)(row0 + n * 16 + fr) * 1024 + h * 256 + (2 * wave + m) * 16 + fq * 4);
    f32x4 hv[2][4];
#pragma unroll
    for (int n = 0; n < 4; ++n) { const int t = n * 16 + fr; const float rf = 1.f / DEN[t], rb = 1.f / DEN[64 + t]; float ss = 0.f;
#pragma unroll
        for (int m = 0; m < 2; ++m) { hv[m][n] = acc[0][m][n] * rf + acc[1][m][n] * rb; ss += hv[m][n].x * hv[m][n].x + hv[m][n].y * hv[m][n].y + hv[m][n].z * hv[m][n].z + hv[m][n].w * hv[m][n].w; }
        ss += __shfl_xor(ss, 16); ss += __shfl_xor(ss, 32);
        if (fq == 0) RS[wave * 64 + t] = ss; }
    __syncthreads();
#pragma unroll
    for (int n = 0; n < 4; ++n) { const int t = n * 16 + fr; float ss = 0.f;
#pragma unroll
        for (int w = 0; w < 8; ++w) ss += RS[w * 64 + t];
        const float rstd = 1.f / sqrtf(ss * (1.f / 256.f) + RMS_EPS);
#pragma unroll
        for (int m = 0; m < 2; ++m) { const int e0 = (2 * wave + m) * 16 + fq * 4; const size_t o = (size_t)(row0 + t) * 1024 + h * 256 + e0;
            *(u32x2*)(A.HM + o) = pk4(hv[m][n] * rstd * gq[m] * unpk4(ogq[n][m])); } }
    __syncthreads();
}

__device__ __forceinline__ void tr_load(const float* W, size_t ldw, int k0, int n0, int nvalid, LAS float* scr, int lane) {
#pragma unroll 8
    for (int i = 0; i < 32; ++i) { const int kk = 2 * i + (lane >> 5), n = lane & 31; scr[kk * 33 + n] = (n < nvalid) ? W[(size_t)(k0 + kk) * ldw + n0 + n] : 0.f; }
    LDS_WAIT(); asm volatile("" ::: "memory");
}
__device__ __forceinline__ int perm32(int n) { return (n & ~31) | (((n >> 2) & 1) << 4) | (((n >> 3) & 3) << 2) | (n & 3); }
template <int MODE  >
__device__ __forceinline__ void tr_store(bf16_t* WT, size_t ldt, int drow0, int dcol0, int nvalid, const LAS float* scr, int lane, bool perm = false) {
    const int c = lane & 7;
#pragma unroll
    for (int j = 0; j < 4; ++j) { const int n = (lane >> 3) + 8 * j; const LAS float* s = scr + (8 * c) * 33 + n; float v[8];
#pragma unroll
        for (int e = 0; e < 8; ++e) { v[e] = s[e * 33]; if (MODE == 1) v[e] = v[e] - bf2f(f2bf(v[e])); }
        u32x4 o; o.x = pk2(v[0], v[1]); o.y = pk2(v[2], v[3]); o.z = pk2(v[4], v[5]); o.w = pk2(v[6], v[7]);
        if (n < nvalid) *(u32x4*)(WT + (size_t)(drow0 + (perm ? perm32(n) : n)) * ldt + dcol0 + 8 * c) = o; }
}

__device__ __forceinline__ void tr_load64(const float* W, size_t ldw, int k0, int n0, LAS float* scr, int lane) {
    float v[64];
    const float* p = W + (size_t)k0 * ldw + n0 + lane;
#pragma unroll
    for (int i = 0; i < 64; ++i) v[i] = __builtin_nontemporal_load(p + (size_t)i * ldw);
#pragma unroll
    for (int i = 0; i < 64; ++i) scr[i * 65 + lane] = v[i];
    LDS_WAIT(); asm volatile("" ::: "memory");
}
template <bool PERM = false>
__device__ __forceinline__ void tr_store64(bf16_t* WT, size_t ldt, int drow0, int dcol0, const LAS float* scr, int lane) {
    const int c = lane & 7;
#pragma unroll
    for (int j = 0; j < 8; ++j) { const int nl = (lane >> 3) + 8 * j; const LAS float* s = scr + (8 * c) * 65 + nl; const int n = PERM ? perm32(nl) : nl;
        u32x4 o; o.x = pk2(s[0], s[65]); o.y = pk2(s[2 * 65], s[3 * 65]); o.z = pk2(s[4 * 65], s[5 * 65]); o.w = pk2(s[6 * 65], s[7 * 65]);
        *(u32x4*)(WT + (size_t)(drow0 + n) * ldt + dcol0 + 8 * c) = o; }
    LDS_WAIT(); asm volatile("" ::: "memory");
}
struct KArgs { const float* in[25]; float* out; unsigned char* ws; int dbg; int pad; };

__device__ __forceinline__ void ln_row(f32x4 (&v)[4], const float* g, const float* bta, int lane) {
    float s = 0.f;
#pragma unroll
    for (int j = 0; j < 4; ++j) s += (v[j].x + v[j].y) + (v[j].z + v[j].w);
    const float mean = wave_sum(s) * (1.f / 1024.f); float s2 = 0.f;
#pragma unroll
    for (int j = 0; j < 4; ++j) { v[j] = v[j] - mean; s2 += (v[j].x * v[j].x + v[j].y * v[j].y) + (v[j].z * v[j].z + v[j].w * v[j].w); }
    const float rstd = 1.f / sqrtf(wave_sum(s2) * (1.f / 1024.f) + LN_EPS);
#pragma unroll
    for (int j = 0; j < 4; ++j) { const f32x4 gg = *(const f32x4*)(g + 4 * lane + 256 * j), bb = *(const f32x4*)(bta + 4 * lane + 256 * j); v[j] = v[j] * rstd * gg + bb; }
}

#define C8(j) (8 * lane + 512 * ((j) >> 1) + 4 * ((j) & 1))
__device__ __forceinline__ void ln_row8(f32x4 (&v)[4], const float* g, const float* bta, int lane) {
    float s = 0.f;
#pragma unroll
    for (int j = 0; j < 4; ++j) s += (v[j].x + v[j].y) + (v[j].z + v[j].w);
    const float mean = wave_sum(s) * (1.f / 1024.f); float s2 = 0.f;
#pragma unroll
    for (int j = 0; j < 4; ++j) { v[j] = v[j] - mean; s2 += (v[j].x * v[j].x + v[j].y * v[j].y) + (v[j].z * v[j].z + v[j].w * v[j].w); }
    const float rstd = 1.f / sqrtf(wave_sum(s2) * (1.f / 1024.f) + LN_EPS);
#pragma unroll
    for (int j = 0; j < 4; ++j) { const f32x4 gg = *(const f32x4*)(g + C8(j)), bb = *(const f32x4*)(bta + C8(j)); v[j] = v[j] * rstd * gg + bb; }
}

#define AS4 __attribute__((address_space(4)))
__device__ __forceinline__ const char AS4* kargp() { const char AS4* p = (const char AS4*)__builtin_amdgcn_kernarg_segment_ptr(); asm volatile("" : "+s"(p)); return p; }
#define INP(k) (*(const float* const AS4*)(kargp() + 8 * (k)))
#define OUTP() (*(float* const AS4*)(kargp() + 200))
#define WSB() (*(unsigned char* const AS4*)(kargp() + 208))
enum { I_X = 0, I_C, I_CTX, I_CCTX, I_ADAW, I_ADAB, I_WIN, I_BG, I_CONV, I_LAM, I_SUBLN, I_NORMM, I_WBRA, I_WBRM, I_WOUT, I_LN1G, I_LN1B, I_LN2G, I_LN2B, I_WR, I_EB, I_WEIN, I_WEOUT, I_WSIN, I_WSOUT };

__global__ void __launch_bounds__(NTHR, 2) mega_fwd(KArgs args) {
    extern __shared__ __attribute__((aligned(16))) unsigned char lds_raw[];
    LAS unsigned char* lds = (LAS unsigned char*)lds_raw;
    for (int u = threadIdx.x; u < (LDS_BYTES - MISC_OFF) / 4; u += NTHR) ((LAS unsigned*)(lds + MISC_OFF))[u] = 0u;
    __syncthreads();
    (void)xcd_barrier_post((unsigned*)(WSB() + WS_CTL) + CW_BAR, (volatile LAS unsigned*)(lds + MISC_OFF) + 8);
#define GRID_BAR() do { for (int xb_ = 0; xb_ < 1 + XBAR; ++xb_) { XcdBarrier b_; b_.bar = (unsigned*)(WSB() + WS_CTL) + CW_BAR; b_.x = xb_xcc_id(); b_.st = (volatile LAS unsigned*)(lds + MISC_OFF) + 8; if (xb_ == 0) xcd_barrier<true, false>(b_); else xcd_barrier<false, true>(b_); } } while (0)
#define PHASE_LOCALS() const int tid = opaque_tid(), lane = tid & 63, wave = __builtin_amdgcn_readfirstlane(tid >> 6); int G = (int)gridDim.x; asm volatile("" : "+s"(G)); \
    const int bx = (int)blockIdx.x, vcu = (G % 8 == 0) ? (bx % 8) * (G / 8) + bx / 8 : bx, gw = vcu * NWAVES + wave, NGW = G * NWAVES; (void)tid; (void)lane; (void)wave; (void)gw; (void)NGW; (void)vcu

#if PROBE
#define STAMP(cat) do { if (blockIdx.x == 0 && threadIdx.x == 0) { LAS unsigned long long* ts_ = (LAS unsigned long long*)(lds + MISC_OFF + 64); const unsigned long long t_ = __builtin_amdgcn_s_memrealtime(); ts_[1 + (cat)] += t_ - ts_[0]; ts_[0] = t_; } } while (0)
    if (blockIdx.x == 0 && threadIdx.x == 0) ((LAS unsigned long long*)(lds + MISC_OFF + 64))[0] = __builtin_amdgcn_s_memrealtime();
#else
#define STAMP(cat) do { } while (0)
#endif
    for (int rep_ = 0; rep_ < NREP(1); ++rep_) {
        PHASE_LOCALS(); unsigned char* ws = WSB();
        LAS float* scr = (LAS float*)(lds + wave * 16640);
        constexpr int IT_IN = 257 * 16;
        constexpr int IT_SQ = 32 * 16;
        constexpr int IT_RT = 8 * 16;
        constexpr int IT_E1 = 8 * 16, IT_E2 = 16 * 4;
        constexpr int IT_LAYER = IT_IN + 3 * IT_SQ + IT_RT + 257 * IT_E1 + 257 * IT_E2;
        for (int it = gw; it < 2 * IT_LAYER; it += NGW) {
            const int l = it / IT_LAYER; int r = it % IT_LAYER; unsigned char* WL = ws + WS_W0 + (size_t)l * WL_SIZE;
            if (r < IT_IN) { const int nb = r / 16, kb = r % 16; int n0, drow, nv = 32;
                if (nb < 192) { n0 = nb * 32; drow = n0; } else if (nb == 192) { n0 = 6144; drow = 8192; nv = 16; } else { n0 = 6160 + (nb - 193) * 32; drow = 6144 + (nb - 193) * 32; }
                tr_load(INP(I_WIN) + (size_t)l * 1024 * INW, INW, kb * 64, n0, nv, scr, lane); tr_store<0>((bf16_t*)(WL + WL_IN), 1024, drow, kb * 64, nv, scr, lane, drow >= 2048 && drow < 8192); continue; }
            r -= IT_IN;
            if (r < 3 * IT_SQ) { const int w = r / IT_SQ, q = r % IT_SQ, nb = q / 16, kb = q % 16; const float* src = (w == 0 ? INP(I_WBRA) : w == 1 ? INP(I_WBRM) : INP(I_WOUT)) + (size_t)l * 1024 * 1024;
                tr_load(src, 1024, kb * 64, nb * 32, 32, scr, lane); tr_store<0>((bf16_t*)(WL + (w == 0 ? WL_BRA : w == 1 ? WL_BRM : WL_OUT)), 1024, nb * 32, kb * 64, 32, scr, lane, true); continue; }
            r -= 3 * IT_SQ;
            if (r < IT_RT) { const int nb = r / 16, kb = r % 16; tr_load(INP(I_WR) + (size_t)l * 1024 * 256, 256, kb * 64, nb * 32, 32, scr, lane);
                bf16_t* dst = (bf16_t*)(WL + WL_R3); tr_store<0>(dst, 3072, nb * 32, kb * 64, 32, scr, lane); tr_store<0>(dst, 3072, nb * 32, 1024 + kb * 64, 32, scr, lane); tr_store<1>(dst, 3072, nb * 32, 2048 + kb * 64, 32, scr, lane); continue; }
            r -= IT_RT;
            if (r < 257 * IT_E1) { const int e = r / IT_E1, q = r % IT_E1, kb = q / 8, nb = q % 8, n0 = nb * 64;
                const float* src = e < 256 ? INP(I_WEIN) + ((size_t)l * 256 + e) * 1024 * 512 : INP(I_WSIN) + (size_t)l * 1024 * 512;
                const int isg = n0 >= 256, j0 = n0 & 255, drow = (j0 >> 7) * 256 + isg * 128 + (j0 & 127);
                tr_load64(src, 512, kb * 64, n0, scr, lane); tr_store64<true>((bf16_t*)(WL + WL_E1) + (size_t)e * 512 * 1024, 1024, drow, kb * 64, scr, lane); continue; }
            r -= 257 * IT_E1;
            { const int e = r / IT_E2, q = r % IT_E2, kb = q / 16, nb = q % 16;
                const float* src = e < 256 ? INP(I_WEOUT) + ((size_t)l * 256 + e) * 256 * 1024 : INP(I_WSOUT) + (size_t)l * 256 * 1024;
                tr_load64(src, 1024, kb * 64, nb * 64, scr, lane); tr_store64<true>((bf16_t*)(WL + WL_E2) + (size_t)e * 1024 * 256, 256, nb * 64, kb * 64, scr, lane); }
        }
        { const float* in_c = INP(I_C); const float* in_cctx = INP(I_CCTX); const float* ada_w = INP(I_ADAW); const float* ada_b = INP(I_ADAB); float* MODV = (float*)(ws + WS_MODV);
        for (int it = bx * NTHR + tid; it < 2 * 6144; it += G * NTHR) { const int l = it / 6144, j = it % 6144; const float* wcol = ada_w + (size_t)l * 1024 * 6144 + j; float a0 = 0.f, a1 = 0.f, a2 = 0.f;
#pragma unroll 4
            for (int k = 0; k < 1024; ++k) { const float w = wcol[(size_t)k * 6144]; a0 += siluf_(in_c[k]) * w; a1 += siluf_(in_c[1024 + k]) * w; a2 += siluf_(in_cctx[k]) * w; }
            const float bb = ada_b[l * 6144 + j]; MODV[(l * 3 + 0) * 6144 + j] = a0 + bb; MODV[(l * 3 + 1) * 6144 + j] = a1 + bb; MODV[(l * 3 + 2) * 6144 + j] = a2 + bb; } }
        { f32x2* ROPE = (f32x2*)(ws + WS_ROPE);
        for (int it = bx * NTHR + tid; it < 256 * 16; it += G * NTHR) { const int pos = it >> 4, i = it & 15; const float inv = powf(10000.f, -(float)i / 16.f); const float ang = (float)pos * inv; float s, c; sincosf(ang, &s, &c); ROPE[it] = (f32x2){c, s}; } }
    }
    GRID_BAR(); STAMP(0);

    for (int l = 0; l < 2; ++l) {
        if (l == 0) for (int rep_ = 0; rep_ < NREP(2); ++rep_) {
            PHASE_LOCALS(); unsigned char* ws = WSB(); const float* modv = (const float*)(ws + WS_MODV); bf16_t* HMOD = (bf16_t*)(ws + WS_HMOD);
            XSrc xs{INP(I_X), INP(I_CTX), (const float*)(ws + WS_XCUR), 0};
            for (int r = gw; r < MALL; r += NGW) { const int b = r / TPB, set = (r % TPB) < SEQ ? b : 2; const float* xr = xs.row(r); const float* mv = modv + set * 6144;
#pragma unroll
                for (int j = 0; j < 4; ++j) { const int c = 4 * lane + 256 * j; const f32x4 v = *(const f32x4*)(xr + c), sh = *(const f32x4*)(mv + c), sc = *(const f32x4*)(mv + 1024 + c);
                    *(u32x2*)(HMOD + (size_t)r * 1024 + c) = pk4(v * (sc + 1.f) + sh); } }
            GRID_BAR(); STAMP(0);
        }
        for (int rep_ = 0; rep_ < NREP(4); ++rep_) {
            PHASE_LOCALS(); unsigned char* ws = WSB(); unsigned char* WL = ws + WS_W0 + (size_t)l * WL_SIZE;
            pg8::DenseOrder S; S.init(NRT, INW_PAD / 256, G, bx, WL + WL_IN, 1024);
            EpiInProj E{(bf16_t*)(ws + WS_Q), (bf16_t*)(ws + WS_K), (bf16_t*)(ws + WS_V), (bf16_t*)(ws + WS_QKM), (bf16_t*)(ws + WS_VM), (bf16_t*)(ws + WS_OMS), (bf16_t*)(ws + WS_GA), (bf16_t*)(ws + WS_GB),
                        (float*)(ws + WS_GATES), INP(I_BG) + l * 16, (const f32x2*)(ws + WS_ROPE), (unsigned*)(ws + WS_CTL) + CW_MSTAB + l * 16};
            pg8::gemm_phase(lds, (const bf16_t*)(ws + WS_HMOD), 1024, 1024, S, E);
        }
        GRID_BAR(); STAMP(1);
        for (int rep_ = 0; rep_ < NREP(8); ++rep_) {
            PHASE_LOCALS(); unsigned char* ws = WSB();
            MlstmArgs MA{(const bf16_t*)(ws + WS_QKM), (const bf16_t*)(ws + WS_VM), (const bf16_t*)(ws + WS_OMS), (const float*)(ws + WS_GATES), INP(I_CONV) + (size_t)l * 3 * 1024, INP(I_NORMM) + l * 1024,
                         (const unsigned*)(ws + WS_CTL) + CW_MSTAB + l * 16, (bf16_t*)(ws + WS_ST), (float*)(ws + WS_NU), (float*)(ws + WS_ADEC), (bf16_t*)(ws + WS_HM), ws + WS_X1};
            for (int u = bx; u < 8 * NCHUNK; u += G) mlstm_d1_unit(MA, u / NCHUNK, u % NCHUNK, lds);
        }
        GRID_BAR(); STAMP(2);
        for (int rep_ = 0; rep_ < NREP(16); ++rep_) {
            PHASE_LOCALS(); unsigned char* ws = WSB();
            MlstmArgs MA{nullptr, nullptr, nullptr, nullptr, nullptr, nullptr, nullptr, (bf16_t*)(ws + WS_ST), (float*)(ws + WS_NU), (float*)(ws + WS_ADEC), nullptr, ws + WS_X1};
            mlstm_scan(MA, bx * NTHR + tid, G * NTHR);
            if (XSCAN) { GRID_BAR(); mlstm_scan(MA, bx * NTHR + tid, G * NTHR, (bf16_t*)(ws + WS_YB), (float*)(ws + WS_HE)); }
        }
        GRID_BAR(); STAMP(3);
        for (int rep_ = 0; rep_ < NREP(32); ++rep_) {
            PHASE_LOCALS(); unsigned char* ws = WSB(); const bf16_t* Qb_ = (const bf16_t*)(ws + WS_Q); const bf16_t* Kb_ = (const bf16_t*)(ws + WS_K); const bf16_t* Vb_ = (const bf16_t*)(ws + WS_V); bf16_t* OJ = (bf16_t*)(ws + WS_OJ);
            const int nun = (G == 256) ? 8 : (2048 + G - 1) / G;
            for (int r = 0; r < nun; ++r) {
                int grp, qb;
                if (G == 256) { const int xg = vcu >> 5, ii = vcu & 31; grp = xg + 8 * (r >> 1); qb = ii + 32 * (r & 1); }
                else { const int u = bx + r * G; if (u >= 2048) break; grp = u >> 6; qb = u & 63; }
                const int b = grp >> 4, h = (grp >> 1) & 7, j = grp & 1; const size_t q0 = (size_t)b * TPB + qb * 256, k0 = (size_t)b * TPB;
                att::attn_body(Qb_ + q0 * 1024 + h * 128 + j * 64, Kb_ + k0 * 1024 + h * 128 + j * 64, Vb_ + k0 * 1024 + h * 128, OJ + q0 * 2048 + h * 256 + j * 128, TPB, (char*)lds_raw);
            }
            if (l == 0) for (int u = bx; u < 32; u += G) { const int b = u >> 4, h = (u >> 1) & 7, j = u & 1; const size_t q0 = (size_t)b * TPB + SEQ;
                att::attn_body(Qb_ + q0 * 1024 + h * 128 + j * 64, Kb_ + q0 * 1024 + h * 128 + j * 64, Vb_ + q0 * 1024 + h * 128, OJ + q0 * 2048 + h * 256 + j * 128, CTX, (char*)lds_raw); }
        }
        STAMP(4);
        for (int rep_ = 0; rep_ < NREP(64); ++rep_) {
            PHASE_LOCALS(); unsigned char* ws = WSB();
            MlstmArgs MA{(const bf16_t*)(ws + WS_QKM), (const bf16_t*)(ws + WS_VM), (const bf16_t*)(ws + WS_OMS), (const float*)(ws + WS_GATES), INP(I_CONV) + (size_t)l * 3 * 1024, INP(I_NORMM) + l * 1024,
                         (const unsigned*)(ws + WS_CTL) + CW_MSTAB + l * 16, (bf16_t*)(ws + WS_ST), (float*)(ws + WS_NU), (float*)(ws + WS_ADEC), (bf16_t*)(ws + WS_HM), ws + WS_X1};
            for (int u = bx; u < 8 * NCHUNK; u += G) mlstm_d3_unit(MA, u / NCHUNK, u % NCHUNK, lds);
        }
        GRID_BAR(); STAMP(5);
        for (int rep_ = 0; rep_ < NREP(128); ++rep_) {
            PHASE_LOCALS(); unsigned char* ws = WSB(); const bf16_t* OJ = (const bf16_t*)(ws + WS_OJ); bf16_t* OA = (bf16_t*)(ws + WS_OA);
            const float lam_init = l == 0 ? 0.2f : (0.8f - 0.6f * 0.7408182206817179f);
            const float* lm = INP(I_LAM) + l * 256;
            const float lv = __expf(wave_sum(lm[lane] * lm[64 + lane])) - __expf(wave_sum(lm[128 + lane] * lm[192 + lane])) + lam_init;
            const int hh = lane >> 3, e0 = (lane & 7) * 16; f32x4 sgv[4];
#pragma unroll
            for (int q = 0; q < 4; ++q) sgv[q] = *(const f32x4*)(INP(I_SUBLN) + l * 128 + e0 + 4 * q);
            for (int r0 = gw; r0 < MALL; r0 += 2 * NGW) { const int r1 = r0 + NGW; const bool has1 = r1 < MALL; const int rr[2] = {r0, has1 ? r1 : r0};
                u32x4 ra[2][2], rb[2][2];
#pragma unroll
                for (int x = 0; x < 2; ++x) { const bf16_t* p = OJ + (size_t)rr[x] * 2048 + hh * 256 + e0; ra[x][0] = *(const u32x4*)p; ra[x][1] = *(const u32x4*)(p + 8); rb[x][0] = *(const u32x4*)(p + 128); rb[x][1] = *(const u32x4*)(p + 136); }
#pragma unroll
                for (int x = 0; x < 2; ++x) { if (x == 1 && !has1) break;
                    float d[16]; float ss = 0.f;
#pragma unroll
                    for (int q = 0; q < 2; ++q) { const unsigned a4[4] = {ra[x][q].x, ra[x][q].y, ra[x][q].z, ra[x][q].w}, b4[4] = {rb[x][q].x, rb[x][q].y, rb[x][q].z, rb[x][q].w};
#pragma unroll
                        for (int e = 0; e < 4; ++e) { const float lo = bf2f(a4[e] & 0xffffu) - lv * bf2f(b4[e] & 0xffffu), hi_ = bf2f(a4[e] >> 16) - lv * bf2f(b4[e] >> 16); d[q * 8 + 2 * e] = lo; d[q * 8 + 2 * e + 1] = hi_; ss += lo * lo + hi_ * hi_; } }
                    ss += __shfl_xor(ss, 1); ss += __shfl_xor(ss, 2); ss += __shfl_xor(ss, 4);
                    const float rstd = __builtin_amdgcn_rsqf(ss * (1.f / 128.f) + RMS_EPS) * (1.f - lam_init);
                    u32x4 o0, o1;
                    o0.x = pk2(d[0] * rstd * sgv[0].x, d[1] * rstd * sgv[0].y); o0.y = pk2(d[2] * rstd * sgv[0].z, d[3] * rstd * sgv[0].w); o0.z = pk2(d[4] * rstd * sgv[1].x, d[5] * rstd * sgv[1].y); o0.w = pk2(d[6] * rstd * sgv[1].z, d[7] * rstd * sgv[1].w);
                    o1.x = pk2(d[8] * rstd * sgv[2].x, d[9] * rstd * sgv[2].y); o1.y = pk2(d[10] * rstd * sgv[2].z, d[11] * rstd * sgv[2].w); o1.z = pk2(d[12] * rstd * sgv[3].x, d[13] * rstd * sgv[3].y); o1.w = pk2(d[14] * rstd * sgv[3].z, d[15] * rstd * sgv[3].w);
                    bf16_t* po = OA + (size_t)rr[x] * 1024 + hh * 128 + e0; *(u32x4*)po = o0; *(u32x4*)(po + 8) = o1; } }
        }
        GRID_BAR(); STAMP(6);
        for (int rep_ = 0; rep_ < NREP(256); ++rep_) { PHASE_LOCALS(); unsigned char* ws = WSB(); unsigned char* WL = ws + WS_W0 + (size_t)l * WL_SIZE;
            pg8::DenseOrder S; S.init(l ? NRT - 2 : NRT, 4, G, bx, WL + WL_BRA, 1024, l); EpiGate1 E{(const bf16_t*)(ws + WS_GA), (bf16_t*)(ws + WS_T1)}; pg8::gemm_phase(lds, (const bf16_t*)(ws + WS_OA), 1024, 1024, S, E); }
        GRID_BAR(); STAMP(7);
        for (int rep_ = 0; rep_ < NREP(512); ++rep_) { PHASE_LOCALS(); unsigned char* ws = WSB(); unsigned char* WL = ws + WS_W0 + (size_t)l * WL_SIZE;
            pg8::DenseOrder S; S.init(l ? NRT - 2 : NRT, 4, G, bx, WL + WL_BRM, 1024, l); EpiGate2 E{(const bf16_t*)(ws + WS_GB), (const bf16_t*)(ws + WS_T1), (bf16_t*)(ws + WS_Y)}; pg8::gemm_phase(lds, (const bf16_t*)(ws + WS_HM), 1024, 1024, S, E); }
        GRID_BAR(); STAMP(7);
        for (int rep_ = 0; rep_ < NREP(1024); ++rep_) { PHASE_LOCALS(); unsigned char* ws = WSB(); unsigned char* WL = ws + WS_W0 + (size_t)l * WL_SIZE;
            XSrc xs{INP(I_X), INP(I_CTX), (const float*)(ws + WS_XCUR), l};
            pg8::DenseOrder S; S.init(l ? NRT - 2 : NRT, 4, G, bx, WL + WL_OUT, 1024, l); EpiOut E{xs, (const float*)(ws + WS_MODV) + l * 3 * 6144, (float*)(ws + WS_R)}; pg8::gemm_phase(lds, (const bf16_t*)(ws + WS_Y), 1024, 1024, S, E); }
        GRID_BAR(); STAMP(7);
        for (int rep_ = 0; rep_ < NREP(2048); ++rep_) {
            PHASE_LOCALS(); unsigned char* ws = WSB(); const float* modv = (const float*)(ws + WS_MODV) + l * 3 * 6144; const float* Rf = (const float*)(ws + WS_R); float* X1 = (float*)(ws + WS_X1); bf16_t* H2A = (bf16_t*)(ws + WS_H2A);
            const float* g1 = INP(I_LN1G) + l * 1024; const float* b1 = INP(I_LN1B) + l * 1024;
            for (int r0 = gw; r0 < MALL; r0 += 2 * NGW) { const int r1 = r0 + NGW; const bool has1 = r1 < MALL; const int rr[2] = {r0, has1 ? r1 : r0}; f32x4 vv[2][4];
#pragma unroll
                for (int x = 0; x < 2; ++x)
#pragma unroll
                    for (int j = 0; j < 4; ++j) vv[x][j] = unpk4(*(const u32x2*)((const bf16_t*)Rf + (size_t)rr[x] * 1024 + 4 * lane + 256 * j));
#pragma unroll
                for (int x = 0; x < 2; ++x) { if (x == 1 && !has1) break;
                    const int r = rr[x]; const int b = r / TPB, set = (r % TPB) < SEQ ? b : 2; const float* mv = modv + set * 6144;
                    ln_row(vv[x], g1, b1, lane);
#pragma unroll
                    for (int j = 0; j < 4; ++j) { const int c = 4 * lane + 256 * j;
                        const f32x4 sh = *(const f32x4*)(mv + 3 * 1024 + c), sc = *(const f32x4*)(mv + 4 * 1024 + c); const f32x4 hh = vv[x][j] * (sc + 1.f) + sh;
                        *(u32x2*)(H2A + (size_t)r * 1024 + c) = pk4(hh); } } }
        }
        GRID_BAR(); STAMP(8);
        for (int rep_ = 0; rep_ < NREP(4096); ++rep_) { PHASE_LOCALS(); unsigned char* ws = WSB(); unsigned char* WL = ws + WS_W0 + (size_t)l * WL_SIZE;
            pg8::DenseOrder S; S.init(NRT, 1, G, bx, WL + WL_R3, 3072); EpiLogits E{(float*)(ws + WS_LOG)}; pg8::gemm_phase(lds, (const bf16_t*)(ws + WS_H2A), 1024, ROUTER_K, S, E, 3072); }
        GRID_BAR(); STAMP(9);
        for (int rep_ = 0; rep_ < NREP(8192); ++rep_) {
            PHASE_LOCALS(); unsigned char* ws = WSB(); const float* LOGITS = (const float*)(ws + WS_LOG); const float* e_bias = INP(I_EB) + l * 256; unsigned* ecnt = (unsigned*)(ws + WS_CTL) + CW_CNT + l * 256;
            for (int xt_ = 0; xt_ < 1 + XTOPK; ++xt_) {
            if (xt_) ecnt += 2048;
            int* TOPI = (int*)(ws + (xt_ ? WS_YB : WS_TOPI)); float* TOPW = (float*)(ws + (xt_ ? WS_YB + 2 * MiB : WS_TOPW)); int* POS = (int*)(ws + (xt_ ? WS_YB + 4 * MiB : WS_POS));
            for (int r4 = gw * 4; r4 < MALL; r4 += NGW * 4) {
                const int r = r4 + (lane >> 4), sub = lane & 15; float sc[16], bs[16];
#pragma unroll
                for (int q = 0; q < 4; ++q) { const f32x4 lg = *(const f32x4*)(LOGITS + (size_t)r * 256 + sub * 16 + 4 * q), eb = *(const f32x4*)(e_bias + sub * 16 + 4 * q);
                    sc[4 * q] = sigmoidf_(lg.x); sc[4 * q + 1] = sigmoidf_(lg.y); sc[4 * q + 2] = sigmoidf_(lg.z); sc[4 * q + 3] = sigmoidf_(lg.w);
                    bs[4 * q] = sc[4 * q] + eb.x; bs[4 * q + 1] = sc[4 * q + 1] + eb.y; bs[4 * q + 2] = sc[4 * q + 2] + eb.z; bs[4 * q + 3] = sc[4 * q + 3] + eb.w; }
                int myi = 0; float myw = 0.f, wsum = 0.f;
#pragma unroll
                for (int k = 0; k < 8; ++k) {
                    float bv = bs[0], bsc = sc[0]; int bi = 0;
#pragma unroll
                    for (int e = 1; e < 16; ++e) if (bs[e] > bv) { bv = bs[e]; bsc = sc[e]; bi = e; }
                    int gi = sub * 16 + bi;
#pragma unroll
                    for (int o = 1; o < 16; o <<= 1) { const float ov = __shfl_xor(bv, o), os = __shfl_xor(bsc, o); const int oi = __shfl_xor(gi, o); if (ov > bv || (ov == bv && oi < gi)) { bv = ov; gi = oi; bsc = os; } }
                    if ((gi >> 4) == sub) { const int oe = gi & 15;
#pragma unroll
                        for (int e = 0; e < 16; ++e) if (e == oe) bs[e] = -1e30f; }
                    wsum += bsc;
                    if (sub == k) { myi = gi; myw = bsc; }
                }
                if (sub < 8) { const float w = myw / wsum * 2.5f; const int p = (int)atomicAdd(ecnt + myi, 1u);
                    TOPI[(size_t)r * 8 + sub] = myi; TOPW[(size_t)r * 8 + sub] = w; POS[(size_t)r * 8 + sub] = p; }
            }
            }
        }
        GRID_BAR(); STAMP(10);
        for (int rep_ = 0; rep_ < NREP(16384); ++rep_) {
            PHASE_LOCALS(); unsigned char* ws = WSB(); unsigned* ecnt = (unsigned*)(ws + WS_CTL) + CW_CNT + l * 256;
            const int* TOPI = (const int*)(ws + WS_TOPI); const float* TOPW = (const float*)(ws + WS_TOPW); const int* POS = (const int*)(ws + WS_POS); int* SLOT = (int*)(ws + WS_SLOT);
            int* ROWTOK = (int*)(ws + WS_ROWTOK); float* ROWW = (float*)(ws + WS_ROWW); int* BLKEXP = (int*)(ws + WS_BLKEXP);
            LAS int* cntL = (LAS int*)lds; LAS int* bst = cntL + 256; LAS int* tot = bst + 256;
            if (tid < 256) cntL[tid] = (int)__hip_atomic_load(ecnt + tid, RLX_AGENT);
            __syncthreads();
            if (tid == 0) { int s = 0; for (int e = 0; e < 256; ++e) { bst[e] = s; s += (cntL[e] + 255) >> 8; } tot[0] = s; }
            __syncthreads();
            const int NB = tot[0]; const int gt = bx * NTHR + tid, GT = G * NTHR;
            for (int i = gt; i < MALL * 8; i += GT) { const int e = TOPI[i]; const int slot = bst[e] * 256 + POS[i]; SLOT[i] = slot; st_wt(ROWTOK + slot, i >> 3); st_wt(ROWW + slot, TOPW[i]); }
            for (int i = gt; i < 256 * 256; i += GT) { const int e = i >> 8, p = i & 255, c = cntL[e]; if ((c & 255) != 0 && p >= (c & 255)) { const int slot = (bst[e] + (c >> 8)) * 256 + p; st_wt(ROWTOK + slot, 0); st_wt(ROWW + slot, -1.f); } }
            for (int i = gt; i < 256 * 160; i += GT) { const int e = i / 160, j = i % 160; if (j < ((cntL[e] + 255) >> 8)) st_wt(BLKEXP + bst[e] + j, e); }
            for (int i = gt; i < NRT * 256; i += GT) { const int slot = NB * 256 + i; ROWTOK[slot] = i; ROWW[slot] = 1.f; if ((i & 255) == 0) st_wt(BLKEXP + NB + (i >> 8), 256); }
            if (gt == 0) st_wt(BLKEXP + MAXBLK, NB + NRT);
            __syncthreads();
        }
        GRID_BAR(); STAMP(10);
        for (int rep_ = 0; rep_ < NREP(32768); ++rep_) {
            PHASE_LOCALS(); unsigned char* ws = WSB(); unsigned char* WL = ws + WS_W0 + (size_t)l * WL_SIZE; const int* ROWTOK = (const int*)(ws + WS_ROWTOK); const int* BLKEXP = (const int*)(ws + WS_BLKEXP);
            LAS int* rowtab = (LAS int*)(lds + TAB_OFF); LAS int* etab = rowtab + 12 * 256;
            const int nunits = BLKEXP[MAXBLK] * 2;
            for (int i = 0; i < 12; ++i) { const int L = i * G + vcu; if (L >= nunits) break; const int bi = L >> 1;
                if (tid < 256) rowtab[i * 256 + tid] = ROWTOK[(size_t)bi * 256 + tid]; if (tid == 256) etab[i] = BLKEXP[bi]; }
            __syncthreads();
            pg8::MoeOrder<2, true> S{nunits, G, vcu, (const char*)(WL + WL_E1), (size_t)512 * 1024 * 2, (size_t)256 * 1024 * 2, rowtab, etab};
            EpiSwiglu E{(bf16_t*)(ws + WS_HE)}; pg8::gemm_phase(lds, (const bf16_t*)(ws + WS_H2A), 1024, 1024, S, E);
        }
        GRID_BAR(); STAMP(11);
        for (int rep_ = 0; rep_ < NREP(65536); ++rep_) {
            PHASE_LOCALS(); unsigned char* ws = WSB(); unsigned char* WL = ws + WS_W0 + (size_t)l * WL_SIZE; const int* BLKEXP = (const int*)(ws + WS_BLKEXP);
            LAS int* rowtab = (LAS int*)(lds + TAB_OFF); LAS int* etab = rowtab + 12 * 256;
            const int nunits = BLKEXP[MAXBLK] * 4;
            for (int i = tid; i < 64; i += NTHR) { const int L = i * G + vcu; if (L < nunits) etab[i] = BLKEXP[L >> 2]; }
            __syncthreads();
            pg8::MoeOrder<4, false> S{nunits, G, vcu, (const char*)(WL + WL_E2), (size_t)1024 * 256 * 2, (size_t)256 * 256 * 2, rowtab, etab};
            EpiScaleRow E{(bf16_t*)(ws + WS_YB), (const float*)(ws + WS_ROWW)}; pg8::gemm_phase(lds, (const bf16_t*)(ws + WS_HE), 256, 256, S, E);
        }
        GRID_BAR(); STAMP(12);
        for (int rep_ = 0; rep_ < NREP(131072); ++rep_) {
            PHASE_LOCALS(); unsigned char* ws = WSB(); const float* MODV = (const float*)(ws + WS_MODV); const float* modv = MODV + l * 3 * 6144; const bf16_t* YB = (const bf16_t*)(ws + WS_YB); const int* SLOT = (const int*)(ws + WS_SLOT);
            const float* X1 = (const float*)(ws + WS_R); float* XCUR = (float*)(ws + WS_XCUR); bf16_t* HMOD = (bf16_t*)(ws + WS_HMOD); float* outp = OUTP();
            const float* g2 = INP(I_LN2G) + l * 1024; const float* b2 = INP(I_LN2B) + l * 1024; const float* g1 = INP(I_LN1G) + l * 1024; const float* b1 = INP(I_LN1B) + l * 1024;
            const int NB = ((const int*)(ws + WS_BLKEXP))[MAXBLK] - NRT;
            for (int r0 = gw; r0 < MALL; r0 += 2 * NGW) { const int r1 = r0 + NGW; const bool has1 = r1 < MALL; const int rr[2] = {r0, has1 ? r1 : r0};
                int sl[2]; u32x2 yb[2][9][2]; u32x4 rx[2][2];
#pragma unroll
                for (int x = 0; x < 2; ++x) sl[x] = SLOT[(size_t)rr[x] * 8 + (lane & 7)];
#pragma unroll
                for (int x = 0; x < 2; ++x) {
#pragma unroll
                    for (int j2 = 0; j2 < 2; ++j2) { yb[x][8][j2] = *(const u32x2*)((const unsigned char*)YB + ((size_t)NB * 256 + rr[x]) * 1024 + 8 * lane + 512 * j2); rx[x][j2] = *(const u32x4*)((const bf16_t*)X1 + (size_t)rr[x] * 1024 + 8 * lane + 512 * j2); }
#pragma unroll
                    for (int k = 0; k < 8; ++k) { const size_t so = (size_t)__shfl(sl[x], k) * 1024;
#pragma unroll
                        for (int j2 = 0; j2 < 2; ++j2) yb[x][k][j2] = *(const u32x2*)((const unsigned char*)YB + so + 8 * lane + 512 * j2); } }
#pragma unroll
                for (int x = 0; x < 2; ++x) { if (x == 1 && !has1) break;
                    const int r = rr[x]; const int b = r / TPB, t = r % TPB, set = t < SEQ ? b : 2; const float* mv = modv + set * 6144; f32x4 xv[4], v[4];
#pragma unroll
                    for (int j2 = 0; j2 < 2; ++j2) { xv[2 * j2] = unpk4((u32x2){rx[x][j2].x, rx[x][j2].y}); xv[2 * j2 + 1] = unpk4((u32x2){rx[x][j2].z, rx[x][j2].w}); }
                    ln_row8(xv, g1, b1, lane);
#pragma unroll
                    for (int j = 0; j < 4; ++j) { const int j2 = j >> 1, hf = j & 1; f32x4 f = unpk4_fp8(hf ? yb[x][8][j2].y : yb[x][8][j2].x);
#pragma unroll
                        for (int k = 0; k < 8; ++k) f = f + unpk4_fp8(hf ? yb[x][k][j2].y : yb[x][k][j2].x);
                        f = f * (1.f / YB8_SCALE);
                        v[j] = xv[j] * ALPHA_RES + *(const f32x4*)(mv + 5 * 1024 + C8(j)) * f; }
                    ln_row8(v, g2, b2, lane);
                    if (l == 0) { const float* mn = MODV + 3 * 6144 + set * 6144;
#pragma unroll
                        for (int j2 = 0; j2 < 2; ++j2) { u32x2 pk[2];
#pragma unroll
                            for (int hf = 0; hf < 2; ++hf) { const int j = 2 * j2 + hf, c = C8(j); *(f32x4*)(XCUR + (size_t)r * 1024 + c) = v[j];
                                const f32x4 sh = *(const f32x4*)(mn + c), sc = *(const f32x4*)(mn + 1024 + c); pk[hf] = pk4(v[j] * (sc + 1.f) + sh); }
                            *(u32x4*)(HMOD + (size_t)r * 1024 + 8 * lane + 512 * j2) = (u32x4){pk[0].x, pk[0].y, pk[1].x, pk[1].y}; } }
                    else if (t < SEQ) {
#pragma unroll
                        for (int j = 0; j < 4; ++j) *(f32x4*)(outp + ((size_t)b * SEQ + t) * 1024 + C8(j)) = v[j]; } } }
        }
        if (l == 0 || PROBE) { GRID_BAR(); STAMP(13); }
    }
#if PROBE
    {
        unsigned char* ws = WSB(); unsigned* ctl = (unsigned*)(ws + WS_CTL);
        if (blockIdx.x == 0 && threadIdx.x == 0) { LAS unsigned long long* ts_ = (LAS unsigned long long*)(lds + MISC_OFF + 64);
            unsigned long long sa = 0, sb = 0; for (int c = 0; c < 14; ++c) { if ((PROBE_A >> c) & 1) sa += ts_[1 + c]; if ((PROBE_B >> c) & 1) sb += ts_[1 + c]; }
            __hip_atomic_store(ctl + 20000, (unsigned)(sa / 100ull), RLX_AGENT); __hip_atomic_store(ctl + 20001, (unsigned)(sb / 100ull), RLX_AGENT); }
        GRID_BAR();
        const float va = sqrtf((float)__hip_atomic_load(ctl + 20000, RLX_AGENT)), vb = (float)__hip_atomic_load(ctl + 20001, RLX_AGENT);
        float* outp = OUTP();
        for (size_t i = (size_t)blockIdx.x * NTHR + threadIdx.x; i < (size_t)BATCH * SEQ * 1024; i += (size_t)gridDim.x * NTHR) outp[i] = (i == 0) ? vb : va;
    }
#endif
}

extern "C" void kernel_launch(void* const* d_in, const int* in_sizes, int n_in, void* d_out, int out_size, void* d_ws, size_t ws_size, hipStream_t stream) {
    static int grid = 0;
    if (grid == 0) {
        if (n_in != 25 || ws_size < WS_END) { fprintf(stderr, "kernel_launch: need 25 inputs and >= %zu bytes of workspace; got %d, %zu\n", (size_t)WS_END, n_in, ws_size); grid = -1; return; }
        int dev = 0, cus = 0, per_cu = 0;
        if (hipGetDevice(&dev) != hipSuccess || hipDeviceGetAttribute(&cus, hipDeviceAttributeMultiprocessorCount, dev) != hipSuccess) { grid = -1; return; }
        if (hipFuncSetAttribute((const void*)mega_fwd, hipFuncAttributeMaxDynamicSharedMemorySize, LDS_BYTES) != hipSuccess) { fprintf(stderr, "kernel_launch: hipFuncSetAttribute failed\n"); grid = -1; return; }
        if (hipOccupancyMaxActiveBlocksPerMultiprocessor(&per_cu, (const void*)mega_fwd, NTHR, LDS_BYTES) != hipSuccess || per_cu < 1) { fprintf(stderr, "kernel_launch: occupancy query says %d\n", per_cu); (void)hipGetLastError(); per_cu = 1; }
        grid = cus;
    }
    if (grid < 0) return;
    if (hipMemsetAsync((char*)d_ws + WS_CTL, 0, CTL_ZERO_BYTES, stream) != hipSuccess) return;
    KArgs a{};
    for (int i = 0; i < 25; ++i) a.in[i] = (const float*)d_in[i];
    a.out = (float*)d_out; a.ws = (unsigned char*)d_ws; a.dbg = 0; a.pad = 0;
    hipLaunchKernelGGL(mega_fwd, dim3(grid), dim3(NTHR), LDS_BYTES, stream, a);
}
```

```cpp
#include <hip/hip_runtime.h>
#include <cstdio>
#include <cstdint>

#define GAS __attribute__((address_space(1)))
#define LAS __attribute__((address_space(3)))
typedef unsigned short bf16_t;
typedef short bf16x8 __attribute__((ext_vector_type(8)));
typedef short s16x4 __attribute__((ext_vector_type(4)));
typedef float f32x4 __attribute__((ext_vector_type(4)));
typedef float f32x2 __attribute__((ext_vector_type(2)));
typedef float f32x8 __attribute__((ext_vector_type(8)));
typedef float f32x16 __attribute__((ext_vector_type(16)));
typedef unsigned u32x4 __attribute__((ext_vector_type(4)));
typedef unsigned u32x2 __attribute__((ext_vector_type(2)));
typedef GAS unsigned gu32;
#define RLX_AGENT __ATOMIC_RELAXED, __HIP_MEMORY_SCOPE_AGENT
#define LDS_WAIT() asm volatile("s_waitcnt lgkmcnt(0)" ::: "memory")
#define VM_WAIT() asm volatile("s_waitcnt vmcnt(0)" ::: "memory")

constexpr int D = 1024, BATCH = 2, SEQ = 16384, CTX = 256, TPB = SEQ + CTX  , MALL = BATCH * TPB  ;
constexpr int NRT = MALL / 256;
constexpr int NWAVES = 8, NTHR = 512;
constexpr int INW = 8208, INW_PAD = 8448;
constexpr int NEXP = 256, TOPK = 8;
constexpr float ALPHA_RES = 1.4142135623730951f;
constexpr float LN_EPS = 1e-5f, RMS_EPS = 1e-6f;
constexpr float QSCALE = 0.125f * 1.4426950408889634f;
constexpr int MAXBLK = 1040 + 256 + 130;
constexpr int NCHUNK = TPB / 64;
constexpr int NCHAIN = 16;
#ifndef PHM
#define PHM 0x3ffff
#endif
#ifndef PROBE
#define PROBE 0
#endif
#ifndef REPM
#define REPM 0
#endif
#ifndef XBAR
#define XBAR 1
#endif
#ifndef ROUTER_K
#define ROUTER_K 1024
#endif
#ifndef XTOPK
#define XTOPK 0
#endif
#ifndef XSCAN
#define XSCAN 0
#endif
#define NREP(bit) (((PHM) & (bit)) ? (((REPM) & (bit)) ? 2 : 1) : 0)
#ifndef PROBE_A
#define PROBE_A 0x10
#endif
#ifndef PROBE_B
#define PROBE_B 0x2c
#endif

__device__ __forceinline__ unsigned pk2(float lo, float hi) { unsigned r; asm("v_cvt_pk_bf16_f32 %0, %1, %2" : "=v"(r) : "v"(lo), "v"(hi)); return r; }
__device__ __forceinline__ unsigned f2bf(float f) { return pk2(f, 0.f) & 0xffffu; }
__device__ __forceinline__ float bf2f(unsigned h) { return __builtin_bit_cast(float, h << 16); }

__device__ __forceinline__ u32x2 pk4(f32x4 v) { u32x2 r; r.x = pk2(v.x, v.y); r.y = pk2(v.z, v.w); return r; }
__device__ __forceinline__ f32x4 unpk4(u32x2 w) { f32x4 r; r.x = bf2f(w.x & 0xffffu); r.y = bf2f(w.x >> 16); r.z = bf2f(w.y & 0xffffu); r.w = bf2f(w.y >> 16); return r; }
__device__ __forceinline__ float sigmoidf_(float x) { return __builtin_amdgcn_rcpf(1.f + __expf(-x)); }
__device__ __forceinline__ float siluf_(float x) { return x * __builtin_amdgcn_rcpf(1.f + __expf(-x)); }
__device__ __forceinline__ float logsigf_(float x) { return fminf(x, 0.f) - log1pf(__expf(-fabsf(x))); }
__device__ __forceinline__ void st_wt(int* p, int v) { __hip_atomic_store(p, v, __ATOMIC_RELAXED, __HIP_MEMORY_SCOPE_AGENT); }
__device__ __forceinline__ void st_wt(float* p, float v) { __hip_atomic_store(p, v, __ATOMIC_RELAXED, __HIP_MEMORY_SCOPE_AGENT); }
__device__ __forceinline__ int opaque_tid() { int t = threadIdx.x; asm volatile("" : "+v"(t)); return t; }
__device__ __forceinline__ float wave_sum(float v) {
    v += __builtin_bit_cast(float, __builtin_amdgcn_mov_dpp(__builtin_bit_cast(int, v), 0xB1, 0xF, 0xF, true));
    v += __builtin_bit_cast(float, __builtin_amdgcn_mov_dpp(__builtin_bit_cast(int, v), 0x4E, 0xF, 0xF, true));
    v += __builtin_bit_cast(float, __builtin_amdgcn_mov_dpp(__builtin_bit_cast(int, v), 0x141, 0xF, 0xF, true));
    v += __builtin_bit_cast(float, __builtin_amdgcn_mov_dpp(__builtin_bit_cast(int, v), 0x140, 0xF, 0xF, true));
    { auto a = __builtin_amdgcn_permlane16_swap(__float_as_uint(v), __float_as_uint(v), false, false); v = __uint_as_float(a[0]) + __uint_as_float(a[1]); }
    { auto b = __builtin_amdgcn_permlane32_swap(__float_as_uint(v), __float_as_uint(v), false, false); v = __uint_as_float(b[0]) + __uint_as_float(b[1]); }
    return v;
}

constexpr size_t MiB = 1u << 20;
constexpr size_t WS_CTL = 0, CTL_ZERO_BYTES = 1 * MiB;
constexpr size_t WS_MODV = 1 * MiB;
constexpr size_t WS_ROPE = WS_MODV + 256 * 1024;
constexpr size_t WS_W0 = 2 * MiB;
constexpr size_t WL_IN = 0;
constexpr size_t WL_BRA = WL_IN + (size_t)INW_PAD * 1024 * 2;
constexpr size_t WL_BRM = WL_BRA + 2 * MiB;
constexpr size_t WL_OUT = WL_BRM + 2 * MiB;
constexpr size_t WL_R3 = WL_OUT + 2 * MiB;
constexpr size_t WL_E1 = WL_R3 + (size_t)256 * 3072 * 2;
constexpr size_t WL_E2 = WL_E1 + (size_t)257 * 512 * 1024 * 2;
constexpr size_t WL_SIZE = WL_E2 + (size_t)257 * 1024 * 256 * 2;
constexpr size_t ACT0 = WS_W0 + 2 * WL_SIZE;
constexpr size_t SZ_B16 = (size_t)MALL * 1024 * 2;
constexpr size_t WS_HMOD = ACT0;
constexpr size_t WS_Q = WS_HMOD + SZ_B16, WS_K = WS_Q + SZ_B16, WS_V = WS_K + SZ_B16, WS_QKM = WS_V + SZ_B16, WS_VM = WS_QKM + SZ_B16;
constexpr size_t WS_OMS = WS_VM + SZ_B16, WS_GA = WS_OMS + SZ_B16, WS_GB = WS_GA + SZ_B16;
constexpr size_t WS_GATES = WS_GB + SZ_B16;
constexpr size_t WS_OJ = WS_GATES + (size_t)MALL * 16 * 4 + 61440;
constexpr size_t WS_OA = WS_OJ + 2 * SZ_B16;
constexpr size_t WS_ST = WS_OA + SZ_B16;
constexpr size_t WS_NU = WS_ST + (size_t)NCHAIN * NCHUNK * 65536;
constexpr size_t WS_ADEC = WS_NU + (size_t)NCHAIN * NCHUNK * 128 * 4;
constexpr size_t WS_HM = WS_ADEC + 65536;
constexpr size_t WS_T1 = WS_HM + SZ_B16, WS_Y = WS_T1 + SZ_B16;
constexpr size_t WS_R = WS_Y + SZ_B16;
constexpr size_t WS_X1 = WS_R + 2 * SZ_B16, WS_XCUR = WS_X1 + 2 * SZ_B16;
constexpr size_t WS_H2A = WS_XCUR + 2 * SZ_B16;
constexpr size_t WS_LOG = WS_H2A + 3 * SZ_B16;
constexpr size_t WS_TOPI = WS_LOG + (size_t)MALL * 256 * 4;
constexpr size_t WS_TOPW = WS_TOPI + 2 * MiB, WS_POS = WS_TOPW + 2 * MiB, WS_SLOT = WS_POS + 2 * MiB;
constexpr size_t WS_ROWTOK = WS_SLOT + 2 * MiB;
constexpr size_t WS_ROWW = WS_ROWTOK + 2 * MiB;
constexpr size_t WS_BLKEXP = WS_ROWW + 2 * MiB;
constexpr size_t WS_HE = WS_BLKEXP + 1 * MiB;
constexpr size_t WS_YB = WS_HE + (size_t)MAXBLK * 256 * 256 * 2;
constexpr size_t WS_END = WS_YB + (size_t)MAXBLK * 256 * 1024 * 2;
static_assert(WS_END <= (size_t)4096 * MiB, "d_ws map fits 4 GiB");
constexpr int CW_BAR = 4096;
constexpr int CW_CNT = 16384;
constexpr int CW_MSTAB = 17408;

constexpr int RING_BYTES = 131072;
constexpr int TAB_OFF = RING_BYTES;
constexpr int TAB_BYTES = 12 * 1024 + 256;
constexpr int MISC_OFF = TAB_OFF + TAB_BYTES;
constexpr int LDS_BYTES = 147456;
static_assert(MISC_OFF + 128 <= LDS_BYTES, "LDS map");

#define XB_TMO      128
#define XB_XCNT(j)  (256  + 64 * (j))
#define XB_XSUB(j)  (1280 + 64 * (j))
#define XB_XGEN(j)  (2304 + 64 * (j))
#define XB_TOP      3328
#define XB_TOPGEN   3392
#define XCD_BAR_WORDS 3456
#define XB_SPIN_CAP (1u << 22)
__device__ __forceinline__ unsigned xb_ld(unsigned* p)              { return __hip_atomic_load(p, __ATOMIC_RELAXED, __HIP_MEMORY_SCOPE_AGENT); }
__device__ __forceinline__ unsigned xb_add(unsigned* p, unsigned v) { return __hip_atomic_fetch_add(p, v, __ATOMIC_RELAXED, __HIP_MEMORY_SCOPE_AGENT); }
__device__ __forceinline__ unsigned xb_xcc_id() { return (unsigned)__builtin_amdgcn_s_getreg((3 << 11) | 20) & 0xFu; }
#define XB_SPIN(cond, bar) do { unsigned _sp = 0; while (cond) { __builtin_amdgcn_s_sleep(1); \
    if ((++_sp & 255u) == 0u) { if (xb_ld(&(bar)[XB_TMO])) break; if (_sp > XB_SPIN_CAP) { atomicAdd(&(bar)[XB_TMO], 1u); break; } } } } while (0)
struct XcdBarrier { unsigned* bar; unsigned x; volatile LAS unsigned* st; };
__device__ __forceinline__ XcdBarrier xcd_barrier_post(unsigned* bar, volatile LAS unsigned* st) {
    XcdBarrier b; b.bar = bar; b.x = xb_xcc_id(); b.st = st;
    if (threadIdx.x == 0) (void)xb_add(&bar[XB_XCNT(b.x)], 1u);
    return b;
}
__device__ __forceinline__ void xcd_barrier_complete(unsigned* bar, unsigned x, unsigned& nloc, unsigned& nx) {
    const unsigned G = gridDim.x * gridDim.y * gridDim.z;
    unsigned sum, cnt, mine, sp = 0u;
    for (;;) {
        sum = 0u; cnt = 0u; mine = 0u;
#pragma unroll
        for (unsigned j = 0; j < 16; ++j) { const unsigned c = xb_ld(&bar[XB_XCNT(j)]); sum += c; cnt += (c > 0u) ? 1u : 0u; mine = (j == x) ? c : mine; }
        if (sum == G) break;
        __builtin_amdgcn_s_sleep(1);
        if ((++sp & 255u) == 0u) { if (xb_ld(&bar[XB_TMO])) break; if (sp > XB_SPIN_CAP) { atomicAdd(&bar[XB_TMO], 1u); break; } }
    }
    nloc = mine > 0u ? mine : 1u; nx = cnt > 0u ? cnt : 1u;
}
template <bool FENCES, bool LOCAL>
__device__ __forceinline__ void xcd_barrier(const XcdBarrier& b) {
    asm volatile("s_waitcnt vmcnt(0)" ::: "memory");
    __syncthreads();
    if (threadIdx.x == 0) {
        unsigned* bar = b.bar;
        __builtin_amdgcn_s_waitcnt(0);
        unsigned nloc = b.st[0], nx = b.st[1];
        if (nloc == 0u) { xcd_barrier_complete(bar, b.x, nloc, nx); b.st[0] = nloc; b.st[1] = nx; }
        const unsigned old = xb_add(&bar[XB_XSUB(b.x)], 1u);
        const unsigned gen = old / nloc;
        if (old + 1u == (gen + 1u) * nloc) {
            if (FENCES) __builtin_amdgcn_fence(__ATOMIC_RELEASE, "agent");
            asm volatile("s_waitcnt vmcnt(0)" ::: "memory");
            if (!LOCAL) { const unsigned og = xb_add(&bar[XB_TOP], 1u);
                const unsigned tg = og / nx;
                if (og + 1u == (tg + 1u) * nx) xb_add(&bar[XB_TOPGEN], 1u);
                else XB_SPIN(xb_ld(&bar[XB_TOPGEN]) == tg, bar); }
            if (FENCES) __builtin_amdgcn_fence(__ATOMIC_ACQUIRE, "agent");
            xb_add(&bar[XB_XGEN(b.x)], 1u);
            asm volatile("s_waitcnt vmcnt(0)" ::: "memory");
        } else {
            XB_SPIN(xb_ld(&bar[XB_XGEN(b.x)]) == gen, bar);
            if (FENCES) __builtin_amdgcn_fence(__ATOMIC_ACQUIRE, "agent");
            asm volatile("s_waitcnt vmcnt(0)" ::: "memory");
        }
    }
    __syncthreads();
}

namespace pg8 {
constexpr int BM = 256, BK = 64, HALF = 128, HTB = HALF * BK * 2, STAGE_BYTES = 8 * HTB, NXCD = 8, WGM = 8;
__host__ __device__ __forceinline__ int lds_byte(int r, int c) { const int st = (r >> 4) * 2 + (c >> 5), rr = r & 15, cc = c & 31, ob = rr * 64 + cc * 2; return st * 1024 + (ob ^ (((ob >> 9) & 1) << 5)); }
__host__ __device__ __forceinline__ void stage_rc(int b, int& R, int& C) { const int st = b / 1024, sb = b % 1024, swz = sb ^ (((sb >> 9) & 1) << 5); R = (st >> 1) * 16 + swz / 64; C = (st & 1) * 32 + (swz % 64) / 2; }
struct Unit { int pm, pn, aux; };

struct DenseOrder {
    static constexpr bool GATHER = false;
    int nM, nN, nwg, G, c, skipctx; const char* Bt; size_t btile;
    __device__ __forceinline__ void init(int nM_, int nN_, int G_, int c_, const void* Bt_, int K, int skipctx_ = 0) { nM = nM_; nN = nN_; nwg = nM * nN; G = G_; c = c_; Bt = (const char*)Bt_; btile = (size_t)256 * K * 2; skipctx = skipctx_; }
    __device__ __forceinline__ bool next(int i, Unit& u) const {
        const long L = (long)i * G + c; if (L >= nwg) return false;
        int wgid = (int)L; { const int q = nwg / NXCD, r = nwg % NXCD, xcd = wgid % NXCD, off = wgid / NXCD; wgid = (xcd < r ? xcd * (q + 1) : r * (q + 1) + (xcd - r) * q) + off; }
        const int nig = WGM * nN, gid = wgid / nig, fm = gid * WGM, gsz = (nM - fm) < WGM ? (nM - fm) : WGM;
        u.pm = fm + ((wgid % nig) % gsz); u.pn = (wgid % nig) / gsz; u.aux = 0; if (skipctx && u.pm >= 64) u.pm += 1; return true;
    }
    __device__ __forceinline__ unsigned arow(const Unit& u, int r) const { return 0u; }
    __device__ __forceinline__ const char* bptr(const Unit& u) const { return Bt + (size_t)u.pn * btile; }
};
template <int NPN, bool GATHER_> struct MoeOrder {
    static constexpr bool GATHER = GATHER_;
    int nunits, G, vcu; const char* W; size_t estride, btile; const LAS int* rowtab; const LAS int* etab;
    __device__ __forceinline__ bool next(int i, Unit& u) const {
        const int L = i * G + vcu; if (L >= nunits) return false;
        u.pm = L / NPN; u.pn = L % NPN; u.aux = i; return true;
    }
    __device__ __forceinline__ unsigned arow(const Unit& u, int r) const { return (unsigned)rowtab[u.aux * 256 + r]; }
    __device__ __forceinline__ const char* bptr(const Unit& u) const { return W + (size_t)etab[u.aux] * estride + (size_t)u.pn * btile; }
};

template <class Epi, class Sched>
__device__ __forceinline__ void gemm_phase(LAS unsigned char* lds, const bf16_t* A, int lda, int K, const Sched& S, const Epi& E, int ldb = 0) {
    if (ldb == 0) ldb = K;
    constexpr bool GATHER = Sched::GATHER;
    const int tid = opaque_tid(), wid = __builtin_amdgcn_readfirstlane(tid >> 6), lane = tid & 63, wr = wid >> 2, wc = wid & 3, fr = lane & 15, fq = lane >> 4;
    const int nt = K / BK;
    int R0, C0, R1, C1; stage_rc(tid * 16, R0, C0); stage_rc(tid * 16 + 8192, R1, C1);
    const unsigned vb0 = (unsigned)(R0 * ldb + C0) * 2u, vb1 = (unsigned)(R1 * ldb + C1) * 2u;
    const unsigned lda2 = (unsigned)lda * 2u;
    const size_t kstep = (size_t)(BK * 2);
    const size_t hstepB = (size_t)HALF * ldb * 2;
    const size_t hstepA = GATHER ? (size_t)0 : (size_t)HALF * lda2, tstepA = GATHER ? (size_t)0 : (size_t)256 * lda2;
    const unsigned ldsw = (unsigned)wid * 1024u;
    const int aoff = lds_byte(wr * 64 + fr, fq * 8), boff = lds_byte(wc * 32 + fr, fq * 8);
    const char* gA = (const char*)A;
#define PG8_SA(b, h) (((b) * 2 + (h)) * HTB)
#define PG8_SB(b, h) ((4 + (b) * 2 + (h)) * HTB)
#define PG8_STAGE(bufoff, gbase, o0, o1) do { \
        __builtin_amdgcn_global_load_lds((const unsigned*)((const char*)(gbase) + (o0)), (LAS unsigned*)(lds + (bufoff) + ldsw), 16, 0, 0); \
        __builtin_amdgcn_global_load_lds((const unsigned*)((const char*)(gbase) + (o1)), (LAS unsigned*)(lds + (bufoff) + ldsw + 8192), 16, 0, 0); } while (0)
#define PG8_LDA(dst, b, h) do { _Pragma("unroll") for (int m = 0; m < 4; ++m) _Pragma("unroll") for (int k = 0; k < 2; ++k) dst[m][k] = *(const LAS bf16x8*)(lds + PG8_SA(b, h) + aoff + m * 2048 + k * 1024); } while (0)
#define PG8_LDB(dst, b, h) do { _Pragma("unroll") for (int n = 0; n < 2; ++n) _Pragma("unroll") for (int k = 0; k < 2; ++k) dst[n][k] = *(const LAS bf16x8*)(lds + PG8_SB(b, h) + boff + n * 2048 + k * 1024); } while (0)
#define PG8_MMA(ai, bj, At, Bt) do { __builtin_amdgcn_s_setprio(1); _Pragma("unroll") for (int m = 0; m < 4; ++m) _Pragma("unroll") for (int n = 0; n < 2; ++n) _Pragma("unroll") for (int k = 0; k < 2; ++k) \
        acc[ai][bj][m][n] = __builtin_amdgcn_mfma_f32_16x16x32_bf16(Bt[n][k], At[m][k], acc[ai][bj][m][n], 0, 0, 0); __builtin_amdgcn_s_setprio(0); } while (0)
#define PG8_WAIT_V(n) asm volatile("s_waitcnt vmcnt(" #n ")" ::: "memory")
#define PG8_WAIT_L(n) asm volatile("s_waitcnt lgkmcnt(" #n ")" ::: "memory")
#define PG8_BAR __builtin_amdgcn_s_barrier()
#define PG8_SCHED __builtin_amdgcn_sched_barrier(0)
    Unit cur, nxt; int ui = 0;
    if (!S.next(0, cur)) return;
    f32x4 acc[2][2][4][2];
#pragma unroll
    for (int a = 0; a < 2; ++a)
#pragma unroll
        for (int b = 0; b < 2; ++b)
#pragma unroll
            for (int m = 0; m < 4; ++m)
#pragma unroll
                for (int n = 0; n < 2; ++n) acc[a][b][m][n] = (f32x4){0.f, 0.f, 0.f, 0.f};
    bf16x8 At[4][2], B0[2][2], B1[2][2];
    unsigned o00, o01, o10, o11;
    if constexpr (GATHER) { o00 = S.arow(cur, R0) * lda2 + (unsigned)(C0 * 2); o01 = S.arow(cur, R1) * lda2 + (unsigned)(C1 * 2); o10 = S.arow(cur, 128 + R0) * lda2 + (unsigned)(C0 * 2); o11 = S.arow(cur, 128 + R1) * lda2 + (unsigned)(C1 * 2); }
    else { o00 = (unsigned)R0 * lda2 + (unsigned)(C0 * 2); o01 = (unsigned)R1 * lda2 + (unsigned)(C1 * 2); o10 = o00; o11 = o01; }
    const char* cA = gA + (size_t)cur.pm * tstepA;
    const char* cB = S.bptr(cur);
    PG8_STAGE(PG8_SB(0, 0), cB, vb0, vb1); PG8_STAGE(PG8_SB(0, 1), cB + hstepB, vb0, vb1); PG8_STAGE(PG8_SA(0, 0), cA, o00, o01); PG8_STAGE(PG8_SA(0, 1), cA + hstepA, o10, o11);
    if (wr == 1) PG8_BAR;
    PG8_WAIT_V(2); PG8_BAR;
    PG8_STAGE(PG8_SB(1, 0), cB + kstep, vb0, vb1); PG8_STAGE(PG8_SA(1, 0), cA + kstep, o00, o01); PG8_STAGE(PG8_SB(1, 1), cB + hstepB + kstep, vb0, vb1);
    PG8_WAIT_V(6); PG8_BAR;
    for (;;) {
        const bool has_next = S.next(ui + 1, nxt);
        const char* nA = has_next ? gA + (size_t)nxt.pm * tstepA : cA; const char* nB = has_next ? S.bptr(nxt) : cB;
        for (int t = 0; t < nt; t += 2) {
            const bool last = (t == nt - 2);
            const char* a1 = cA + (size_t)(t + 1) * kstep;
            const char* a2 = last ? nA : cA + (size_t)(t + 2) * kstep; const char* b2 = last ? nB : cB + (size_t)(t + 2) * kstep;
            const char* a3 = a2 + kstep; const char* b3 = b2 + kstep;
            unsigned s00 = o00, s01 = o01, s10 = o10, s11 = o11;
            if constexpr (GATHER) { if (last && has_next) { s00 = S.arow(nxt, R0) * lda2 + (unsigned)(C0 * 2); s01 = S.arow(nxt, R1) * lda2 + (unsigned)(C1 * 2); s10 = S.arow(nxt, 128 + R0) * lda2 + (unsigned)(C0 * 2); s11 = S.arow(nxt, 128 + R1) * lda2 + (unsigned)(C1 * 2); } }
            PG8_LDB(B0, 0, 0); PG8_LDB(B1, 0, 1); PG8_SCHED; PG8_LDA(At, 0, 0); PG8_STAGE(PG8_SA(1, 1), a1 + hstepA, o10, o11);
            PG8_WAIT_V(8); PG8_WAIT_L(0); PG8_BAR; PG8_MMA(0, 0, At, B0); PG8_MMA(0, 1, At, B1); PG8_BAR; PG8_SCHED;
            PG8_LDA(At, 0, 1); PG8_STAGE(PG8_SB(0, 0), b2, vb0, vb1); PG8_STAGE(PG8_SB(0, 1), b2 + hstepB, vb0, vb1); PG8_STAGE(PG8_SA(0, 0), a2, s00, s01);
            PG8_WAIT_V(8); PG8_WAIT_L(0); PG8_BAR; PG8_MMA(1, 0, At, B0); PG8_MMA(1, 1, At, B1); PG8_BAR; PG8_SCHED;
            PG8_LDB(B0, 1, 0); PG8_LDB(B1, 1, 1); PG8_SCHED; PG8_LDA(At, 1, 0); PG8_STAGE(PG8_SA(0, 1), a2 + hstepA, s10, s11);
            PG8_WAIT_V(8); PG8_WAIT_L(0); PG8_BAR; PG8_MMA(0, 0, At, B0); PG8_MMA(0, 1, At, B1); PG8_BAR; PG8_SCHED;
            PG8_LDA(At, 1, 1); PG8_STAGE(PG8_SB(1, 0), b3, vb0, vb1); PG8_STAGE(PG8_SB(1, 1), b3 + hstepB, vb0, vb1); PG8_STAGE(PG8_SA(1, 0), a3, s00, s01);
            PG8_WAIT_V(8); PG8_WAIT_L(0); PG8_BAR; PG8_MMA(1, 0, At, B0); PG8_MMA(1, 1, At, B1); PG8_BAR; PG8_SCHED;
        }
        if (wr == 0) PG8_BAR;
        { const int t2 = opaque_tid(), w2 = __builtin_amdgcn_readfirstlane(t2 >> 6); E(acc, cur, w2 >> 2, w2 & 3, t2 & 15, (t2 & 63) >> 4); }
        if (!has_next) break;
#pragma unroll
        for (int a = 0; a < 2; ++a)
#pragma unroll
            for (int b = 0; b < 2; ++b)
#pragma unroll
                for (int m = 0; m < 4; ++m)
#pragma unroll
                    for (int n = 0; n < 2; ++n) acc[a][b][m][n] = (f32x4){0.f, 0.f, 0.f, 0.f};
        cur = nxt; cA = nA; cB = nB; ++ui;
        if constexpr (GATHER) { o00 = S.arow(cur, R0) * lda2 + (unsigned)(C0 * 2); o01 = S.arow(cur, R1) * lda2 + (unsigned)(C1 * 2); o10 = S.arow(cur, 128 + R0) * lda2 + (unsigned)(C0 * 2); o11 = S.arow(cur, 128 + R1) * lda2 + (unsigned)(C1 * 2); }
        if (wr == 1) PG8_BAR;
    }
    PG8_WAIT_V(0);
    PG8_BAR;
#undef PG8_SA
#undef PG8_SB
#undef PG8_STAGE
#undef PG8_LDA
#undef PG8_LDB
#undef PG8_MMA
#undef PG8_WAIT_V
#undef PG8_WAIT_L
#undef PG8_BAR
#undef PG8_SCHED
}
}

typedef const f32x4 (&AccRef)[2][2][4][2];
#define EPI_ROW(u, ai, m) ((u).pm * 256 + (ai) * 128 + wr * 64 + (m) * 16 + fr)
#define EPI_COL(bj, n) ((bj) * 128 + wc * 32 + (n) * 16 + 4 * fq)

__device__ __forceinline__ unsigned pk4_fp8(f32x4 v) { int w = 0; w = __builtin_amdgcn_cvt_pk_fp8_f32(v.x, v.y, w, false); w = __builtin_amdgcn_cvt_pk_fp8_f32(v.z, v.w, w, true); return (unsigned)w; }
__device__ __forceinline__ f32x4 unpk4_fp8(unsigned w) { return (f32x4){__builtin_amdgcn_cvt_f32_fp8((int)w, 0), __builtin_amdgcn_cvt_f32_fp8((int)w, 1), __builtin_amdgcn_cvt_f32_fp8((int)w, 2), __builtin_amdgcn_cvt_f32_fp8((int)w, 3)}; }
constexpr float IN8_SCALE = 16.f;
__device__ __forceinline__ u32x4 fp8x8_to_bf16x8(u32x4 w) { const u32x2 lo = pk4(unpk4_fp8(w.x) * (1.f / IN8_SCALE)), hi = pk4(unpk4_fp8(w.y) * (1.f / IN8_SCALE)); return (u32x4){lo.x, lo.y, hi.x, hi.y}; }
struct EpiInProj {
    bf16_t *Q, *K, *V, *QKM, *VM, *OMS, *GA, *GB; float* GATES; const float* b_gates; const f32x2* rope; unsigned* mstab;
    __device__ __forceinline__ void operator()(AccRef acc, const pg8::Unit& u, int wr, int wc, int fr, int fq) const {
        const int b = u.pm / 65, tile = u.pm % 65; const bool is_ctx = (tile == 64);
        if (u.pn == 32) {
            if (wc != 0) return;
            const f32x4 bg = *(const f32x4*)(b_gates + 4 * fq);
            f32x4 mx = (f32x4){0.f, 0.f, 0.f, 0.f};
#pragma unroll
            for (int ai = 0; ai < 2; ++ai)
#pragma unroll
                for (int m = 0; m < 4; ++m) { const f32x4 g = acc[ai][0][m][0] + bg; *(f32x4*)(GATES + (size_t)EPI_ROW(u, ai, m) * 16 + 4 * fq) = g;
                    mx.x = fmaxf(mx.x, g.x); mx.y = fmaxf(mx.y, g.y); mx.z = fmaxf(mx.z, g.z); mx.w = fmaxf(mx.w, g.w); }
#pragma unroll
            for (int o = 1; o < 16; o <<= 1) { mx.x = fmaxf(mx.x, __shfl_xor(mx.x, o)); mx.y = fmaxf(mx.y, __shfl_xor(mx.y, o)); mx.z = fmaxf(mx.z, __shfl_xor(mx.z, o)); mx.w = fmaxf(mx.w, __shfl_xor(mx.w, o)); }
            if (fr == 0 && (fq == 0 || fq == 2)) { const int dir = fq >> 1;
                const unsigned r0 = atomicMax(mstab + (b * 4 + 0) * 2 + dir, __float_as_uint(mx.x)), r1 = atomicMax(mstab + (b * 4 + 1) * 2 + dir, __float_as_uint(mx.y));
                const unsigned r2 = atomicMax(mstab + (b * 4 + 2) * 2 + dir, __float_as_uint(mx.z)), r3 = atomicMax(mstab + (b * 4 + 3) * 2 + dir, __float_as_uint(mx.w));
                asm volatile("" :: "v"(r0), "v"(r1), "v"(r2), "v"(r3)); }
            return;
        }
        const int grp = u.pn >> 2, cbase = (u.pn & 3) * 256;
        bf16_t* dst = grp == 0 ? Q : grp == 1 ? K : grp == 2 ? V : grp == 3 ? QKM : grp == 4 ? VM : grp == 5 ? OMS : grp == 6 ? GA : GB;
        if (grp <= 1 && !is_ctx) {
            const bool colrot = (wc & 1) != 0; const float qs = grp == 0 ? QSCALE : 1.f;
#pragma unroll
            for (int ai = 0; ai < 2; ++ai) { f32x4 csa[4], csb[4];
#pragma unroll
                for (int m = 0; m < 4; ++m) { const int t = tile * 256 + ai * 128 + wr * 64 + m * 16 + fr; const int pos = colrot ? (t & 63) : (t >> 6);
                    csa[m] = *(const f32x4*)(rope + pos * 16 + 4 * fq); csb[m] = *(const f32x4*)(rope + pos * 16 + 4 * fq + 2); }
#pragma unroll
                for (int m = 0; m < 4; ++m) { const int row = EPI_ROW(u, ai, m);
                    const f32x4 cs0 = csa[m], cs1 = csb[m];
                    const f32x4 cv = (f32x4){cs0.x, cs0.z, cs1.x, cs1.z}, sv = (f32x4){cs0.y, cs0.w, cs1.y, cs1.w};
#pragma unroll
                    for (int bj = 0; bj < 2; ++bj) { const f32x4 x0 = acc[ai][bj][m][0], x1 = acc[ai][bj][m][1];
                        const f32x4 o0 = (x0 * cv - x1 * sv) * qs, o1 = (x1 * cv + x0 * sv) * qs;
                        bf16_t* p = dst + (size_t)row * 1024 + cbase + EPI_COL(bj, 0);
                        *(u32x2*)p = pk4(o0); *(u32x2*)(p + 16) = pk4(o1); } } }
            return;
        }
        const bool sig = grp >= 5; const float qs2 = grp == 0 ? QSCALE : 1.f;
#pragma unroll
        for (int ai = 0; ai < 2; ++ai)
#pragma unroll
            for (int m = 0; m < 4; ++m) { const int row = EPI_ROW(u, ai, m);
#pragma unroll
                for (int bj = 0; bj < 2; ++bj) { u32x2 pk[2];
#pragma unroll
                    for (int n = 0; n < 2; ++n) { f32x4 v = acc[ai][bj][m][n] * qs2;
                        if (sig) { v.x = sigmoidf_(v.x); v.y = sigmoidf_(v.y); v.z = sigmoidf_(v.z); v.w = sigmoidf_(v.w); }
                        pk[n] = pk4(v); }
                    bf16_t* p = dst + (size_t)row * 1024 + cbase;
                    if (grp == 3 || grp == 4) *(u32x2*)((unsigned char*)dst + (size_t)row * 1024 + cbase + bj * 128 + wc * 32 + 8 * fq) = (u32x2){pk4_fp8(acc[ai][bj][m][0] * IN8_SCALE), pk4_fp8(acc[ai][bj][m][1] * IN8_SCALE)};
                    else if (grp >= 2) *(u32x4*)(p + bj * 128 + wc * 32 + 8 * fq) = (u32x4){pk[0].x, pk[0].y, pk[1].x, pk[1].y};
                    else { *(u32x2*)(p + EPI_COL(bj, 0)) = pk[0]; *(u32x2*)(p + EPI_COL(bj, 1)) = pk[1]; } } }
    }
};
struct EpiGate1 {
    const bf16_t* G; bf16_t* O;
    __device__ __forceinline__ void operator()(AccRef acc, const pg8::Unit& u, int wr, int wc, int fr, int fq) const {
#pragma unroll
        for (int ai = 0; ai < 2; ++ai) { u32x4 gw[4][2];
#pragma unroll
            for (int m = 0; m < 4; ++m) { const size_t ro = (size_t)EPI_ROW(u, ai, m) * 1024 + u.pn * 256;
#pragma unroll
                for (int bj = 0; bj < 2; ++bj) gw[m][bj] = *(const u32x4*)(G + ro + bj * 128 + wc * 32 + 8 * fq); }
#pragma unroll
            for (int m = 0; m < 4; ++m) { const size_t ro = (size_t)EPI_ROW(u, ai, m) * 1024 + u.pn * 256;
#pragma unroll
                for (int bj = 0; bj < 2; ++bj) { const u32x4 g = gw[m][bj];
                    const u32x2 lo = pk4(unpk4((u32x2){g.x, g.y}) * acc[ai][bj][m][0]), hi = pk4(unpk4((u32x2){g.z, g.w}) * acc[ai][bj][m][1]);
                    *(u32x4*)(O + ro + bj * 128 + wc * 32 + 8 * fq) = (u32x4){lo.x, lo.y, hi.x, hi.y}; } } }
    }
};
struct EpiGate2 {
    const bf16_t* G; const bf16_t* T1; bf16_t* O;
    __device__ __forceinline__ void operator()(AccRef acc, const pg8::Unit& u, int wr, int wc, int fr, int fq) const {
#pragma unroll
        for (int ai = 0; ai < 2; ++ai) { u32x4 gw[4][2], tw[4][2];
#pragma unroll
            for (int m = 0; m < 4; ++m) { const size_t ro = (size_t)EPI_ROW(u, ai, m) * 1024 + u.pn * 256;
#pragma unroll
                for (int bj = 0; bj < 2; ++bj) { gw[m][bj] = *(const u32x4*)(G + ro + bj * 128 + wc * 32 + 8 * fq); tw[m][bj] = *(const u32x4*)(T1 + ro + bj * 128 + wc * 32 + 8 * fq); } }
#pragma unroll
            for (int m = 0; m < 4; ++m) { const size_t ro = (size_t)EPI_ROW(u, ai, m) * 1024 + u.pn * 256;
#pragma unroll
                for (int bj = 0; bj < 2; ++bj) { const u32x4 g = gw[m][bj], t = tw[m][bj];
                    const u32x2 lo = pk4(unpk4((u32x2){t.x, t.y}) + unpk4((u32x2){g.x, g.y}) * acc[ai][bj][m][0]), hi = pk4(unpk4((u32x2){t.z, t.w}) + unpk4((u32x2){g.z, g.w}) * acc[ai][bj][m][1]);
                    *(u32x4*)(O + ro + bj * 128 + wc * 32 + 8 * fq) = (u32x4){lo.x, lo.y, hi.x, hi.y}; } } }
    }
};
struct XSrc {
    const float* x; const float* ctx; const float* xcur; int layer;
    __device__ __forceinline__ const float* row(int r) const {
        if (layer) return xcur + (size_t)r * 1024;
        const int b = r / TPB, t = r % TPB;
        return t < SEQ ? x + ((size_t)b * SEQ + t) * 1024 : ctx + ((size_t)b * CTX + (t - SEQ)) * 1024;
    }
};
struct EpiOut {
    XSrc xs; const float* modv  ; float* R;
    __device__ __forceinline__ void operator()(AccRef acc, const pg8::Unit& u, int wr, int wc, int fr, int fq) const {
        const int b = u.pm / 65, set = (u.pm % 65 == 64) ? 2 : b; const float* gate = modv + set * 6144 + 2 * 1024 + u.pn * 256;
        f32x4 g[2][2];
#pragma unroll
        for (int bj = 0; bj < 2; ++bj)
#pragma unroll
            for (int n = 0; n < 2; ++n) g[bj][n] = *(const f32x4*)(gate + bj * 128 + wc * 32 + 8 * fq + 4 * n);
#pragma unroll
        for (int ai = 0; ai < 2; ++ai) { f32x4 xv[4][2][2];
#pragma unroll
            for (int m = 0; m < 4; ++m) { const float* xr = xs.row(EPI_ROW(u, ai, m)) + u.pn * 256;
#pragma unroll
                for (int bj = 0; bj < 2; ++bj)
#pragma unroll
                    for (int n = 0; n < 2; ++n) xv[m][bj][n] = *(const f32x4*)(xr + bj * 128 + wc * 32 + 8 * fq + 4 * n); }
#pragma unroll
            for (int m = 0; m < 4; ++m) { bf16_t* rr = (bf16_t*)R + (size_t)EPI_ROW(u, ai, m) * 1024 + u.pn * 256;
#pragma unroll
                for (int bj = 0; bj < 2; ++bj) { const u32x2 lo = pk4(xv[m][bj][0] * ALPHA_RES + g[bj][0] * acc[ai][bj][m][0]), hi = pk4(xv[m][bj][1] * ALPHA_RES + g[bj][1] * acc[ai][bj][m][1]);
                    *(u32x4*)(rr + bj * 128 + wc * 32 + 8 * fq) = (u32x4){lo.x, lo.y, hi.x, hi.y}; } } }
    }
};
struct EpiLogits {
    float* O;
    __device__ __forceinline__ void operator()(AccRef acc, const pg8::Unit& u, int wr, int wc, int fr, int fq) const {
#pragma unroll
        for (int ai = 0; ai < 2; ++ai)
#pragma unroll
            for (int m = 0; m < 4; ++m) { float* rr = O + (size_t)EPI_ROW(u, ai, m) * 256;
#pragma unroll
                for (int bj = 0; bj < 2; ++bj)
#pragma unroll
                    for (int n = 0; n < 2; ++n) *(f32x4*)(rr + EPI_COL(bj, n)) = acc[ai][bj][m][n]; }
    }
};
struct EpiSwiglu {
    bf16_t* HE;
    __device__ __forceinline__ void operator()(AccRef acc, const pg8::Unit& u, int wr, int wc, int fr, int fq) const {
#pragma unroll
        for (int ai = 0; ai < 2; ++ai)
#pragma unroll
            for (int m = 0; m < 4; ++m) { bf16_t* rr = HE + (size_t)EPI_ROW(u, ai, m) * 256 + u.pn * 128;
                u32x2 pk[2];
#pragma unroll
                for (int n = 0; n < 2; ++n) { const f32x4 a = acc[ai][0][m][n], g = acc[ai][1][m][n];
                    f32x4 o; o.x = siluf_(a.x) * g.x; o.y = siluf_(a.y) * g.y; o.z = siluf_(a.z) * g.z; o.w = siluf_(a.w) * g.w; pk[n] = pk4(o); }
                *(u32x4*)(rr + wc * 32 + 8 * fq) = (u32x4){pk[0].x, pk[0].y, pk[1].x, pk[1].y}; }
    }
};
constexpr float YB8_SCALE = 64.f;
struct EpiScaleRow {
    bf16_t* YB; const float* roww;
    __device__ __forceinline__ void operator()(AccRef acc, const pg8::Unit& u, int wr, int wc, int fr, int fq) const {
        float w8[2][4];
#pragma unroll
        for (int ai = 0; ai < 2; ++ai)
#pragma unroll
            for (int m = 0; m < 4; ++m) w8[ai][m] = roww[EPI_ROW(u, ai, m)];
#pragma unroll
        for (int ai = 0; ai < 2; ++ai)
#pragma unroll
            for (int m = 0; m < 4; ++m) { const int row = EPI_ROW(u, ai, m); const float w0 = w8[ai][m], w = w0 * YB8_SCALE;
#pragma unroll
                for (int bj = 0; bj < 2; ++bj)
                    if (w0 >= 0.f) *(u32x2*)((unsigned char*)YB + (size_t)row * 1024 + u.pn * 256 + bj * 128 + wc * 32 + 8 * fq) = (u32x2){pk4_fp8(acc[ai][bj][m][0] * w), pk4_fp8(acc[ai][bj][m][1] * w)};
                asm volatile("" ::: "memory"); }
    }
};

namespace att {
constexpr int QBLK = 32, KVBLK = 64, LDX = 1024;
constexpr float SCALE = 0.125f, THR = 8.f;
constexpr size_t SHM_V = KVBLK * 128 * 2, SHM_K = KVBLK * 64 * 2, SHM_ATTN = 2 * SHM_V + 2 * SHM_K + NWAVES * 64 * 4;
#define KSWZ64(row, colB) ((row) * 128 + ((colB) ^ ((((row) >> 1) & 7) << 4)))
#define SBAR() __builtin_amdgcn_sched_barrier(0)
__device__ __forceinline__ int crow(int r, int hi) { return (r & 3) + 8 * (r >> 2) + 4 * hi; }
__device__ __forceinline__ unsigned cvtpk(float lo, float hi) { unsigned r; asm volatile("v_cvt_pk_bf16_f32 %0, %1, %2" : "=v"(r) : "v"(lo), "v"(hi)); return r; }
__device__ __forceinline__ void partialSM(f32x16& p0, f32x16& p1, float& m_reg, float& mn, float& alpha) {
  constexpr float C = SCALE * 1.4426950408889634f;
  float pmax = p0[0];
#pragma unroll
  for (int r = 1; r < 16; ++r) pmax = fmaxf(pmax, p0[r]);
#pragma unroll
  for (int r = 0; r < 16; ++r) pmax = fmaxf(pmax, p1[r]);
  { auto rr = __builtin_amdgcn_permlane32_swap(__float_as_uint(pmax), __float_as_uint(pmax), false, false);
    pmax = fmaxf(__uint_as_float(rr[0]), __uint_as_float(rr[1])); }
  if (__builtin_expect(__all(pmax - m_reg <= THR / SCALE), 1)) { mn = m_reg; alpha = 1.f; }
  else { mn = fmaxf(m_reg, pmax); alpha = __builtin_amdgcn_exp2f((m_reg - mn) * C); m_reg = mn; }
  float mnC = -mn * C;
#pragma unroll
  for (int r = 0; r < 16; ++r) p0[r] = fmaf(p0[r], C, mnC);
#pragma unroll
  for (int r = 0; r < 16; ++r) p1[r] = fmaf(p1[r], C, mnC);
#pragma unroll
  for (int r = 0; r < 16; ++r) p0[r] = __builtin_amdgcn_exp2f(p0[r]);
}
__device__ __forceinline__ void finishSM(f32x16& p0, f32x16& p1, float alpha, float& l_reg, bf16x8& pa0, bf16x8& pa1, bf16x8& pa2, bf16x8& pa3) {
#pragma unroll
  for (int r = 0; r < 16; ++r) p1[r] = __builtin_amdgcn_exp2f(p1[r]);
  float ps = 0;
#pragma unroll
  for (int r = 0; r < 16; ++r) ps += p0[r];
#pragma unroll
  for (int r = 0; r < 16; ++r) ps += p1[r];
  { auto rr = __builtin_amdgcn_permlane32_swap(__float_as_uint(ps), __float_as_uint(ps), false, false);
    ps = __uint_as_float(rr[0]) + __uint_as_float(rr[1]); }
  l_reg = l_reg * alpha + ps;
#define PK4(P, BASE, OUT) do { u32x4 w = {cvtpk(P[BASE + 0], P[BASE + 1]), cvtpk(P[BASE + 2], P[BASE + 3]), cvtpk(P[BASE + 4], P[BASE + 5]), cvtpk(P[BASE + 6], P[BASE + 7])}; \
    OUT = *reinterpret_cast<bf16x8*>(&w); } while (0)
  PK4(p0, 0, pa0); PK4(p0, 8, pa1); PK4(p1, 0, pa2); PK4(p1, 8, pa3);
#undef PK4
}
__device__ __forceinline__ void qkt(f32x16& p0, f32x16& p1, const char* Ks, const bf16x8* qr, int r32, int hi) {
  p0 = f32x16{}; p1 = f32x16{};
#pragma unroll
  for (int d0 = 0; d0 < 4; ++d0) { const int cb = (d0 * 16 + hi * 8) * 2;
    bf16x8 b0 = *reinterpret_cast<const bf16x8*>(Ks + KSWZ64(r32, cb));
    bf16x8 b1 = *reinterpret_cast<const bf16x8*>(Ks + KSWZ64(32 + r32, cb));
    p0 = __builtin_amdgcn_mfma_f32_32x32x16_bf16(b0, qr[d0], p0, 0, 0, 0);
    p1 = __builtin_amdgcn_mfma_f32_32x32x16_bf16(b1, qr[d0], p1, 0, 0, 0); }
}
__device__ __forceinline__ int v_st(int k, int c) { const int kk = (k & ~0xC) | ((k & 4) << 1) | ((k & 8) >> 1); return ((kk >> 3) * 4 + (c >> 5)) * 512 + ((kk & 7) * 32 + (c & 31)) * 2; }
__device__ __forceinline__ int v_rd_base(int lane) { return ((lane & 3) << 3) | (((lane >> 2) & 3) << 6) | (((lane >> 4) & 1) << 5) | (((lane >> 5) & 1) << 8); }
constexpr int v_rd_off(int d0, int ks, int half) { return d0 * 512 + ks * 4096 + half * 2048; }
template <int OFF> __device__ __forceinline__ s16x4 tr_read(int vb) {
  s16x4 r; asm volatile("ds_read_b64_tr_b16 %0, %1 offset:%2" : "=&v"(r) : "v"(vb), "i"(OFF) : "memory"); return r;
}
template <int I> __device__ __forceinline__ void pv_rd(s16x4& L, s16x4& H, int vb) { L = tr_read<v_rd_off(I >> 2, I & 3, 0)>(vb); H = tr_read<v_rd_off(I >> 2, I & 3, 1)>(vb); }
template <int N> __device__ __forceinline__ void pv_wait(s16x4& L, s16x4& H) { asm volatile("s_waitcnt lgkmcnt(%2)" : "+v"(L), "+v"(H) : "i"(N) : "memory"); }
__device__ __forceinline__ void pv_d0(f32x16* o, int vb, bf16x8 pa0, bf16x8 pa1, bf16x8 pa2, bf16x8 pa3) {
  s16x4 L0, H0, L1, H1, L2, H2, L3, H3;
#define PK(L, H) (bf16x8){L[0], L[1], L[2], L[3], H[0], H[1], H[2], H[3]}
#define PVM(I, PA, L, H, CNT) do { pv_wait<CNT>(L, H); o[(I) >> 2] = __builtin_amdgcn_mfma_f32_32x32x16_bf16(PA, PK(L, H), o[(I) >> 2], 0, 0, 0); } while (0)
  pv_rd<0>(L0, H0, vb); pv_rd<1>(L1, H1, vb); pv_rd<2>(L2, H2, vb);
  PVM(0, pa0, L0, H0, 4);  pv_rd<3>(L3, H3, vb);
  PVM(1, pa1, L1, H1, 4);  pv_rd<4>(L0, H0, vb);
  PVM(2, pa2, L2, H2, 4);  pv_rd<5>(L1, H1, vb);
  PVM(3, pa3, L3, H3, 4);  pv_rd<6>(L2, H2, vb);
  PVM(4, pa0, L0, H0, 4);  pv_rd<7>(L3, H3, vb);
  PVM(5, pa1, L1, H1, 4);  pv_rd<8>(L0, H0, vb);
  PVM(6, pa2, L2, H2, 4);  pv_rd<9>(L1, H1, vb);
  PVM(7, pa3, L3, H3, 4);  pv_rd<10>(L2, H2, vb);
  PVM(8, pa0, L0, H0, 4);  pv_rd<11>(L3, H3, vb);
  PVM(9, pa1, L1, H1, 4);  pv_rd<12>(L0, H0, vb);
  PVM(10, pa2, L2, H2, 4); pv_rd<13>(L1, H1, vb);
  PVM(11, pa3, L3, H3, 4); pv_rd<14>(L2, H2, vb);
  PVM(12, pa0, L0, H0, 4); pv_rd<15>(L3, H3, vb);
  PVM(13, pa1, L1, H1, 4);
  PVM(14, pa2, L2, H2, 2);
  PVM(15, pa3, L3, H3, 0);
#undef PVM
#undef PK
}
constexpr int NSLOT = 4, NVSLOT = 5, KSLOT = 8192, VSLOT = 16384, LDS_K = 0, LDS_V = NSLOT * KSLOT, LDS_WS = LDS_V + NVSLOT * VSLOT, LDS_END = LDS_WS + NWAVES * 64 * 4;
static_assert(LDS_END <= RING_BYTES, "attention LDS");
constexpr float THR2 = 8.f;
__device__ __forceinline__ void glds16(const void* sbase, unsigned voff, unsigned lds_dst) { unsigned keep;
  asm volatile("s_mov_b32 %0, m0\n\ts_mov_b32 m0, %3\n\ts_nop 2\n\tglobal_load_lds_dwordx4 %1, %2\n\ts_mov_b32 m0, %0" : "=&s"(keep) : "v"(voff), "s"(sbase), "s"(lds_dst) : "memory"); }
#define WAIT_BAR(N) asm volatile("s_waitcnt vmcnt(" #N ") lgkmcnt(0)\n\ts_barrier" ::: "memory")
__device__ __forceinline__ float rowmax32(const f32x16& p0, const f32x16& p1) {
  float a = fmaxf(fmaxf(p0[0], p0[1]), p1[0]), b = fmaxf(fmaxf(p0[2], p0[3]), p1[1]); a = fmaxf(fmaxf(a, p1[2]), p1[3]);
#pragma unroll
  for (int r = 4; r < 16; r += 4) { a = fmaxf(fmaxf(a, p0[r]), p0[r + 1]); b = fmaxf(fmaxf(b, p0[r + 2]), p0[r + 3]); a = fmaxf(fmaxf(a, p1[r]), p1[r + 1]); b = fmaxf(fmaxf(b, p1[r + 2]), p1[r + 3]); }
  float m = fmaxf(a, b);
  auto rr = __builtin_amdgcn_permlane32_swap(__float_as_uint(m), __float_as_uint(m), false, false);
  return fmaxf(__uint_as_float(rr[0]), __uint_as_float(rr[1]));
}
template <bool FIRST> __device__ __forceinline__ void partialSM2(f32x16& p0, f32x16& p1, float& m_reg, f32x16& negm, float& alpha) {
  const float pmax = rowmax32(p0, p1);
  if (FIRST || !__builtin_expect(__all(pmax <= THR2), 1)) {
    const float dl = FIRST ? pmax : fmaxf(pmax, 0.f); m_reg += dl;
#pragma unroll
    for (int r = 0; r < 16; ++r) { p0[r] -= dl; p1[r] -= dl; }
#pragma unroll
    for (int r = 0; r < 16; ++r) negm[r] = -m_reg;
    alpha = FIRST ? 1.f : __builtin_amdgcn_exp2f(-dl);
  } else alpha = 1.f;
#pragma unroll
  for (int r = 0; r < 16; ++r) p0[r] = __builtin_amdgcn_exp2f(p0[r]);
}
__device__ __forceinline__ void qkt2(f32x16& p0, f32x16& p1, const char* Ks, const bf16x8* qr, const f32x16& negm, int r32, int hi) {
#pragma unroll
  for (int d0 = 0; d0 < 4; ++d0) { const int cb = (d0 * 16 + hi * 8) * 2;
    bf16x8 b0 = *reinterpret_cast<const bf16x8*>(Ks + KSWZ64(r32, cb));
    bf16x8 b1 = *reinterpret_cast<const bf16x8*>(Ks + KSWZ64(32 + r32, cb));
    if (d0 == 0) { p0 = __builtin_amdgcn_mfma_f32_32x32x16_bf16(b0, qr[0], negm, 0, 0, 0); p1 = __builtin_amdgcn_mfma_f32_32x32x16_bf16(b1, qr[0], negm, 0, 0, 0); }
    else { p0 = __builtin_amdgcn_mfma_f32_32x32x16_bf16(b0, qr[d0], p0, 0, 0, 0); p1 = __builtin_amdgcn_mfma_f32_32x32x16_bf16(b1, qr[d0], p1, 0, 0, 0); } }
}
__device__ __forceinline__ int swap23(int k) { return (k & ~0xC) | ((k & 4) << 1) | ((k & 8) >> 1); }
__device__ __forceinline__ void attn_body(const bf16_t* __restrict__ Qb, const bf16_t* __restrict__ Kh, const bf16_t* __restrict__ Vh, bf16_t* __restrict__ Ob, int seq, char* lds) {
  const int tid = opaque_tid(), wid = __builtin_amdgcn_readfirstlane(tid >> 6), lane = tid & 63, r32 = lane & 31, hi = lane >> 5;
  const unsigned lds0 = (unsigned)(uintptr_t)lds;
  const char* K_lds = lds + LDS_K;
  float* ws = (float*)(lds + LDS_WS) + wid * 64; float* li_l = ws; float* al_l = ws + 32;
  float m_reg = 0.f, l_reg = 0.f; f32x16 o[4] = {}; bf16x8 qr[4]; f32x16 negm = {};
  const bf16_t* Qw = Qb + (long)(wid * QBLK + r32) * LDX + hi * 8;
#pragma unroll
  for (int d0 = 0; d0 < 4; ++d0) qr[d0] = *reinterpret_cast<const bf16x8*>(Qw + d0 * 16);
  const int rowK = tid >> 3, cK = (tid & 7) ^ ((rowK >> 1) & 7);
  const unsigned ksrc = (unsigned)(rowK * LDX + cK * 8) * 2u;
  const int U0 = tid, U1 = 512 + tid;
  const int sub0 = U0 >> 5, sub1 = U1 >> 5;
  const unsigned vsrc0 = (unsigned)(((sub0 >> 2) * 8 + ((U0 >> 2) & 7)) * LDX + (sub0 & 3) * 32 + (U0 & 3) * 8) * 2u;
  const unsigned vsrc1 = (unsigned)(((sub1 >> 2) * 8 + ((U1 >> 2) & 7)) * LDX + (sub1 & 3) * 32 + (U1 & 3) * 8) * 2u;
  const unsigned kdst = lds0 + LDS_K + wid * 1024, vdst = lds0 + LDS_V + wid * 1024;
#define DMA(t) do { const unsigned sl_ = (unsigned)((t) & 3), sv_ = (unsigned)((t) % NVSLOT); const long go_ = (long)(t) * KVBLK * LDX; \
    glds16(Kh + go_, ksrc, (unsigned)__builtin_amdgcn_readfirstlane(kdst + sl_ * KSLOT)); glds16(Vh + go_, vsrc0, (unsigned)__builtin_amdgcn_readfirstlane(vdst + sv_ * VSLOT)); \
    glds16(Vh + go_, vsrc1, (unsigned)__builtin_amdgcn_readfirstlane(vdst + sv_ * VSLOT + 8192)); } while (0)
#define RESC(a) do { if (__any((a) < 1.f)) { if (hi == 0) al_l[r32] = (a); asm volatile("s_waitcnt lgkmcnt(0)" ::: "memory"); \
    _Pragma("unroll") for (int d = 0; d < 4; ++d) _Pragma("unroll") for (int r = 0; r < 16; ++r) o[d][r] *= al_l[crow(r, hi)]; } } while (0)
  const int vb0 = (int)(lds0 + LDS_V) + v_rd_base(lane);
  f32x16 pA0, pA1, pB0, pB1; float alA, alB; bf16x8 pa0, pa1, pa2, pa3; const int NT = seq / KVBLK;
  asm volatile("s_waitcnt vmcnt(0)" ::: "memory");
  if (wid < 4) __builtin_amdgcn_s_setprio(3);
  DMA(0); DMA(1);
  WAIT_BAR(3);
  DMA(2);
#define VSL(t) ((int)((t) % NVSLOT) * VSLOT)
  if (wid < 4) {
    qkt2(pA0, pA1, K_lds, qr, negm, r32, hi); partialSM2<true>(pA0, pA1, m_reg, negm, alA);
#define STEP(C0, C1, alC, P0, P1, alP, jj, WN) do { WAIT_BAR(WN); if ((jj) + 2 < NT) DMA((jj) + 2); \
      SBAR(); qkt2(C0, C1, K_lds + ((jj) & 3) * KSLOT, qr, negm, r32, hi); finishSM(P0, P1, alP, l_reg, pa0, pa1, pa2, pa3); SBAR(); \
      pv_d0(o, vb0 + VSL((jj) - 1), pa0, pa1, pa2, pa3); partialSM2<false>(C0, C1, m_reg, negm, alC); RESC(alC); } while (0)
    int j = 1;
    for (; j + 1 < NT; j += 2) { STEP(pB0, pB1, alB, pA0, pA1, alA, j, 3); STEP(pA0, pA1, alA, pB0, pB1, alB, j + 1, 3); }
    STEP(pB0, pB1, alB, pA0, pA1, alA, NT - 1, 0);
#undef STEP
  } else {
    qkt2(pA0, pA1, K_lds, qr, negm, r32, hi);
    WAIT_BAR(3); if (3 < NT) DMA(3);
    partialSM2<true>(pA0, pA1, m_reg, negm, alA);
    SBAR(); qkt2(pB0, pB1, K_lds + KSLOT, qr, negm, r32, hi); finishSM(pA0, pA1, alA, l_reg, pa0, pa1, pa2, pa3); SBAR();
#define STEPL(C0, C1, P0, P1, alP, jj, WN) do { WAIT_BAR(WN); if ((jj) + 2 < NT) DMA((jj) + 2); \
      pv_d0(o, vb0 + VSL((jj) - 2), pa0, pa1, pa2, pa3); partialSM2<false>(P0, P1, m_reg, negm, alP); RESC(alP); \
      SBAR(); qkt2(C0, C1, K_lds + ((jj) & 3) * KSLOT, qr, negm, r32, hi); finishSM(P0, P1, alP, l_reg, pa0, pa1, pa2, pa3); SBAR(); } while (0)
    int j = 2;
    for (; j + 2 < NT; j += 2) { STEPL(pA0, pA1, pB0, pB1, alB, j, 3); STEPL(pB0, pB1, pA0, pA1, alA, j + 1, 3); }
    STEPL(pA0, pA1, pB0, pB1, alB, NT - 2, 3); STEPL(pB0, pB1, pA0, pA1, alA, NT - 1, 0);
#undef STEPL
    pv_d0(o, vb0 + VSL(NT - 2), pa0, pa1, pa2, pa3); partialSM2<false>(pB0, pB1, m_reg, negm, alB); RESC(alB);
  }
  finishSM(pB0, pB1, alB, l_reg, pa0, pa1, pa2, pa3); SBAR();
  pv_d0(o, vb0 + VSL(NT - 1), pa0, pa1, pa2, pa3);
#undef VSL
  if (hi == 0) li_l[r32] = l_reg; asm volatile("s_waitcnt lgkmcnt(0)" ::: "memory");
  float rli[16];
#pragma unroll
  for (int r = 0; r < 16; ++r) rli[r] = __builtin_amdgcn_rcpf(li_l[crow(r, hi)]);
  bf16_t* Ow = Ob + (long)(wid * QBLK) * 2048;
#pragma unroll
  for (int r = 0; r < 16; ++r) { const int orow = crow(r, hi);
#pragma unroll
    for (int d0 = 0; d0 < 4; ++d0) Ow[(long)orow * 2048 + d0 * 32 + r32] = (bf16_t)f2bf(o[d0][r] * rli[r]); }
  __builtin_amdgcn_s_setprio(0);
  asm volatile("s_waitcnt lgkmcnt(0)\n\ts_barrier" ::: "memory");
#undef DMA
#undef RESC
#undef STEP
}
#undef WAIT_BAR
#undef SBAR
}

__device__ __forceinline__ int pos_f(int jb) { return jb < 256 ? 4 + jb : jb - 256; }
__device__ __forceinline__ int pos_b(int jb) { return jb < 256 ? 4 + 255 - jb : 3 - (jb - 256); }
constexpr int KP = 72;
constexpr int QP = 136;
__device__ __forceinline__ bf16x8 lds_frag(const LAS unsigned char* base, int row, int pitch, int col) { return *(const LAS bf16x8*)(base + ((size_t)row * pitch + col) * 2); }

__device__ __forceinline__ void conv_silu8(u32x4 xm, u32x4 x0, u32x4 xp, const float* cw  , float scale, float (&o)[8]) {
    const f32x4 w0a = *(const f32x4*)(cw), w0b = *(const f32x4*)(cw + 4), w1a = *(const f32x4*)(cw + 1024), w1b = *(const f32x4*)(cw + 1028), w2a = *(const f32x4*)(cw + 2048), w2b = *(const f32x4*)(cw + 2052);
    const float w0[8] = {w0a.x, w0a.y, w0a.z, w0a.w, w0b.x, w0b.y, w0b.z, w0b.w}, w1[8] = {w1a.x, w1a.y, w1a.z, w1a.w, w1b.x, w1b.y, w1b.z, w1b.w}, w2[8] = {w2a.x, w2a.y, w2a.z, w2a.w, w2b.x, w2b.y, w2b.z, w2b.w};
    const unsigned am[4] = {xm.x, xm.y, xm.z, xm.w}, a0[4] = {x0.x, x0.y, x0.z, x0.w}, ap[4] = {xp.x, xp.y, xp.z, xp.w};
#pragma unroll
    for (int e = 0; e < 8; ++e) { const unsigned sh = (e & 1) * 16;
        const float vm = bf2f((am[e >> 1] >> sh) & 0xffffu), v0 = bf2f((a0[e >> 1] >> sh) & 0xffffu), vp = bf2f((ap[e >> 1] >> sh) & 0xffffu);
        o[e] = siluf_(vm * w0[e] + v0 * w1[e] + vp * w2[e]) * scale; }
}

struct MlstmArgs { const bf16_t* QKM; const bf16_t* VM; const bf16_t* OMS; const float* GATES; const float* conv; const float* norm_m; const unsigned* mstab;
                   bf16_t* ST; float* NU; float* ADEC; bf16_t* HM; unsigned char* U8; };
constexpr float U8_SCALE = 256.f, C8_SCALE = 64.f;
constexpr float U8_SCALE_UNUSED_ = 0.f;

__device__ __forceinline__ void mlstm_gates(const MlstmArgs& A, int bh, int row0, int lane, float& bfv, float& bbv, float& ifm, float& ibm, float& bend_f, float& bend_b) {
    const f32x4 g0 = *(const f32x4*)(A.GATES + (size_t)(row0 + lane) * 16), g1 = *(const f32x4*)(A.GATES + (size_t)(row0 + lane) * 16 + 4),
                g2 = *(const f32x4*)(A.GATES + (size_t)(row0 + lane) * 16 + 8), g3 = *(const f32x4*)(A.GATES + (size_t)(row0 + lane) * 16 + 12);
    const int h = bh & 3;
    const float i_f = h == 0 ? g0.x : h == 1 ? g0.y : h == 2 ? g0.z : g0.w, f_f = h == 0 ? g1.x : h == 1 ? g1.y : h == 2 ? g1.z : g1.w;
    const float i_b = h == 0 ? g2.x : h == 1 ? g2.y : h == 2 ? g2.z : g2.w, f_b = h == 0 ? g3.x : h == 1 ? g3.y : h == 2 ? g3.z : g3.w;
    float inc = logsigf_(f_f), suf = logsigf_(f_b);
#pragma unroll
    for (int o = 1; o < 64; o <<= 1) { const float t = __shfl_up(inc, o); if (lane >= o) inc += t; }
#pragma unroll
    for (int o = 1; o < 64; o <<= 1) { const float t = __shfl_down(suf, o); if (lane + o < 64) suf += t; }
    bend_f = __shfl(inc, 63); bend_b = __shfl(suf, 0);
    const float Mf = __uint_as_float(__hip_atomic_load(A.mstab + bh * 2 + 0, RLX_AGENT)), Mb = __uint_as_float(__hip_atomic_load(A.mstab + bh * 2 + 1, RLX_AGENT));
    bfv = inc; bbv = suf; ifm = i_f - Mf; ibm = i_b - Mb;
}
__device__ __forceinline__ void mlstm_stage_vt(const MlstmArgs& A, int h, int row0, LAS unsigned char* VT, int tid) {
#pragma unroll
    for (int i = 0; i < 4; ++i) { const int p = tid + 512 * i, s = p & 63, ec = p >> 6;
        const u32x2 v8 = *(const u32x2*)((const unsigned char*)A.VM + (size_t)(row0 + s) * 1024 + h * 256 + ec * 8); const u32x4 v = fp8x8_to_bf16x8((u32x4){v8.x, v8.y, 0u, 0u});
        const unsigned a[4] = {v.x, v.y, v.z, v.w};
#pragma unroll
        for (int e = 0; e < 8; ++e) *(LAS bf16_t*)(VT + ((size_t)(ec * 8 + e) * KP + s) * 2) = (bf16_t)((a[e >> 1] >> ((e & 1) * 16)) & 0xffffu); }
}
__device__ __forceinline__ void mlstm_load3(const bf16_t* QKM, int row0, int s, int ch, bool hasL, bool hasR, u32x4& xm, u32x4& x0, u32x4& xp) {
    const unsigned char* p = (const unsigned char*)QKM + (size_t)(row0 + s) * 1024 + ch;
    { const u32x2 t = *(const u32x2*)p; x0 = (u32x4){t.x, t.y, 0u, 0u}; }
    if (s > 0 || hasL) { const u32x2 t = *(const u32x2*)(p - 1024); xm = (u32x4){t.x, t.y, 0u, 0u}; } else xm = (u32x4){0u, 0u, 0u, 0u};
    if (s < 63 || hasR) { const u32x2 t = *(const u32x2*)(p + 1024); xp = (u32x4){t.x, t.y, 0u, 0u}; } else xp = (u32x4){0u, 0u, 0u, 0u};
}

__device__ __forceinline__ void mlstm_d1_unit(const MlstmArgs& A, int bh, int jb, LAS unsigned char* lds) {
    const int tid = opaque_tid(), lane = tid & 63, wave = __builtin_amdgcn_readfirstlane(tid >> 6), fr = lane & 15, fq = lane >> 4;
    const int b = bh >> 2, h = bh & 3, row0 = b * TPB + jb * 64;
    const bool hasL = !(jb == 0 || jb == 256), hasR = !(jb == 255 || jb == 259);
    LAS float* WF = (LAS float*)lds; LAS float* WB = WF + 64;
    LAS unsigned char* KF = lds + 512; LAS unsigned char* KB = KF + 128 * KP * 2; LAS unsigned char* VT = KB + 128 * KP * 2;
    const int cf = bh * 2, cb = bh * 2 + 1, pf = pos_f(jb), pb = pos_b(jb);
    u32x4 xm_[2], x0_[2], xp_[2];
#pragma unroll
    for (int i = 0; i < 2; ++i) { const int p = tid + 512 * i, s = p & 63, dc = p >> 6; mlstm_load3(A.QKM, row0, s, 512 + h * 128 + dc * 8, hasL, hasR, xm_[i], x0_[i], xp_[i]); }
    mlstm_stage_vt(A, h, row0, VT, tid);
    if (wave == 0) {
        float bfv, bbv, ifm, ibm, bend_f, bend_b; mlstm_gates(A, bh, row0, lane, bfv, bbv, ifm, ibm, bend_f, bend_b);
        WF[lane] = __expf(bend_f - bfv + ifm); WB[lane] = __expf(bend_b - bbv + ibm);
        if (lane == 0) { st_wt(A.ADEC + cf * NCHUNK + pf, __expf(bend_f)); st_wt(A.ADEC + cb * NCHUNK + pb, __expf(bend_b)); }
    }
    __syncthreads();
#pragma unroll
    for (int i = 0; i < 2; ++i) { const int p = tid + 512 * i, s = p & 63, dc = p >> 6; const int ch = 512 + h * 128 + dc * 8;
        const u32x4 xm = fp8x8_to_bf16x8(xm_[i]), x0 = fp8x8_to_bf16x8(x0_[i]), xp = fp8x8_to_bf16x8(xp_[i]);
        float k[8]; conv_silu8(xm, x0, xp, A.conv + ch, 0.08838834764831845f, k);
        const float wf = WF[s], wb = WB[s];
#pragma unroll
        for (int e = 0; e < 8; ++e) { *(LAS bf16_t*)(KF + ((size_t)(dc * 8 + e) * KP + s) * 2) = (bf16_t)f2bf(k[e] * wf); *(LAS bf16_t*)(KB + ((size_t)(dc * 8 + e) * KP + s) * 2) = (bf16_t)f2bf(k[e] * wb); } }
    __syncthreads();
    if (tid < 256) { const int dir = tid >> 7, d = tid & 127; const LAS unsigned char* src = (dir ? KB : KF) + (size_t)d * KP * 2; float s = 0.f;
#pragma unroll 8
        for (int i = 0; i < 64; ++i) s += bf2f(*(const LAS bf16_t*)(src + i * 2));
        A.NU[((size_t)(dir ? cb : cf) * NCHUNK + (dir ? pb : pf)) * 128 + d] = s; }
#pragma unroll
    for (int dir = 0; dir < 2; ++dir) {
        const LAS unsigned char* KW = dir ? KB : KF;
        f32x4 acc[8][2];
#pragma unroll
        for (int m = 0; m < 8; ++m) { acc[m][0] = (f32x4){0.f, 0.f, 0.f, 0.f}; acc[m][1] = (f32x4){0.f, 0.f, 0.f, 0.f}; }
#pragma unroll
        for (int ks = 0; ks < 2; ++ks) {
            const bf16x8 b0 = lds_frag(VT, (2 * wave) * 16 + fr, KP, ks * 32 + fq * 8), b1 = lds_frag(VT, (2 * wave + 1) * 16 + fr, KP, ks * 32 + fq * 8);
#pragma unroll
            for (int m = 0; m < 8; ++m) { const bf16x8 a = lds_frag(KW, m * 16 + fr, KP, ks * 32 + fq * 8);
                acc[m][0] = __builtin_amdgcn_mfma_f32_16x16x32_bf16(a, b0, acc[m][0], 0, 0, 0); acc[m][1] = __builtin_amdgcn_mfma_f32_16x16x32_bf16(a, b1, acc[m][1], 0, 0, 0); } }
        unsigned char* dst8 = A.U8 + ((size_t)(dir ? cb : cf) * NCHUNK + (dir ? pb : pf)) * 32768;
#pragma unroll
        for (int m = 0; m < 8; ++m)
#pragma unroll
            for (int n = 0; n < 2; ++n) { const int e = (2 * wave + n) * 16 + fr, d0 = m * 16 + fq * 4; *(unsigned*)(dst8 + (size_t)e * 128 + d0) = pk4_fp8(acc[m][n] * U8_SCALE); }
    }
    __syncthreads();
}

__device__ __forceinline__ void mlstm_scan(const MlstmArgs& A, int gtid, int nthreads, bf16_t* dryST = nullptr, float* dryNU = nullptr) {
    constexpr int PF = 20;
    for (int it = gtid; it < NCHAIN * 8192; it += nthreads) {
        const int chain = it >> 13, e4 = (it & 8191) * 4; bf16_t* __restrict__ p = A.ST + (size_t)chain * NCHUNK * 32768 + e4; const float* __restrict__ ad = A.ADEC + chain * NCHUNK; const unsigned char* q8 = A.U8 + (size_t)chain * NCHUNK * 32768 + e4; unsigned char* w8 = A.U8 + (size_t)chain * NCHUNK * 32768 + e4;
        f32x4 s = (f32x4){0.f, 0.f, 0.f, 0.f};
        for (int c0 = 0; c0 < NCHUNK; c0 += PF) {
            unsigned u[PF]; float a[PF];
#pragma unroll
            for (int i = 0; i < PF; ++i) { u[i] = __builtin_nontemporal_load((const unsigned*)(q8 + (size_t)(c0 + i) * 32768)); a[i] = ad[c0 + i]; }
#pragma unroll
            for (int i = 0; i < PF; ++i) { if (dryST) *(u32x2*)(dryST + (p - A.ST) + (size_t)(c0 + i) * 32768) = pk4(s); else *(unsigned*)(w8 + (size_t)(c0 + i) * 32768) = pk4_fp8(s * C8_SCALE); s = s * a[i] + unpk4_fp8(u[i]) * (1.f / U8_SCALE); }
        }
    }
    for (int it = gtid; it < NCHAIN * 128; it += nthreads) {
        const int chain = it >> 7, d = it & 127; float* __restrict__ p = A.NU + (size_t)chain * NCHUNK * 128 + d; const float* __restrict__ ad = A.ADEC + chain * NCHUNK; float s = 0.f;
        for (int c0 = 0; c0 < NCHUNK; c0 += PF) {
            float u[PF], a[PF];
#pragma unroll
            for (int i = 0; i < PF; ++i) { u[i] = p[(c0 + i) * 128]; a[i] = ad[c0 + i]; }
#pragma unroll
            for (int i = 0; i < PF; ++i) { (dryNU ? dryNU + (p - A.NU) : p)[(c0 + i) * 128] = s; s = s * a[i] + u[i]; }
        }
    }
}

constexpr int D3_G = 0, D3_Q = 4096, D3_QF = D3_Q + 64 * QP * 2, D3_QB = D3_QF + 64 * QP * 2, D3_KT = D3_QB + 64 * QP * 2, D3_VT = D3_KT + 64 * QP * 2, D3_PF = D3_VT + 256 * KP * 2, D3_PB = D3_PF + 64 * KP * 2, D3_END = D3_PB + 64 * KP * 2;
static_assert(D3_END + 1024 <= RING_BYTES, "mLSTM D3 LDS");
__device__ __forceinline__ void mlstm_d3_unit(const MlstmArgs& A, int bh, int jb, LAS unsigned char* lds) {
    const int tid = opaque_tid(), lane = tid & 63, wave = __builtin_amdgcn_readfirstlane(tid >> 6), fr = lane & 15, fq = lane >> 4;
    const int b = bh >> 2, h = bh & 3, row0 = b * TPB + jb * 64;
    const bool hasL = !(jb == 0 || jb == 256), hasR = !(jb == 255 || jb == 259);
    LAS float* GF = (LAS float*)(lds + D3_G);
    LAS float* BF = GF, *BB = GF + 64, *IFM = GF + 128, *IBM = GF + 192, *EBF = GF + 256, *EBB = GF + 320, *DEN = GF + 384, *RS = GF + 512;
    LAS float* NPV = (LAS float*)(lds + D3_END);
    LAS unsigned char* Qs = lds + D3_Q; LAS unsigned char* QF = lds + D3_QF; LAS unsigned char* QB = lds + D3_QB; LAS unsigned char* KT = lds + D3_KT;
    LAS unsigned char* VT = lds + D3_VT; LAS unsigned char* PF = lds + D3_PF; LAS unsigned char* PB = lds + D3_PB;
    const int cf = bh * 2, cb = bh * 2 + 1, pf = pos_f(jb), pb = pos_b(jb);
    const float Mf = __uint_as_float(__hip_atomic_load(A.mstab + bh * 2 + 0, RLX_AGENT)), Mb = __uint_as_float(__hip_atomic_load(A.mstab + bh * 2 + 1, RLX_AGENT));
    u32x4 xm_[4], x0_[4], xp_[4];
#pragma unroll
    for (int i = 0; i < 4; ++i) { const int p = tid + 512 * i, dc = p & 15, s = (p >> 4) & 63, isk = p >> 10; mlstm_load3(A.QKM, row0, s, isk * 512 + h * 128 + dc * 8, hasL, hasR, xm_[i], x0_[i], xp_[i]); }
    mlstm_stage_vt(A, h, row0, VT, tid);
    if (wave == 0) {
        float bfv, bbv, ifm, ibm, bend_f, bend_b; mlstm_gates(A, bh, row0, lane, bfv, bbv, ifm, ibm, bend_f, bend_b);
        BF[lane] = bfv; BB[lane] = bbv; IFM[lane] = ifm; IBM[lane] = ibm; EBF[lane] = __expf(bfv); EBB[lane] = __expf(bbv);
    } else if (tid >= 256) { const int dir = (tid >> 7) & 1, d = tid & 127; NPV[dir * 128 + d] = A.NU[((size_t)(dir ? cb : cf) * NCHUNK + (dir ? pb : pf)) * 128 + d]; }
    __syncthreads();
#pragma unroll
    for (int i = 0; i < 4; ++i) { const int p = tid + 512 * i, dc = p & 15, s = (p >> 4) & 63, isk = p >> 10; const int ch = isk * 512 + h * 128 + dc * 8;
        const u32x4 xm = fp8x8_to_bf16x8(xm_[i]), x0 = fp8x8_to_bf16x8(x0_[i]), xp = fp8x8_to_bf16x8(xp_[i]);
        float v[8]; conv_silu8(xm, x0, xp, A.conv + ch, isk ? 0.08838834764831845f : 1.f, v);
        if (isk) { u32x4 w; w.x = pk2(v[0], v[1]); w.y = pk2(v[2], v[3]); w.z = pk2(v[4], v[5]); w.w = pk2(v[6], v[7]); *(LAS u32x4*)(KT + ((size_t)s * QP + dc * 8) * 2) = w; }
        else { const float ef = EBF[s], eb = EBB[s]; u32x4 w;
            w.x = pk2(v[0], v[1]); w.y = pk2(v[2], v[3]); w.z = pk2(v[4], v[5]); w.w = pk2(v[6], v[7]); *(LAS u32x4*)(Qs + ((size_t)s * QP + dc * 8) * 2) = w;
            w.x = pk2(v[0] * ef, v[1] * ef); w.y = pk2(v[2] * ef, v[3] * ef); w.z = pk2(v[4] * ef, v[5] * ef); w.w = pk2(v[6] * ef, v[7] * ef); *(LAS u32x4*)(QF + ((size_t)s * QP + dc * 8) * 2) = w;
            w.x = pk2(v[0] * eb, v[1] * eb); w.y = pk2(v[2] * eb, v[3] * eb); w.z = pk2(v[4] * eb, v[5] * eb); w.w = pk2(v[6] * eb, v[7] * eb); *(LAS u32x4*)(QB + ((size_t)s * QP + dc * 8) * 2) = w; } }
    __syncthreads();
    {
        const int mt = wave >> 1, nt0 = (wave & 1) * 2;
        f32x4 S0 = (f32x4){0.f, 0.f, 0.f, 0.f}, S1 = S0;
#pragma unroll
        for (int ks = 0; ks < 4; ++ks) { const bf16x8 a = lds_frag(Qs, mt * 16 + fr, QP, ks * 32 + fq * 8);
            S0 = __builtin_amdgcn_mfma_f32_16x16x32_bf16(a, lds_frag(KT, nt0 * 16 + fr, QP, ks * 32 + fq * 8), S0, 0, 0, 0);
            S1 = __builtin_amdgcn_mfma_f32_16x16x32_bf16(a, lds_frag(KT, (nt0 + 1) * 16 + fr, QP, ks * 32 + fq * 8), S1, 0, 0, 0); }
#pragma unroll
        for (int n = 0; n < 2; ++n) { const int s = (nt0 + n) * 16 + fr; const float bfs = BF[s], bbs = BB[s], ifs = IFM[s], ibs = IBM[s];
#pragma unroll
            for (int r = 0; r < 4; ++r) { const int t = mt * 16 + fq * 4 + r; const float sv = n ? S1[r] : S0[r];
                const float pf_ = (s <= t) ? sv * __expf(BF[t] - bfs + ifs) : 0.f, pb_ = (s >= t) ? sv * __expf(BB[t] - bbs + ibs) : 0.f;
                *(LAS bf16_t*)(PF + ((size_t)t * KP + s) * 2) = (bf16_t)f2bf(pf_); *(LAS bf16_t*)(PB + ((size_t)t * KP + s) * 2) = (bf16_t)f2bf(pb_); } }
    }
    __syncthreads();
    {
        const int t = tid >> 3, part = tid & 7;
        const u32x4 pfv = *(const LAS u32x4*)(PF + ((size_t)t * KP + part * 8) * 2), pbv = *(const LAS u32x4*)(PB + ((size_t)t * KP + part * 8) * 2);
        const u32x4 q0v = *(const LAS u32x4*)(Qs + ((size_t)t * QP + part * 16) * 2), q1v = *(const LAS u32x4*)(Qs + ((size_t)t * QP + part * 16 + 8) * 2);
        const unsigned pw[4] = {pfv.x, pfv.y, pfv.z, pfv.w}, pwb[4] = {pbv.x, pbv.y, pbv.z, pbv.w}, qw[8] = {q0v.x, q0v.y, q0v.z, q0v.w, q1v.x, q1v.y, q1v.z, q1v.w};
        float sf = 0.f, sb = 0.f, dqf = 0.f, dqb = 0.f;
#pragma unroll
        for (int i = 0; i < 4; ++i) { sf += bf2f(pw[i] & 0xffffu) + bf2f(pw[i] >> 16); sb += bf2f(pwb[i] & 0xffffu) + bf2f(pwb[i] >> 16); }
#pragma unroll
        for (int i = 0; i < 8; ++i) { const float qa = bf2f(qw[i] & 0xffffu), qb2 = bf2f(qw[i] >> 16); const int d = part * 16 + 2 * i;
            dqf += qa * NPV[d] + qb2 * NPV[d + 1]; dqb += qa * NPV[128 + d] + qb2 * NPV[128 + d + 1]; }
#pragma unroll
        for (int o = 1; o < 8; o <<= 1) { sf += __shfl_xor(sf, o); sb += __shfl_xor(sb, o); dqf += __shfl_xor(dqf, o); dqb += __shfl_xor(dqb, o); }
        if (part == 0) { DEN[t] = fmaxf(fabsf(sf + EBF[t] * dqf), __expf(-Mf)); DEN[64 + t] = fmaxf(fabsf(sb + EBB[t] * dqb), __expf(-Mb)); }
    }
    f32x4 acc[2][2][4];
#pragma unroll
    for (int dir = 0; dir < 2; ++dir) {
        const LAS unsigned char* P = dir ? PB : PF; const LAS unsigned char* QD = dir ? QB : QF;
        const unsigned char* CT = A.U8 + ((size_t)(dir ? cb : cf) * NCHUNK + (dir ? pb : pf)) * 32768;
#pragma unroll
        for (int m = 0; m < 2; ++m)
#pragma unroll
            for (int n = 0; n < 4; ++n) acc[dir][m][n] = (f32x4){0.f, 0.f, 0.f, 0.f};
#pragma unroll
        for (int ks = 0; ks < 2; ++ks) {
            const bf16x8 a0 = lds_frag(VT, (2 * wave) * 16 + fr, KP, ks * 32 + fq * 8), a1 = lds_frag(VT, (2 * wave + 1) * 16 + fr, KP, ks * 32 + fq * 8);
#pragma unroll
            for (int n = 0; n < 4; ++n) { const bf16x8 bq = lds_frag(P, n * 16 + fr, KP, ks * 32 + fq * 8);
                acc[dir][0][n] = __builtin_amdgcn_mfma_f32_16x16x32_bf16(a0, bq, acc[dir][0][n], 0, 0, 0); acc[dir][1][n] = __builtin_amdgcn_mfma_f32_16x16x32_bf16(a1, bq, acc[dir][1][n], 0, 0, 0); } }
#pragma unroll
        for (int ks = 0; ks < 4; ++ks) {
            const u32x2 c0_ = *(const u32x2*)(CT + (size_t)((2 * wave) * 16 + fr) * 128 + ks * 32 + fq * 8), c1_ = *(const u32x2*)(CT + (size_t)((2 * wave + 1) * 16 + fr) * 128 + ks * 32 + fq * 8);
            const u32x2 l0_ = pk4(unpk4_fp8(c0_.x) * (1.f / C8_SCALE)), h0_ = pk4(unpk4_fp8(c0_.y) * (1.f / C8_SCALE)), l1_ = pk4(unpk4_fp8(c1_.x) * (1.f / C8_SCALE)), h1_ = pk4(unpk4_fp8(c1_.y) * (1.f / C8_SCALE));
            const u32x4 w0_ = {l0_.x, l0_.y, h0_.x, h0_.y}, w1_ = {l1_.x, l1_.y, h1_.x, h1_.y};
            const bf16x8 a0 = *reinterpret_cast<const bf16x8*>(&w0_), a1 = *reinterpret_cast<const bf16x8*>(&w1_);
#pragma unroll
            for (int n = 0; n < 4; ++n) { const bf16x8 bq = lds_frag(QD, n * 16 + fr, QP, ks * 32 + fq * 8);
                acc[dir][0][n] = __builtin_amdgcn_mfma_f32_16x16x32_bf16(a0, bq, acc[dir][0][n], 0, 0, 0); acc[dir][1][n] = __builtin_amdgcn_mfma_f32_16x16x32_bf16(a1, bq, acc[dir][1][n], 0, 0, 0); } }
    }
    __syncthreads();
    f32x4 gq[2]; u32x2 ogq[4][2];
#pragma unroll
    for (int m = 0; m < 2; ++m) gq[m] = *(const f32x4*)(A.norm_m + h * 256 + (2 * wave + m) * 16 + fq * 4);
#pragma unroll
    for (int n = 0; n < 4; ++n)
#pragma unroll
        for (int m = 0; m < 2; ++m) ogq[n][m] = *(const u32x2*)(A.OMS + (size_t)(row0 + n * 16 + fr) * 1024 + h * 256 + (2 * wave + m) * 16 + fq * 4);
    f32x4 hv[2][4];
#pragma unroll
    for (int n = 0; n < 4; ++n) { const int t = n * 16 + fr; const float rf = 1.f / DEN[t], rb = 1.f / DEN[64 + t]; float ss = 0.f;
#pragma unroll
        for (int m = 0; m < 2; ++m) { hv[m][n] = acc[0][m][n] * rf + acc[1][m][n] * rb; ss += hv[m][n].x * hv[m][n].x + hv[m][n].y * hv[m][n].y + hv[m][n].z * hv[m][n].z + hv[m][n].w * hv[m][n].w; }
        ss += __shfl_xor(ss, 16); ss += __shfl_xor(ss, 32);
        if (fq == 0) RS[wave * 64 + t] = ss; }
    __syncthreads();
#pragma unroll
    for (int n = 0; n < 4; ++n) { const int t = n * 16 + fr; float ss = 0.f;
#pragma unroll
        for (int w = 0; w < 8; ++w) ss += RS[w * 64 + t];
        const float rstd = 1.f / sqrtf(ss * (1.f / 256.f) + RMS_EPS);
#pragma unroll
        for (int m = 0; m < 2; ++m) { const int e0 = (2 * wave + m) * 16 + fq * 4; const size_t o = (size_t)(row0 + t) * 1024 + h * 256 + e0;
            *(u32x2*)(A.HM + o) = pk4(hv[m][n] * rstd * gq[m] * unpk4(ogq[n][m])); } }
    __syncthreads();
}

__device__ __forceinline__ void tr_load(const float* W, size_t ldw, int k0, int n0, int nvalid, LAS float* scr, int lane) {
#pragma unroll 8
    for (int i = 0; i < 32; ++i) { const int kk = 2 * i + (lane >> 5), n = lane & 31; scr[kk * 33 + n] = (n < nvalid) ? W[(size_t)(k0 + kk) * ldw + n0 + n] : 0.f; }
    LDS_WAIT(); asm volatile("" ::: "memory");
}
__device__ __forceinline__ int perm32(int n) { return (n & ~31) | (((n >> 2) & 1) << 4) | (((n >> 3) & 3) << 2) | (n & 3); }
template <int MODE  >
__device__ __forceinline__ void tr_store(bf16_t* WT, size_t ldt, int drow0, int dcol0, int nvalid, const LAS float* scr, int lane, bool perm = false) {
    const int c = lane & 7;
#pragma unroll
    for (int j = 0; j < 4; ++j) { const int n = (lane >> 3) + 8 * j; const LAS float* s = scr + (8 * c) * 33 + n; float v[8];
#pragma unroll
        for (int e = 0; e < 8; ++e) { v[e] = s[e * 33]; if (MODE == 1) v[e] = v[e] - bf2f(f2bf(v[e])); }
        u32x4 o; o.x = pk2(v[0], v[1]); o.y = pk2(v[2], v[3]); o.z = pk2(v[4], v[5]); o.w = pk2(v[6], v[7]);
        if (n < nvalid) *(u32x4*)(WT + (size_t)(drow0 + (perm ? perm32(n) : n)) * ldt + dcol0 + 8 * c) = o; }
}

__device__ __forceinline__ void tr_load64(const float* W, size_t ldw, int k0, int n0, LAS float* scr, int lane) {
    float v[64];
    const float* p = W + (size_t)k0 * ldw + n0 + lane;
#pragma unroll
    for (int i = 0; i < 64; ++i) v[i] = __builtin_nontemporal_load(p + (size_t)i * ldw);
#pragma unroll
    for (int i = 0; i < 64; ++i) scr[i * 65 + lane] = v[i];
    LDS_WAIT(); asm volatile("" ::: "memory");
}
template <bool PERM = false>
__device__ __forceinline__ void tr_store64(bf16_t* WT, size_t ldt, int drow0, int dcol0, const LAS float* scr, int lane) {
    const int c = lane & 7;
#pragma unroll
    for (int j = 0; j < 8; ++j) { const int nl = (lane >> 3) + 8 * j; const LAS float* s = scr + (8 * c) * 65 + nl; const int n = PERM ? perm32(nl) : nl;
        u32x4 o; o.x = pk2(s[0], s[65]); o.y = pk2(s[2 * 65], s[3 * 65]); o.z = pk2(s[4 * 65], s[5 * 65]); o.w = pk2(s[6 * 65], s[7 * 65]);
        *(u32x4*)(WT + (size_t)(drow0 + n) * ldt + dcol0 + 8 * c) = o; }
    LDS_WAIT(); asm volatile("" ::: "memory");
}
struct KArgs { const float* in[25]; float* out; unsigned char* ws; int dbg; int pad; };

__device__ __forceinline__ void ln_row(f32x4 (&v)[4], const float* g, const float* bta, int lane) {
    float s = 0.f;
#pragma unroll
    for (int j = 0; j < 4; ++j) s += (v[j].x + v[j].y) + (v[j].z + v[j].w);
    const float mean = wave_sum(s) * (1.f / 1024.f); float s2 = 0.f;
#pragma unroll
    for (int j = 0; j < 4; ++j) { v[j] = v[j] - mean; s2 += (v[j].x * v[j].x + v[j].y * v[j].y) + (v[j].z * v[j].z + v[j].w * v[j].w); }
    const float rstd = 1.f / sqrtf(wave_sum(s2) * (1.f / 1024.f) + LN_EPS);
#pragma unroll
    for (int j = 0; j < 4; ++j) { const f32x4 gg = *(const f32x4*)(g + 4 * lane + 256 * j), bb = *(const f32x4*)(bta + 4 * lane + 256 * j); v[j] = v[j] * rstd * gg + bb; }
}

#define C8(j) (8 * lane + 512 * ((j) >> 1) + 4 * ((j) & 1))
__device__ __forceinline__ void ln_row8(f32x4 (&v)[4], const float* g, const float* bta, int lane) {
    float s = 0.f;
#pragma unroll
    for (int j = 0; j < 4; ++j) s += (v[j].x + v[j].y) + (v[j].z + v[j].w);
    const float mean = wave_sum(s) * (1.f / 1024.f); float s2 = 0.f;
#pragma unroll
    for (int j = 0; j < 4; ++j) { v[j] = v[j] - mean; s2 += (v[j].x * v[j].x + v[j].y * v[j].y) + (v[j].z * v[j].z + v[j].w * v[j].w); }
    const float rstd = 1.f / sqrtf(wave_sum(s2) * (1.f / 1024.f) + LN_EPS);
#pragma unroll
    for (int j = 0; j < 4; ++j) { const f32x4 gg = *(const f32x4*)(g + C8(j)), bb = *(const f32x4*)(bta + C8(j)); v[j] = v[j] * rstd * gg + bb; }
}

#define AS4 __attribute__((address_space(4)))
__device__ __forceinline__ const char AS4* kargp() { const char AS4* p = (const char AS4*)__builtin_amdgcn_kernarg_segment_ptr(); asm volatile("" : "+s"(p)); return p; }
#define INP(k) (*(const float* const AS4*)(kargp() + 8 * (k)))
#define OUTP() (*(float* const AS4*)(kargp() + 200))
#define WSB() (*(unsigned char* const AS4*)(kargp() + 208))
enum { I_X = 0, I_C, I_CTX, I_CCTX, I_ADAW, I_ADAB, I_WIN, I_BG, I_CONV, I_LAM, I_SUBLN, I_NORMM, I_WBRA, I_WBRM, I_WOUT, I_LN1G, I_LN1B, I_LN2G, I_LN2B, I_WR, I_EB, I_WEIN, I_WEOUT, I_WSIN, I_WSOUT };

__global__ void __launch_bounds__(NTHR, 2) mega_fwd(KArgs args) {
    extern __shared__ __attribute__((aligned(16))) unsigned char lds_raw[];
    LAS unsigned char* lds = (LAS unsigned char*)lds_raw;
    for (int u = threadIdx.x; u < (LDS_BYTES - MISC_OFF) / 4; u += NTHR) ((LAS unsigned*)(lds + MISC_OFF))[u] = 0u;
    __syncthreads();
    (void)xcd_barrier_post((unsigned*)(WSB() + WS_CTL) + CW_BAR, (volatile LAS unsigned*)(lds + MISC_OFF) + 8);
#define GRID_BAR() do { for (int xb_ = 0; xb_ < 1 + XBAR; ++xb_) { XcdBarrier b_; b_.bar = (unsigned*)(WSB() + WS_CTL) + CW_BAR; b_.x = xb_xcc_id(); b_.st = (volatile LAS unsigned*)(lds + MISC_OFF) + 8; if (xb_ == 0) xcd_barrier<true, false>(b_); else xcd_barrier<false, true>(b_); } } while (0)
#define PHASE_LOCALS() const int tid = opaque_tid(), lane = tid & 63, wave = __builtin_amdgcn_readfirstlane(tid >> 6); int G = (int)gridDim.x; asm volatile("" : "+s"(G)); \
    const int bx = (int)blockIdx.x, vcu = (G % 8 == 0) ? (bx % 8) * (G / 8) + bx / 8 : bx, gw = vcu * NWAVES + wave, NGW = G * NWAVES; (void)tid; (void)lane; (void)wave; (void)gw; (void)NGW; (void)vcu

#if PROBE
#define STAMP(cat) do { if (blockIdx.x == 0 && threadIdx.x == 0) { LAS unsigned long long* ts_ = (LAS unsigned long long*)(lds + MISC_OFF + 64); const unsigned long long t_ = __builtin_amdgcn_s_memrealtime(); ts_[1 + (cat)] += t_ - ts_[0]; ts_[0] = t_; } } while (0)
    if (blockIdx.x == 0 && threadIdx.x == 0) ((LAS unsigned long long*)(lds + MISC_OFF + 64))[0] = __builtin_amdgcn_s_memrealtime();
#else
#define STAMP(cat) do { } while (0)
#endif
    for (int rep_ = 0; rep_ < NREP(1); ++rep_) {
        PHASE_LOCALS(); unsigned char* ws = WSB();
        LAS float* scr = (LAS float*)(lds + wave * 16640);
        constexpr int IT_IN = 257 * 16;
        constexpr int IT_SQ = 32 * 16;
        constexpr int IT_RT = 8 * 16;
        constexpr int IT_E1 = 8 * 16, IT_E2 = 16 * 4;
        constexpr int IT_LAYER = IT_IN + 3 * IT_SQ + IT_RT + 257 * IT_E1 + 257 * IT_E2;
        for (int it = gw; it < 2 * IT_LAYER; it += NGW) {
            const int l = it / IT_LAYER; int r = it % IT_LAYER; unsigned char* WL = ws + WS_W0 + (size_t)l * WL_SIZE;
            if (r < IT_IN) { const int nb = r / 16, kb = r % 16; int n0, drow, nv = 32;
                if (nb < 192) { n0 = nb * 32; drow = n0; } else if (nb == 192) { n0 = 6144; drow = 8192; nv = 16; } else { n0 = 6160 + (nb - 193) * 32; drow = 6144 + (nb - 193) * 32; }
                tr_load(INP(I_WIN) + (size_t)l * 1024 * INW, INW, kb * 64, n0, nv, scr, lane); tr_store<0>((bf16_t*)(WL + WL_IN), 1024, drow, kb * 64, nv, scr, lane, drow >= 2048 && drow < 8192); continue; }
            r -= IT_IN;
            if (r < 3 * IT_SQ) { const int w = r / IT_SQ, q = r % IT_SQ, nb = q / 16, kb = q % 16; const float* src = (w == 0 ? INP(I_WBRA) : w == 1 ? INP(I_WBRM) : INP(I_WOUT)) + (size_t)l * 1024 * 1024;
                tr_load(src, 1024, kb * 64, nb * 32, 32, scr, lane); tr_store<0>((bf16_t*)(WL + (w == 0 ? WL_BRA : w == 1 ? WL_BRM : WL_OUT)), 1024, nb * 32, kb * 64, 32, scr, lane, true); continue; }
            r -= 3 * IT_SQ;
            if (r < IT_RT) { const int nb = r / 16, kb = r % 16; tr_load(INP(I_WR) + (size_t)l * 1024 * 256, 256, kb * 64, nb * 32, 32, scr, lane);
                bf16_t* dst = (bf16_t*)(WL + WL_R3); tr_store<0>(dst, 3072, nb * 32, kb * 64, 32, scr, lane); tr_store<0>(dst, 3072, nb * 32, 1024 + kb * 64, 32, scr, lane); tr_store<1>(dst, 3072, nb * 32, 2048 + kb * 64, 32, scr, lane); continue; }
            r -= IT_RT;
            if (r < 257 * IT_E1) { const int e = r / IT_E1, q = r % IT_E1, kb = q / 8, nb = q % 8, n0 = nb * 64;
                const float* src = e < 256 ? INP(I_WEIN) + ((size_t)l * 256 + e) * 1024 * 512 : INP(I_WSIN) + (size_t)l * 1024 * 512;
                const int isg = n0 >= 256, j0 = n0 & 255, drow = (j0 >> 7) * 256 + isg * 128 + (j0 & 127);
                tr_load64(src, 512, kb * 64, n0, scr, lane); tr_store64<true>((bf16_t*)(WL + WL_E1) + (size_t)e * 512 * 1024, 1024, drow, kb * 64, scr, lane); continue; }
            r -= 257 * IT_E1;
            { const int e = r / IT_E2, q = r % IT_E2, kb = q / 16, nb = q % 16;
                const float* src = e < 256 ? INP(I_WEOUT) + ((size_t)l * 256 + e) * 256 * 1024 : INP(I_WSOUT) + (size_t)l * 256 * 1024;
                tr_load64(src, 1024, kb * 64, nb * 64, scr, lane); tr_store64<true>((bf16_t*)(WL + WL_E2) + (size_t)e * 1024 * 256, 256, nb * 64, kb * 64, scr, lane); }
        }
        { const float* in_c = INP(I_C); const float* in_cctx = INP(I_CCTX); const float* ada_w = INP(I_ADAW); const float* ada_b = INP(I_ADAB); float* MODV = (float*)(ws + WS_MODV);
        for (int it = bx * NTHR + tid; it < 2 * 6144; it += G * NTHR) { const int l = it / 6144, j = it % 6144; const float* wcol = ada_w + (size_t)l * 1024 * 6144 + j; float a0 = 0.f, a1 = 0.f, a2 = 0.f;
#pragma unroll 4
            for (int k = 0; k < 1024; ++k) { const float w = wcol[(size_t)k * 6144]; a0 += siluf_(in_c[k]) * w; a1 += siluf_(in_c[1024 + k]) * w; a2 += siluf_(in_cctx[k]) * w; }
            const float bb = ada_b[l * 6144 + j]; MODV[(l * 3 + 0) * 6144 + j] = a0 + bb; MODV[(l * 3 + 1) * 6144 + j] = a1 + bb; MODV[(l * 3 + 2) * 6144 + j] = a2 + bb; } }
        { f32x2* ROPE = (f32x2*)(ws + WS_ROPE);
        for (int it = bx * NTHR + tid; it < 256 * 16; it += G * NTHR) { const int pos = it >> 4, i = it & 15; const float inv = powf(10000.f, -(float)i / 16.f); const float ang = (float)pos * inv; float s, c; sincosf(ang, &s, &c); ROPE[it] = (f32x2){c, s}; } }
    }
    GRID_BAR(); STAMP(0);

    for (int l = 0; l < 2; ++l) {
        if (l == 0) for (int rep_ = 0; rep_ < NREP(2); ++rep_) {
            PHASE_LOCALS(); unsigned char* ws = WSB(); const float* modv = (const float*)(ws + WS_MODV); bf16_t* HMOD = (bf16_t*)(ws + WS_HMOD);
            XSrc xs{INP(I_X), INP(I_CTX), (const float*)(ws + WS_XCUR), 0};
            for (int r = gw; r < MALL; r += NGW) { const int b = r / TPB, set = (r % TPB) < SEQ ? b : 2; const float* xr = xs.row(r); const float* mv = modv + set * 6144;
#pragma unroll
                for (int j = 0; j < 4; ++j) { const int c = 4 * lane + 256 * j; const f32x4 v = *(const f32x4*)(xr + c), sh = *(const f32x4*)(mv + c), sc = *(const f32x4*)(mv + 1024 + c);
                    *(u32x2*)(HMOD + (size_t)r * 1024 + c) = pk4(v * (sc + 1.f) + sh); } }
            GRID_BAR(); STAMP(0);
        }
        for (int rep_ = 0; rep_ < NREP(4); ++rep_) {
            PHASE_LOCALS(); unsigned char* ws = WSB(); unsigned char* WL = ws + WS_W0 + (size_t)l * WL_SIZE;
            pg8::DenseOrder S; S.init(NRT, INW_PAD / 256, G, bx, WL + WL_IN, 1024);
            EpiInProj E{(bf16_t*)(ws + WS_Q), (bf16_t*)(ws + WS_K), (bf16_t*)(ws + WS_V), (bf16_t*)(ws + WS_QKM), (bf16_t*)(ws + WS_VM), (bf16_t*)(ws + WS_OMS), (bf16_t*)(ws + WS_GA), (bf16_t*)(ws + WS_GB),
                        (float*)(ws + WS_GATES), INP(I_BG) + l * 16, (const f32x2*)(ws + WS_ROPE), (unsigned*)(ws + WS_CTL) + CW_MSTAB + l * 16};
            pg8::gemm_phase(lds, (const bf16_t*)(ws + WS_HMOD), 1024, 1024, S, E);
        }
        GRID_BAR(); STAMP(1);
        for (int rep_ = 0; rep_ < NREP(8); ++rep_) {
            PHASE_LOCALS(); unsigned char* ws = WSB();
            MlstmArgs MA{(const bf16_t*)(ws + WS_QKM), (const bf16_t*)(ws + WS_VM), (const bf16_t*)(ws + WS_OMS), (const float*)(ws + WS_GATES), INP(I_CONV) + (size_t)l * 3 * 1024, INP(I_NORMM) + l * 1024,
                         (const unsigned*)(ws + WS_CTL) + CW_MSTAB + l * 16, (bf16_t*)(ws + WS_ST), (float*)(ws + WS_NU), (float*)(ws + WS_ADEC), (bf16_t*)(ws + WS_HM), ws + WS_X1};
            for (int u = bx; u < 8 * NCHUNK; u += G) mlstm_d1_unit(MA, u / NCHUNK, u % NCHUNK, lds);
        }
        GRID_BAR(); STAMP(2);
        for (int rep_ = 0; rep_ < NREP(16); ++rep_) {
            PHASE_LOCALS(); unsigned char* ws = WSB();
            MlstmArgs MA{nullptr, nullptr, nullptr, nullptr, nullptr, nullptr, nullptr, (bf16_t*)(ws + WS_ST), (float*)(ws + WS_NU), (float*)(ws + WS_ADEC), nullptr, ws + WS_X1};
            mlstm_scan(MA, bx * NTHR + tid, G * NTHR);
            if (XSCAN) { GRID_BAR(); mlstm_scan(MA, bx * NTHR + tid, G * NTHR, (bf16_t*)(ws + WS_YB), (float*)(ws + WS_HE)); }
        }
        GRID_BAR(); STAMP(3);
        for (int rep_ = 0; rep_ < NREP(32); ++rep_) {
            PHASE_LOCALS(); unsigned char* ws = WSB(); const bf16_t* Qb_ = (const bf16_t*)(ws + WS_Q); const bf16_t* Kb_ = (const bf16_t*)(ws + WS_K); const bf16_t* Vb_ = (const bf16_t*)(ws + WS_V); bf16_t* OJ = (bf16_t*)(ws + WS_OJ);
            const int nun = (G == 256) ? 8 : (2048 + G - 1) / G;
            for (int r = 0; r < nun; ++r) {
                int grp, qb;
                if (G == 256) { const int xg = vcu >> 5, ii = vcu & 31; grp = xg + 8 * (r >> 1); qb = ii + 32 * (r & 1); }
                else { const int u = bx + r * G; if (u >= 2048) break; grp = u >> 6; qb = u & 63; }
                const int b = grp >> 4, h = (grp >> 1) & 7, j = grp & 1; const size_t q0 = (size_t)b * TPB + qb * 256, k0 = (size_t)b * TPB;
                att::attn_body(Qb_ + q0 * 1024 + h * 128 + j * 64, Kb_ + k0 * 1024 + h * 128 + j * 64, Vb_ + k0 * 1024 + h * 128, OJ + q0 * 2048 + h * 256 + j * 128, TPB, (char*)lds_raw);
            }
            if (l == 0) for (int u = bx; u < 32; u += G) { const int b = u >> 4, h = (u >> 1) & 7, j = u & 1; const size_t q0 = (size_t)b * TPB + SEQ;
                att::attn_body(Qb_ + q0 * 1024 + h * 128 + j * 64, Kb_ + q0 * 1024 + h * 128 + j * 64, Vb_ + q0 * 1024 + h * 128, OJ + q0 * 2048 + h * 256 + j * 128, CTX, (char*)lds_raw); }
        }
        STAMP(4);
        for (int rep_ = 0; rep_ < NREP(64); ++rep_) {
            PHASE_LOCALS(); unsigned char* ws = WSB();
            MlstmArgs MA{(const bf16_t*)(ws + WS_QKM), (const bf16_t*)(ws + WS_VM), (const bf16_t*)(ws + WS_OMS), (const float*)(ws + WS_GATES), INP(I_CONV) + (size_t)l * 3 * 1024, INP(I_NORMM) + l * 1024,
                         (const unsigned*)(ws + WS_CTL) + CW_MSTAB + l * 16, (bf16_t*)(ws + WS_ST), (float*)(ws + WS_NU), (float*)(ws + WS_ADEC), (bf16_t*)(ws + WS_HM), ws + WS_X1};
            for (int u = bx; u < 8 * NCHUNK; u += G) mlstm_d3_unit(MA, u / NCHUNK, u % NCHUNK, lds);
        }
        GRID_BAR(); STAMP(5);
        for (int rep_ = 0; rep_ < NREP(128); ++rep_) {
            PHASE_LOCALS(); unsigned char* ws = WSB(); const bf16_t* OJ = (const bf16_t*)(ws + WS_OJ); bf16_t* OA = (bf16_t*)(ws + WS_OA);
            const float lam_init = l == 0 ? 0.2f : (0.8f - 0.6f * 0.7408182206817179f);
            const float* lm = INP(I_LAM) + l * 256;
            const float lv = __expf(wave_sum(lm[lane] * lm[64 + lane])) - __expf(wave_sum(lm[128 + lane] * lm[192 + lane])) + lam_init;
            const int hh = lane >> 3, e0 = (lane & 7) * 16; f32x4 sgv[4];
#pragma unroll
            for (int q = 0; q < 4; ++q) sgv[q] = *(const f32x4*)(INP(I_SUBLN) + l * 128 + e0 + 4 * q);
            for (int r0 = gw; r0 < MALL; r0 += 2 * NGW) { const int r1 = r0 + NGW; const bool has1 = r1 < MALL; const int rr[2] = {r0, has1 ? r1 : r0};
                u32x4 ra[2][2], rb[2][2];
#pragma unroll
                for (int x = 0; x < 2; ++x) { const bf16_t* p = OJ + (size_t)rr[x] * 2048 + hh * 256 + e0; ra[x][0] = *(const u32x4*)p; ra[x][1] = *(const u32x4*)(p + 8); rb[x][0] = *(const u32x4*)(p + 128); rb[x][1] = *(const u32x4*)(p + 136); }
#pragma unroll
                for (int x = 0; x < 2; ++x) { if (x == 1 && !has1) break;
                    float d[16]; float ss = 0.f;
#pragma unroll
                    for (int q = 0; q < 2; ++q) { const unsigned a4[4] = {ra[x][q].x, ra[x][q].y, ra[x][q].z, ra[x][q].w}, b4[4] = {rb[x][q].x, rb[x][q].y, rb[x][q].z, rb[x][q].w};
#pragma unroll
                        for (int e = 0; e < 4; ++e) { const float lo = bf2f(a4[e] & 0xffffu) - lv * bf2f(b4[e] & 0xffffu), hi_ = bf2f(a4[e] >> 16) - lv * bf2f(b4[e] >> 16); d[q * 8 + 2 * e] = lo; d[q * 8 + 2 * e + 1] = hi_; ss += lo * lo + hi_ * hi_; } }
                    ss += __shfl_xor(ss, 1); ss += __shfl_xor(ss, 2); ss += __shfl_xor(ss, 4);
                    const float rstd = __builtin_amdgcn_rsqf(ss * (1.f / 128.f) + RMS_EPS) * (1.f - lam_init);
                    u32x4 o0, o1;
                    o0.x = pk2(d[0] * rstd * sgv[0].x, d[1] * rstd * sgv[0].y); o0.y = pk2(d[2] * rstd * sgv[0].z, d[3] * rstd * sgv[0].w); o0.z = pk2(d[4] * rstd * sgv[1].x, d[5] * rstd * sgv[1].y); o0.w = pk2(d[6] * rstd * sgv[1].z, d[7] * rstd * sgv[1].w);
                    o1.x = pk2(d[8] * rstd * sgv[2].x, d[9] * rstd * sgv[2].y); o1.y = pk2(d[10] * rstd * sgv[2].z, d[11] * rstd * sgv[2].w); o1.z = pk2(d[12] * rstd * sgv[3].x, d[13] * rstd * sgv[3].y); o1.w = pk2(d[14] * rstd * sgv[3].z, d[15] * rstd * sgv[3].w);
                    bf16_t* po = OA + (size_t)rr[x] * 1024 + hh * 128 + e0; *(u32x4*)po = o0; *(u32x4*)(po + 8) = o1; } }
        }
        GRID_BAR(); STAMP(6);
        for (int rep_ = 0; rep_ < NREP(256); ++rep_) { PHASE_LOCALS(); unsigned char* ws = WSB(); unsigned char* WL = ws + WS_W0 + (size_t)l * WL_SIZE;
            pg8::DenseOrder S; S.init(l ? NRT - 2 : NRT, 4, G, bx, WL + WL_BRA, 1024, l); EpiGate1 E{(const bf16_t*)(ws + WS_GA), (bf16_t*)(ws + WS_T1)}; pg8::gemm_phase(lds, (const bf16_t*)(ws + WS_OA), 1024, 1024, S, E); }
        GRID_BAR(); STAMP(7);
        for (int rep_ = 0; rep_ < NREP(512); ++rep_) { PHASE_LOCALS(); unsigned char* ws = WSB(); unsigned char* WL = ws + WS_W0 + (size_t)l * WL_SIZE;
            pg8::DenseOrder S; S.init(l ? NRT - 2 : NRT, 4, G, bx, WL + WL_BRM, 1024, l); EpiGate2 E{(const bf16_t*)(ws + WS_GB), (const bf16_t*)(ws + WS_T1), (bf16_t*)(ws + WS_Y)}; pg8::gemm_phase(lds, (const bf16_t*)(ws + WS_HM), 1024, 1024, S, E); }
        GRID_BAR(); STAMP(7);
        for (int rep_ = 0; rep_ < NREP(1024); ++rep_) { PHASE_LOCALS(); unsigned char* ws = WSB(); unsigned char* WL = ws + WS_W0 + (size_t)l * WL_SIZE;
            XSrc xs{INP(I_X), INP(I_CTX), (const float*)(ws + WS_XCUR), l};
            pg8::DenseOrder S; S.init(l ? NRT - 2 : NRT, 4, G, bx, WL + WL_OUT, 1024, l); EpiOut E{xs, (const float*)(ws + WS_MODV) + l * 3 * 6144, (float*)(ws + WS_R)}; pg8::gemm_phase(lds, (const bf16_t*)(ws + WS_Y), 1024, 1024, S, E); }
        GRID_BAR(); STAMP(7);
        for (int rep_ = 0; rep_ < NREP(2048); ++rep_) {
            PHASE_LOCALS(); unsigned char* ws = WSB(); const float* modv = (const float*)(ws + WS_MODV) + l * 3 * 6144; const float* Rf = (const float*)(ws + WS_R); float* X1 = (float*)(ws + WS_X1); bf16_t* H2A = (bf16_t*)(ws + WS_H2A);
            const float* g1 = INP(I_LN1G) + l * 1024; const float* b1 = INP(I_LN1B) + l * 1024;
            for (int r0 = gw; r0 < MALL; r0 += 2 * NGW) { const int r1 = r0 + NGW; const bool has1 = r1 < MALL; const int rr[2] = {r0, has1 ? r1 : r0}; f32x4 vv[2][4];
#pragma unroll
                for (int x = 0; x < 2; ++x)
#pragma unroll
                    for (int j = 0; j < 4; ++j) vv[x][j] = unpk4(*(const u32x2*)((const bf16_t*)Rf + (size_t)rr[x] * 1024 + 4 * lane + 256 * j));
#pragma unroll
                for (int x = 0; x < 2; ++x) { if (x == 1 && !has1) break;
                    const int r = rr[x]; const int b = r / TPB, set = (r % TPB) < SEQ ? b : 2; const float* mv = modv + set * 6144;
                    ln_row(vv[x], g1, b1, lane);
#pragma unroll
                    for (int j = 0; j < 4; ++j) { const int c = 4 * lane + 256 * j;
                        const f32x4 sh = *(const f32x4*)(mv + 3 * 1024 + c), sc = *(const f32x4*)(mv + 4 * 1024 + c); const f32x4 hh = vv[x][j] * (sc + 1.f) + sh;
                        *(u32x2*)(H2A + (size_t)r * 1024 + c) = pk4(hh); } } }
        }
        GRID_BAR(); STAMP(8);
        for (int rep_ = 0; rep_ < NREP(4096); ++rep_) { PHASE_LOCALS(); unsigned char* ws = WSB(); unsigned char* WL = ws + WS_W0 + (size_t)l * WL_SIZE;
            pg8::DenseOrder S; S.init(NRT, 1, G, bx, WL + WL_R3, 3072); EpiLogits E{(float*)(ws + WS_LOG)}; pg8::gemm_phase(lds, (const bf16_t*)(ws + WS_H2A), 1024, ROUTER_K, S, E, 3072); }
        GRID_BAR(); STAMP(9);
        for (int rep_ = 0; rep_ < NREP(8192); ++rep_) {
            PHASE_LOCALS(); unsigned char* ws = WSB(); const float* LOGITS = (const float*)(ws + WS_LOG); const float* e_bias = INP(I_EB) + l * 256; unsigned* ecnt = (unsigned*)(ws + WS_CTL) + CW_CNT + l * 256;
            for (int xt_ = 0; xt_ < 1 + XTOPK; ++xt_) {
            if (xt_) ecnt += 2048;
            int* TOPI = (int*)(ws + (xt_ ? WS_YB : WS_TOPI)); float* TOPW = (float*)(ws + (xt_ ? WS_YB + 2 * MiB : WS_TOPW)); int* POS = (int*)(ws + (xt_ ? WS_YB + 4 * MiB : WS_POS));
            for (int r4 = gw * 4; r4 < MALL; r4 += NGW * 4) {
                const int r = r4 + (lane >> 4), sub = lane & 15; float sc[16], bs[16];
#pragma unroll
                for (int q = 0; q < 4; ++q) { const f32x4 lg = *(const f32x4*)(LOGITS + (size_t)r * 256 + sub * 16 + 4 * q), eb = *(const f32x4*)(e_bias + sub * 16 + 4 * q);
                    sc[4 * q] = sigmoidf_(lg.x); sc[4 * q + 1] = sigmoidf_(lg.y); sc[4 * q + 2] = sigmoidf_(lg.z); sc[4 * q + 3] = sigmoidf_(lg.w);
                    bs[4 * q] = sc[4 * q] + eb.x; bs[4 * q + 1] = sc[4 * q + 1] + eb.y; bs[4 * q + 2] = sc[4 * q + 2] + eb.z; bs[4 * q + 3] = sc[4 * q + 3] + eb.w; }
                int myi = 0; float myw = 0.f, wsum = 0.f;
#pragma unroll
                for (int k = 0; k < 8; ++k) {
                    float bv = bs[0], bsc = sc[0]; int bi = 0;
#pragma unroll
                    for (int e = 1; e < 16; ++e) if (bs[e] > bv) { bv = bs[e]; bsc = sc[e]; bi = e; }
                    int gi = sub * 16 + bi;
#pragma unroll
                    for (int o = 1; o < 16; o <<= 1) { const float ov = __shfl_xor(bv, o), os = __shfl_xor(bsc, o); const int oi = __shfl_xor(gi, o); if (ov > bv || (ov == bv && oi < gi)) { bv = ov; gi = oi; bsc = os; } }
                    if ((gi >> 4) == sub) { const int oe = gi & 15;
#pragma unroll
                        for (int e = 0; e < 16; ++e) if (e == oe) bs[e] = -1e30f; }
                    wsum += bsc;
                    if (sub == k) { myi = gi; myw = bsc; }
                }
                if (sub < 8) { const float w = myw / wsum * 2.5f; const int p = (int)atomicAdd(ecnt + myi, 1u);
                    TOPI[(size_t)r * 8 + sub] = myi; TOPW[(size_t)r * 8 + sub] = w; POS[(size_t)r * 8 + sub] = p; }
            }
            }
        }
        GRID_BAR(); STAMP(10);
        for (int rep_ = 0; rep_ < NREP(16384); ++rep_) {
            PHASE_LOCALS(); unsigned char* ws = WSB(); unsigned* ecnt = (unsigned*)(ws + WS_CTL) + CW_CNT + l * 256;
            const int* TOPI = (const int*)(ws + WS_TOPI); const float* TOPW = (const float*)(ws + WS_TOPW); const int* POS = (const int*)(ws + WS_POS); int* SLOT = (int*)(ws + WS_SLOT);
            int* ROWTOK = (int*)(ws + WS_ROWTOK); float* ROWW = (float*)(ws + WS_ROWW); int* BLKEXP = (int*)(ws + WS_BLKEXP);
            LAS int* cntL = (LAS int*)lds; LAS int* bst = cntL + 256; LAS int* tot = bst + 256;
            if (tid < 256) cntL[tid] = (int)__hip_atomic_load(ecnt + tid, RLX_AGENT);
            __syncthreads();
            if (tid == 0) { int s = 0; for (int e = 0; e < 256; ++e) { bst[e] = s; s += (cntL[e] + 255) >> 8; } tot[0] = s; }
            __syncthreads();
            const int NB = tot[0]; const int gt = bx * NTHR + tid, GT = G * NTHR;
            for (int i = gt; i < MALL * 8; i += GT) { const int e = TOPI[i]; const int slot = bst[e] * 256 + POS[i]; SLOT[i] = slot; st_wt(ROWTOK + slot, i >> 3); st_wt(ROWW + slot, TOPW[i]); }
            for (int i = gt; i < 256 * 256; i += GT) { const int e = i >> 8, p = i & 255, c = cntL[e]; if ((c & 255) != 0 && p >= (c & 255)) { const int slot = (bst[e] + (c >> 8)) * 256 + p; st_wt(ROWTOK + slot, 0); st_wt(ROWW + slot, -1.f); } }
            for (int i = gt; i < 256 * 160; i += GT) { const int e = i / 160, j = i % 160; if (j < ((cntL[e] + 255) >> 8)) st_wt(BLKEXP + bst[e] + j, e); }
            for (int i = gt; i < NRT * 256; i += GT) { const int slot = NB * 256 + i; ROWTOK[slot] = i; ROWW[slot] = 1.f; if ((i & 255) == 0) st_wt(BLKEXP + NB + (i >> 8), 256); }
            if (gt == 0) st_wt(BLKEXP + MAXBLK, NB + NRT);
            __syncthreads();
        }
        GRID_BAR(); STAMP(10);
        for (int rep_ = 0; rep_ < NREP(32768); ++rep_) {
            PHASE_LOCALS(); unsigned char* ws = WSB(); unsigned char* WL = ws + WS_W0 + (size_t)l * WL_SIZE; const int* ROWTOK = (const int*)(ws + WS_ROWTOK); const int* BLKEXP = (const int*)(ws + WS_BLKEXP);
            LAS int* rowtab = (LAS int*)(lds + TAB_OFF); LAS int* etab = rowtab + 12 * 256;
            const int nunits = BLKEXP[MAXBLK] * 2;
            for (int i = 0; i < 12; ++i) { const int L = i * G + vcu; if (L >= nunits) break; const int bi = L >> 1;
                if (tid < 256) rowtab[i * 256 + tid] = ROWTOK[(size_t)bi * 256 + tid]; if (tid == 256) etab[i] = BLKEXP[bi]; }
            __syncthreads();
            pg8::MoeOrder<2, true> S{nunits, G, vcu, (const char*)(WL + WL_E1), (size_t)512 * 1024 * 2, (size_t)256 * 1024 * 2, rowtab, etab};
            EpiSwiglu E{(bf16_t*)(ws + WS_HE)}; pg8::gemm_phase(lds, (const bf16_t*)(ws + WS_H2A), 1024, 1024, S, E);
        }
        GRID_BAR(); STAMP(11);
        for (int rep_ = 0; rep_ < NREP(65536); ++rep_) {
            PHASE_LOCALS(); unsigned char* ws = WSB(); unsigned char* WL = ws + WS_W0 + (size_t)l * WL_SIZE; const int* BLKEXP = (const int*)(ws + WS_BLKEXP);
            LAS int* rowtab = (LAS int*)(lds + TAB_OFF); LAS int* etab = rowtab + 12 * 256;
            const int nunits = BLKEXP[MAXBLK] * 4;
            for (int i = tid; i < 64; i += NTHR) { const int L = i * G + vcu; if (L < nunits) etab[i] = BLKEXP[L >> 2]; }
            __syncthreads();
            pg8::MoeOrder<4, false> S{nunits, G, vcu, (const char*)(WL + WL_E2), (size_t)1024 * 256 * 2, (size_t)256 * 256 * 2, rowtab, etab};
            EpiScaleRow E{(bf16_t*)(ws + WS_YB), (const float*)(ws + WS_ROWW)}; pg8::gemm_phase(lds, (const bf16_t*)(ws + WS_HE), 256, 256, S, E);
        }
        GRID_BAR(); STAMP(12);
        for (int rep_ = 0; rep_ < NREP(131072); ++rep_) {
            PHASE_LOCALS(); unsigned char* ws = WSB(); const float* MODV = (const float*)(ws + WS_MODV); const float* modv = MODV + l * 3 * 6144; const bf16_t* YB = (const bf16_t*)(ws + WS_YB); const int* SLOT = (const int*)(ws + WS_SLOT);
            const float* X1 = (const float*)(ws + WS_R); float* XCUR = (float*)(ws + WS_XCUR); bf16_t* HMOD = (bf16_t*)(ws + WS_HMOD); float* outp = OUTP();
            const float* g2 = INP(I_LN2G) + l * 1024; const float* b2 = INP(I_LN2B) + l * 1024; const float* g1 = INP(I_LN1G) + l * 1024; const float* b1 = INP(I_LN1B) + l * 1024;
            const int NB = ((const int*)(ws + WS_BLKEXP))[MAXBLK] - NRT;
            for (int r0 = gw; r0 < MALL; r0 += 2 * NGW) { const int r1 = r0 + NGW; const bool has1 = r1 < MALL; const int rr[2] = {r0, has1 ? r1 : r0};
                int sl[2]; u32x2 yb[2][9][2]; u32x4 rx[2][2];
#pragma unroll
                for (int x = 0; x < 2; ++x) sl[x] = SLOT[(size_t)rr[x] * 8 + (lane & 7)];
#pragma unroll
                for (int x = 0; x < 2; ++x) {
#pragma unroll
                    for (int j2 = 0; j2 < 2; ++j2) { yb[x][8][j2] = *(const u32x2*)((const unsigned char*)YB + ((size_t)NB * 256 + rr[x]) * 1024 + 8 * lane + 512 * j2); rx[x][j2] = *(const u32x4*)((const bf16_t*)X1 + (size_t)rr[x] * 1024 + 8 * lane + 512 * j2); }
#pragma unroll
                    for (int k = 0; k < 8; ++k) { const size_t so = (size_t)__shfl(sl[x], k) * 1024;
#pragma unroll
                        for (int j2 = 0; j2 < 2; ++j2) yb[x][k][j2] = *(const u32x2*)((const unsigned char*)YB + so + 8 * lane + 512 * j2); } }
#pragma unroll
                for (int x = 0; x < 2; ++x) { if (x == 1 && !has1) break;
                    const int r = rr[x]; const int b = r / TPB, t = r % TPB, set = t < SEQ ? b : 2; const float* mv = modv + set * 6144; f32x4 xv[4], v[4];
#pragma unroll
                    for (int j2 = 0; j2 < 2; ++j2) { xv[2 * j2] = unpk4((u32x2){rx[x][j2].x, rx[x][j2].y}); xv[2 * j2 + 1] = unpk4((u32x2){rx[x][j2].z, rx[x][j2].w}); }
                    ln_row8(xv, g1, b1, lane);
#pragma unroll
                    for (int j = 0; j < 4; ++j) { const int j2 = j >> 1, hf = j & 1; f32x4 f = unpk4_fp8(hf ? yb[x][8][j2].y : yb[x][8][j2].x);
#pragma unroll
                        for (int k = 0; k < 8; ++k) f = f + unpk4_fp8(hf ? yb[x][k][j2].y : yb[x][k][j2].x);
                        f = f * (1.f / YB8_SCALE);
                        v[j] = xv[j] * ALPHA_RES + *(const f32x4*)(mv + 5 * 1024 + C8(j)) * f; }
                    ln_row8(v, g2, b2, lane);
                    if (l == 0) { const float* mn = MODV + 3 * 6144 + set * 6144;
#pragma unroll
                        for (int j2 = 0; j2 < 2; ++j2) { u32x2 pk[2];
#pragma unroll
                            for (int hf = 0; hf < 2; ++hf) { const int j = 2 * j2 + hf, c = C8(j); *(f32x4*)(XCUR + (size_t)r * 1024 + c) = v[j];
                                const f32x4 sh = *(const f32x4*)(mn + c), sc = *(const f32x4*)(mn + 1024 + c); pk[hf] = pk4(v[j] * (sc + 1.f) + sh); }
                            *(u32x4*)(HMOD + (size_t)r * 1024 + 8 * lane + 512 * j2) = (u32x4){pk[0].x, pk[0].y, pk[1].x, pk[1].y}; } }
                    else if (t < SEQ) {
#pragma unroll
                        for (int j = 0; j < 4; ++j) *(f32x4*)(outp + ((size_t)b * SEQ + t) * 1024 + C8(j)) = v[j]; } } }
        }
        if (l == 0 || PROBE) { GRID_BAR(); STAMP(13); }
    }
#if PROBE
    {
        unsigned char* ws = WSB(); unsigned* ctl = (unsigned*)(ws + WS_CTL);
        if (blockIdx.x == 0 && threadIdx.x == 0) { LAS unsigned long long* ts_ = (LAS unsigned long long*)(lds + MISC_OFF + 64);
            unsigned long long sa = 0, sb = 0; for (int c = 0; c < 14; ++c) { if ((PROBE_A >> c) & 1) sa += ts_[1 + c]; if ((PROBE_B >> c) & 1) sb += ts_[1 + c]; }
            __hip_atomic_store(ctl + 20000, (unsigned)(sa / 100ull), RLX_AGENT); __hip_atomic_store(ctl + 20001, (unsigned)(sb / 100ull), RLX_AGENT); }
        GRID_BAR();
        const float va = sqrtf((float)__hip_atomic_load(ctl + 20000, RLX_AGENT)), vb = (float)__hip_atomic_load(ctl + 20001, RLX_AGENT);
        float* outp = OUTP();
        for (size_t i = (size_t)blockIdx.x * NTHR + threadIdx.x; i < (size_t)BATCH * SEQ * 1024; i += (size_t)gridDim.x * NTHR) outp[i] = (i == 0) ? vb : va;
    }
#endif
}

extern "C" void kernel_launch(void* const* d_in, const int* in_sizes, int n_in, void* d_out, int out_size, void* d_ws, size_t ws_size, hipStream_t stream) {
    static int grid = 0;
    if (grid == 0) {
        if (n_in != 25 || ws_size < WS_END) { fprintf(stderr, "kernel_launch: need 25 inputs and >= %zu bytes of workspace; got %d, %zu\n", (size_t)WS_END, n_in, ws_size); grid = -1; return; }
        int dev = 0, cus = 0, per_cu = 0;
        if (hipGetDevice(&dev) != hipSuccess || hipDeviceGetAttribute(&cus, hipDeviceAttributeMultiprocessorCount, dev) != hipSuccess) { grid = -1; return; }
        if (hipFuncSetAttribute((const void*)mega_fwd, hipFuncAttributeMaxDynamicSharedMemorySize, LDS_BYTES) != hipSuccess) { fprintf(stderr, "kernel_launch: hipFuncSetAttribute failed\n"); grid = -1; return; }
        if (hipOccupancyMaxActiveBlocksPerMultiprocessor(&per_cu, (const void*)mega_fwd, NTHR, LDS_BYTES) != hipSuccess || per_cu < 1) { fprintf(stderr, "kernel_launch: occupancy query says %d\n", per_cu); (void)hipGetLastError(); per_cu = 1; }
        grid = cus;
    }
    if (grid < 0) return;
    if (hipMemsetAsync((char*)d_ws + WS_CTL, 0, CTL_ZERO_BYTES, stream) != hipSuccess) return;
    KArgs a{};
    for (int i = 0; i < 25; ++i) a.in[i] = (const float*)d_in[i];
    a.out = (float*)d_out; a.ws = (unsigned char*)d_ws; a.dbg = 0; a.pad = 0;
    hipLaunchKernelGGL(mega_fwd, dim3(grid), dim3(NTHR), LDS_BYTES, stream, a);
}
```
